# Optimizing an MI355X kernel written in HIP

```python
import math
import jax, jax.numpy as jnp
from jax import lax
import numpy as np

D_MODEL = 1024
BATCH = 4
SEQ = 8192
DEPTH = 4

CHUNK = 64
Q_BLOCK = 128
N_HEADS = 4
DA_HEAD = 64
DA_VDIM = 2 * DA_HEAD
RET_DK = 64
RET_DV = 128
ROPE_BASE = 10000.0
GLA_DK = 64
GLA_DV = 128
GLA_RANK = 16
GLA_TAU = 16.0
D_FF = 2752
EPS = 1e-6
N_BRANCH = 3

A_Q = N_HEADS * 2 * DA_HEAD
A_K = N_HEADS * 2 * DA_HEAD
A_V = N_HEADS * DA_VDIM
B_Q = N_HEADS * RET_DK
B_K = N_HEADS * RET_DK
B_V = N_HEADS * RET_DV
B_G = N_HEADS * RET_DV
C_Q = N_HEADS * GLA_DK
C_K = N_HEADS * GLA_DK
C_V = N_HEADS * GLA_DV
C_G = N_HEADS * GLA_DV
C_A = GLA_RANK
GATE_COLS = N_BRANCH * D_MODEL
IN_COLS = A_Q + A_K + A_V + B_Q + B_K + B_V + B_G + C_Q + C_K + C_V + C_G + C_A + GATE_COLS

kernel_name = "hybrid_diffattn_retention_gla_macaron"


def _rmsnorm(t, g):
    tf = t.astype(jnp.float32)
    y = tf * lax.rsqrt(jnp.mean(tf * tf, axis=-1, keepdims=True) + EPS)
    return (y * g.astype(jnp.float32)).astype(t.dtype)


def _swiglu(t, w1, w3, w2):
    return (jax.nn.silu(t @ w1) * (t @ w3)) @ w2


def _heads(t, h):
    b, s, w = t.shape
    return t.reshape(b, s, h, w // h).transpose(0, 2, 1, 3)


def _merge_heads(t):
    b, h, s, d = t.shape
    return t.transpose(0, 2, 1, 3).reshape(b, s, h * d)


def _to_chunks(t):
    b, h, s, d = t.shape
    return t.reshape(b, h, s // CHUNK, CHUNK, d).transpose(2, 0, 1, 3, 4)


def _from_chunks(t):
    n, b, h, c, d = t.shape
    return t.transpose(1, 2, 0, 3, 4).reshape(b, h, n * c, d)


def _rotary(t):
    s, d = t.shape[-2], t.shape[-1]
    inv = ROPE_BASE ** (-jnp.arange(0, d, 2, dtype=jnp.float32) / d)
    ang = jnp.arange(s, dtype=jnp.float32)[:, None] * inv[None, :]
    cos, sin = jnp.cos(ang), jnp.sin(ang)
    t1, t2 = t[..., : d // 2], t[..., d // 2:]
    return jnp.concatenate([t1 * cos - t2 * sin, t1 * sin + t2 * cos], axis=-1)


def _diff_attention(q, k, v, lam):
    b, h, _, s, dh = q.shape
    nb = s // Q_BLOCK
    qb = q.reshape(b, h, 2, nb, Q_BLOCK, dh).transpose(3, 0, 1, 2, 4, 5)
    key_chunk = jnp.arange(s) // CHUNK
    scale = dh ** -0.5

    def block(args):
        qi, bi = args
        q_chunk = (bi * Q_BLOCK + jnp.arange(Q_BLOCK)) // CHUNK
        mask = key_chunk[None, :] <= q_chunk[:, None]
        sc = jnp.einsum('bhmqd,bhmkd->bhmqk', qi, k).astype(jnp.float32) * scale
        p = jax.nn.softmax(jnp.where(mask, sc, -jnp.inf), axis=-1)
        w = p[:, :, 0] - lam * p[:, :, 1]
        return jnp.einsum('bhqk,bhkd->bhqd', w.astype(v.dtype), v)

    out = lax.map(block, (qb, jnp.arange(nb)))
    return out.transpose(1, 2, 0, 3, 4).reshape(b, h, s, v.shape[-1])


def _retention(q, k, v):
    b, h, _, dk = q.shape
    log_g = jnp.log1p(-jnp.exp2(-5.0 - jnp.arange(h, dtype=jnp.float32)))
    pos = jnp.arange(CHUNK, dtype=jnp.float32)
    causal = pos[:, None] >= pos[None, :]
    d_in = jnp.exp(jnp.where(causal, log_g[:, None, None] * (pos[:, None] - pos[None, :]), -jnp.inf))
    q_dec = jnp.exp(log_g[:, None] * (pos + 1.0))[..., None]
    k_dec = jnp.exp(log_g[:, None] * (CHUNK - 1.0 - pos))[..., None]
    c_dec = jnp.exp(log_g * CHUNK)[:, None, None]

    def step(state, inp):
        qc, kc, vc = inp
        sc = jnp.einsum('bhid,bhjd->bhij', qc, kc) * d_in
        inner = jnp.einsum('bhij,bhje->bhie', sc, vc)
        cross = jnp.einsum('bhid,bhde->bhie', qc, state) * q_dec
        state = state * c_dec + jnp.einsum('bhjd,bhje->bhde', kc * k_dec, vc)
        return state, inner + cross

    init = jnp.zeros((b, h, dk, v.shape[-1]), jnp.float32)
    _, out = lax.scan(step, init, (_to_chunks(q), _to_chunks(k), _to_chunks(v)))
    return _from_chunks(out)


def _gla(q, k, v, log_a):
    b, h, _, dk = q.shape
    pos = jnp.arange(CHUNK)
    causal = (pos[:, None] >= pos[None, :])[:, :, None]

    def step(state, inp):
        qc, kc, vc, ac = inp
        cum = jnp.cumsum(ac, axis=2)
        rel = jnp.exp(jnp.where(causal, cum[:, :, :, None, :] - cum[:, :, None, :, :], -jnp.inf))
        sc = jnp.einsum('bhid,bhjd,bhijd->bhij', qc, kc, rel)
        inner = jnp.einsum('bhij,bhje->bhie', sc, vc)
        cross = jnp.einsum('bhid,bhde->bhie', qc * jnp.exp(cum), state)
        last = cum[:, :, -1:, :]
        state = state * jnp.exp(last[:, :, 0, :, None]) + jnp.einsum('bhjd,bhje->bhde', kc * jnp.exp(last - cum), vc)
        return state, inner + cross

    init = jnp.zeros((b, h, dk, v.shape[-1]), jnp.float32)
    _, out = lax.scan(step, init, (_to_chunks(q), _to_chunks(k), _to_chunks(v), _to_chunks(log_a)))
    return _from_chunks(out)


def _mixer(h, w_in, lam_qk, lam_init, da_g, ret_g, gla_a2, gla_ab, gla_g, w_ba, w_bb, w_bc, w_o):
    f32 = jnp.float32
    dt = h.dtype
    b, s, _ = h.shape
    proj = h @ w_in
    sizes = [A_Q, A_K, A_V, B_Q, B_K, B_V, B_G, C_Q, C_K, C_V, C_G, C_A, GATE_COLS]
    idx = np.cumsum(sizes)[:-1].tolist()
    aq, ak, av, rq, rk, rv, rg, cq, ck, cv, cg, ca, gates = jnp.split(proj, idx, axis=-1)

    def two_maps(t):
        return t.reshape(b, s, N_HEADS, 2, DA_HEAD).transpose(0, 2, 3, 1, 4)
    lq = lam_qk.astype(f32)
    lam = jnp.exp(jnp.sum(lq[0] * lq[1])) - jnp.exp(jnp.sum(lq[2] * lq[3])) + lam_init
    ya = _diff_attention(two_maps(aq), two_maps(ak), _heads(av, N_HEADS), lam)
    ya = _merge_heads(_rmsnorm(ya, da_g) * (1.0 - lam_init)).astype(dt)

    rq_h = _rotary(_heads(rq, N_HEADS).astype(f32))
    rk_h = _rotary(_heads(rk, N_HEADS).astype(f32)) * (RET_DK ** -0.5)
    yb = _retention(rq_h, rk_h, _heads(rv, N_HEADS).astype(f32))
    yb = jax.nn.silu(rg) * _merge_heads(_rmsnorm(yb, ret_g)).astype(dt)

    log_a = jax.nn.log_sigmoid((ca @ gla_a2 + gla_ab).astype(f32)) / GLA_TAU
    yc = _gla(_heads(cq, N_HEADS).astype(f32) * (GLA_DK ** -0.5), _heads(ck, N_HEADS).astype(f32),
              _heads(cv, N_HEADS).astype(f32), _heads(log_a, N_HEADS))
    yc = jax.nn.silu(cg) * _merge_heads(_rmsnorm(yc, gla_g)).astype(dt)

    g = jax.nn.sigmoid(gates).reshape(b, s, N_BRANCH, D_MODEL)
    merged = g[:, :, 0] * (ya @ w_ba) + g[:, :, 1] * (yb @ w_bb) + g[:, :, 2] * (yc @ w_bc)
    return merged @ w_o


def setup_inputs(seed: int = 0) -> dict:
    key = jax.random.key(seed)
    ks = jax.random.split(key, 24)
    f32 = jnp.float32
    L = DEPTH

    def nrm(k, shape, scale):
        return jax.random.normal(k, shape, f32) * scale

    def gain(k, shape):
        return 1.0 + 0.02 * jax.random.normal(k, shape, f32)

    return {
        'x': nrm(ks[0], (BATCH, SEQ, D_MODEL), 1.0),
        'ffn1_norm': gain(ks[1], (L, D_MODEL)),
        'ffn1_w1': nrm(ks[2], (L, D_MODEL, D_FF), D_MODEL ** -0.5),
        'ffn1_w3': nrm(ks[3], (L, D_MODEL, D_FF), D_MODEL ** -0.5),
        'ffn1_w2': nrm(ks[4], (L, D_FF, D_MODEL), D_FF ** -0.5),
        'mix_norm': gain(ks[5], (L, D_MODEL)),
        'w_in': nrm(ks[6], (L, D_MODEL, IN_COLS), D_MODEL ** -0.5),
        'lam_qk': nrm(ks[7], (L, 4, DA_HEAD), 0.1),
        'da_norm': gain(ks[8], (L, DA_VDIM)),
        'ret_norm': gain(ks[9], (L, RET_DV)),
        'gla_a2': nrm(ks[10], (L, GLA_RANK, C_K), GLA_RANK ** -0.5),
        'gla_a_bias': nrm(ks[11], (L, C_K), 0.1),
        'gla_norm': gain(ks[12], (L, GLA_DV)),
        'w_branch_a': nrm(ks[13], (L, A_V, D_MODEL), A_V ** -0.5),
        'w_branch_b': nrm(ks[14], (L, B_V, D_MODEL), B_V ** -0.5),
        'w_branch_c': nrm(ks[15], (L, C_V, D_MODEL), C_V ** -0.5),
        'w_out': nrm(ks[16], (L, D_MODEL, D_MODEL), D_MODEL ** -0.5),
        'ffn2_norm': gain(ks[17], (L, D_MODEL)),
        'ffn2_w1': nrm(ks[18], (L, D_MODEL, D_FF), D_MODEL ** -0.5),
        'ffn2_w3': nrm(ks[19], (L, D_MODEL, D_FF), D_MODEL ** -0.5),
        'ffn2_w2': nrm(ks[20], (L, D_FF, D_MODEL), D_FF ** -0.5),
        'final_norm': gain(ks[21], (D_MODEL,)),
    }


def reference(x, ffn1_norm, ffn1_w1, ffn1_w3, ffn1_w2, mix_norm, w_in, lam_qk, da_norm, ret_norm,
              gla_a2, gla_a_bias, gla_norm, w_branch_a, w_branch_b, w_branch_c, w_out,
              ffn2_norm, ffn2_w1, ffn2_w3, ffn2_w2, final_norm):
    for l in range(DEPTH):
        lam_init = 0.8 - 0.6 * math.exp(-0.3 * l)
        x = x + 0.5 * _swiglu(_rmsnorm(x, ffn1_norm[l]), ffn1_w1[l], ffn1_w3[l], ffn1_w2[l])
        h = _rmsnorm(x, mix_norm[l])
        x = x + _mixer(h, w_in[l], lam_qk[l], lam_init, da_norm[l], ret_norm[l], gla_a2[l],
                       gla_a_bias[l], gla_norm[l], w_branch_a[l], w_branch_b[l], w_branch_c[l], w_out[l])
        x = x + 0.5 * _swiglu(_rmsnorm(x, ffn2_norm[l]), ffn2_w1[l], ffn2_w3[l], ffn2_w2[l])
    return _rmsnorm(x, final_norm)
```

```cpp
#include <hip/hip_runtime.h>
#include <cstdio>
#include <cstdint>

#define GAS __attribute__((address_space(1)))
#define LAS __attribute__((address_space(3)))
typedef unsigned short bf16;
typedef unsigned v4u __attribute__((ext_vector_type(4)));
typedef unsigned v2u __attribute__((ext_vector_type(2)));
typedef float f32x4 __attribute__((ext_vector_type(4)));
typedef float f32x2 __attribute__((ext_vector_type(2)));
typedef short bf16x8 __attribute__((ext_vector_type(8)));

constexpr int BATCH = 4, SEQ = 8192, DMODEL = 1024, DEPTH = 4, M = BATCH * SEQ;
constexpr int NH = 4;
constexpr int DFF = 2752, DFFP = 2816;
constexpr int INC = 7696;
constexpr int PJ = 4864;
constexpr int C_AQ = 0, C_RG = 512, C_CG = 1024, C_AK = 1536, C_AV = 2048, C_RQ = 2560, C_RK = 2816, C_RV = 3072, C_CQ = 3584, C_CK = 3840, C_CV = 4096, C_LA = 4608;
constexpr int C_GATE = 1536;
constexpr int O_AQ = 0, O_AK = 512, O_AV = 1024, O_RQ = 1536, O_RK = 1792, O_RV = 2048, O_RG = 2560, O_CQ = 3072, O_CK = 3328, O_CV = 3584, O_CG = 4096, O_CA = 4608, O_GATE = 4624;
constexpr float EPS = 1e-6f;
constexpr float C2 = 0.125f * 1.4426950408889634f;

constexpr size_t MiB = 1u << 20;
constexpr size_t WS_CTL = 0, CTL_ZERO_BYTES = 64 * 1024;
constexpr size_t WS_LAM = 256 * 1024;
constexpr size_t WS_DEC = 1 * MiB;
constexpr size_t WS_ROPE = 2 * MiB;
constexpr size_t WS_SSQ = 4 * MiB;
constexpr size_t WS_W = 10 * MiB;
constexpr size_t W_13A = WS_W, W_2A = W_13A + 11 * MiB, W_13B = W_2A + 11 * MiB / 2, W_2B = W_13B + 11 * MiB, W_IN = W_2B + 11 * MiB / 2,
                 W_G = W_IN + 19 * MiB / 2, W_B = W_G + 6 * MiB, W_O = W_B + 3 * MiB, W_END = W_O + 2 * MiB;
constexpr size_t WS_HN = 64 * MiB;
constexpr size_t WS_ST = 128 * MiB;
constexpr size_t WS_BIG = 192 * MiB;
constexpr size_t WS_TOT = 496 * MiB;
constexpr size_t WS_DR = 500 * MiB;
constexpr size_t WS_END = 501 * MiB;
static_assert(W_END <= WS_HN, "weight region");

constexpr int RING_BYTES = 131072;
constexpr int MISC_OFF = RING_BYTES + 320;
constexpr int LDS_BYTES = 147456;

__device__ __forceinline__ float bf2f(unsigned h) { return __uint_as_float(h << 16); }
__device__ __forceinline__ float bflo(unsigned w) { return __uint_as_float(w << 16); }
__device__ __forceinline__ float bfhi(unsigned w) { return __uint_as_float(w & 0xffff0000u); }
__device__ __forceinline__ unsigned f2bf(float f) { unsigned u = __float_as_uint(f); return (u + 0x7fffu + ((u >> 16) & 1u)) >> 16; }
__device__ __forceinline__ unsigned pk2(float lo, float hi) { typedef float f2_ __attribute__((ext_vector_type(2))); typedef __bf16 b2_ __attribute__((ext_vector_type(2))); f2_ v = {lo, hi}; b2_ b = __builtin_convertvector(v, b2_); return __builtin_bit_cast(unsigned, b); }
template <int K> __device__ __forceinline__ float xadd(float v) {
    if constexpr (K == 32) { auto rr = __builtin_amdgcn_permlane32_swap(__float_as_uint(v), __float_as_uint(v), false, false); return __uint_as_float(rr[0]) + __uint_as_float(rr[1]); }
    else return v + __int_as_float(__builtin_amdgcn_ds_swizzle(__float_as_int(v), (K << 10) | 0x1f));
}
__device__ __forceinline__ float wave_sum(float v) { v = xadd<1>(v); v = xadd<2>(v); v = xadd<4>(v); v = xadd<8>(v); v = xadd<16>(v); v = xadd<32>(v); return v; }
__device__ __forceinline__ float fast_exp2(float x) { return __builtin_amdgcn_exp2f(x); }
__device__ __forceinline__ float sigmoidf_(float x) { return __builtin_amdgcn_rcpf(1.0f + fast_exp2(-1.4426950408889634f * x)); }
__device__ __forceinline__ float siluf_(float x) { return x * sigmoidf_(x); }
template <class T> __device__ __forceinline__ T* uni(T* p) {
    const unsigned long long v = (unsigned long long)p;
    const unsigned lo = __builtin_amdgcn_readfirstlane((unsigned)v), hi = __builtin_amdgcn_readfirstlane((unsigned)(v >> 32));
    return (T*)(GAS T*)(((unsigned long long)hi << 32) | lo);
}
__device__ __forceinline__ int opaque_tid(int wave) { int z = 0; asm volatile("" : "+v"(z)); const int lane = __builtin_amdgcn_mbcnt_hi(-1, __builtin_amdgcn_mbcnt_lo(-1, z)); return wave * 64 + lane; }
__device__ __forceinline__ unsigned cvtpk2(float lo, float hi) { typedef float f2 __attribute__((ext_vector_type(2))); typedef __bf16 b2 __attribute__((ext_vector_type(2))); f2 v = {lo, hi}; b2 b = __builtin_convertvector(v, b2); return __builtin_bit_cast(unsigned, b); }
__device__ __forceinline__ void glds16(const void* gsrc, unsigned lds_dst) { unsigned keep;
    asm volatile("s_mov_b32 %0, m0\n\ts_mov_b32 m0, %2\n\ts_nop 0\n\tglobal_load_lds_dwordx4 %1, off\n\ts_mov_b32 m0, %0" : "=&s"(keep) : "v"(gsrc), "s"(lds_dst) : "memory"); }
template <int IMM> __device__ __forceinline__ void glds16s(const void* sbase, unsigned voff, unsigned lds_dst) { unsigned keep;
    asm volatile("s_mov_b32 %0, m0\n\ts_mov_b32 m0, %3\n\ts_nop 0\n\tglobal_load_lds_dwordx4 %1, %2 offset:%c4\n\ts_mov_b32 m0, %0" : "=&s"(keep) : "v"(voff), "s"(sbase), "s"(lds_dst), "i"(IMM) : "memory"); }
#define LDS_WAIT() asm volatile("s_waitcnt lgkmcnt(0)" ::: "memory")
#define VM_WAIT() asm volatile("s_waitcnt vmcnt(0)" ::: "memory")

namespace pg8 {
constexpr int BM = 256, BK = 64, HALF = 128, HTB = HALF * BK * 2, NXCD = 8, WGM = 8;
__host__ __device__ __forceinline__ int lds_byte(int r, int c) { const int x = (-(r >> 2)) & 3; return (r >> 3) * 1024 + (c >> 5) * 512 + (r & 7) * 64 + (((((c >> 3) & 3) ^ x)) << 4) + (c & 7) * 2; }
__host__ __device__ __forceinline__ void stage_rc(int b, int& R, int& C) { const int blk = b / 1024, i = (b % 1024) / 16; R = blk * 8 + ((i & 31) >> 2); const int x = (-(R >> 2)) & 3; C = ((i >> 5) * 4 + ((i & 3) ^ x)) * 8 + (b % 16) / 2; }
__host__ __device__ __forceinline__ int perm32(int rho) { const int n = rho >> 4, i = rho & 15; return 8 * (i >> 2) + 4 * n + (i & 3); }

struct Unit { int pm, pn, z; };
struct Gemm { const char* A; const char* B; int lda, ldb, K; size_t zA, zB; };
__device__ __forceinline__ const char* a_base(const Gemm& g, const Unit& u) { return g.A + (size_t)u.pm * 256 * g.lda * 2 + (size_t)u.z * g.zA; }
__device__ __forceinline__ const char* b_base(const Gemm& g, const Unit& u) { return g.B + (size_t)u.pn * 256 * g.ldb * 2 + (size_t)u.z * g.zB; }

template <int NN, int NZ> struct Order {
    static constexpr int nM = M / BM, nN = NN, nwg = nM * nN, nz = NZ;
    int G, c, wave;
    __device__ void init(int G_, int c_, int wave_) { G = G_; c = c_; wave = wave_; }
    __device__ bool next(int i, Unit& u) const {
        const int t = i / NZ; u.z = i - t * NZ;
        const int L = t * G + c; if (L >= nwg) return false;
        static_assert(nwg % NXCD == 0 && nM % WGM == 0, "tile counts");
        int wgid = L; { constexpr int q = nwg / NXCD; const int xcd = wgid % NXCD, off = wgid / NXCD; wgid = xcd * q + off; }
        constexpr int nig = WGM * nN; const int gid = wgid / nig, fm = gid * WGM, w = wgid - gid * nig;
        u.pm = fm + (w % WGM); u.pn = w / WGM; return true;
    }
};

template <class Epi, bool ALIGN_EPI, class Sched>
__device__ __forceinline__ void gemm_phase(LAS unsigned char* lds, const Gemm g, const Sched& S, const Epi& E) {
    const int tid = opaque_tid(S.wave), wid = S.wave, lane = tid & 63, wr = wid >> 2, wc = wid & 3, fr = lane & 15, fq = lane >> 4;
    const int nt = g.K / BK;
    unsigned voffA[2], voffB[2];
#pragma unroll
    for (int i = 0; i < 2; ++i) { int R, C; stage_rc(tid * 16 + i * 8192, R, C); const int Rb = Epi::PERM ? ((R & ~31) + perm32(R & 31)) : R;
        voffA[i] = (unsigned)(R * g.lda + C) * 2u; voffB[i] = (unsigned)(Rb * g.ldb + C) * 2u; }
    const size_t kstep = (size_t)(BK * 2);
    const size_t hstepA = (size_t)HALF * g.lda * 2, hstepB = (size_t)HALF * g.ldb * 2;
    const unsigned ldsw = (unsigned)wid * 1024u; const unsigned ldsb = (unsigned)(size_t)lds;
    const int aoff = lds_byte(wr * 64 + fr, fq * 8), boff = lds_byte(wc * 32 + fr, fq * 8);
#define PG8_SA(b, h) (((b) * 2 + (h)) * HTB)
#define PG8_SB(b, h) ((4 + (b) * 2 + (h)) * HTB)
#define PG8_STAGE(bufoff, gbase, voff) do { _Pragma("unroll") for (int _i = 0; _i < 2; ++_i) \
        glds16s<0>(uni((const char*)(gbase)), (voff)[_i], (unsigned)__builtin_amdgcn_readfirstlane((int)(ldsb + (bufoff) + ldsw + _i * 8192))); } while (0)
#define PG8_LDA(dst, b, h) do { _Pragma("unroll") for (int m = 0; m < 4; ++m) _Pragma("unroll") for (int k = 0; k < 2; ++k) dst[m][k] = *(const LAS bf16x8*)(lds + PG8_SA(b, h) + aoff + m * 2048 + k * 512); } while (0)
#define PG8_LDB(dst, b, h) do { _Pragma("unroll") for (int n = 0; n < 2; ++n) _Pragma("unroll") for (int k = 0; k < 2; ++k) dst[n][k] = *(const LAS bf16x8*)(lds + PG8_SB(b, h) + boff + n * 2048 + k * 512); } while (0)
#define PG8_MMA(ai, bj, At, Bt) do { __builtin_amdgcn_s_setprio(1); _Pragma("unroll") for (int m = 0; m < 4; ++m) _Pragma("unroll") for (int n = 0; n < 2; ++n) _Pragma("unroll") for (int k = 0; k < 2; ++k) \
        acc[ai][bj][m][n] = __builtin_amdgcn_mfma_f32_16x16x32_bf16(Bt[n][k], At[m][k], acc[ai][bj][m][n], 0, 0, 0); __builtin_amdgcn_s_setprio(0); } while (0)
#define PG8_WAIT_V(n) asm volatile("s_waitcnt vmcnt(" #n ")" ::: "memory")
#define PG8_WAIT_VN(n) asm volatile("s_waitcnt vmcnt(%0)" :: "n"(n) : "memory")
#define PG8_WAIT_L(n) asm volatile("s_waitcnt lgkmcnt(" #n ")" ::: "memory")
#define PG8_BAR __builtin_amdgcn_s_barrier()
#define PG8_SCHED __builtin_amdgcn_sched_barrier(0)
    Unit cur, nxt; int ui = 0;
    if (!S.next(0, cur)) return;
    f32x4 acc[2][2][4][2];
    if constexpr (Epi::CINIT) E.cinit(acc, cur, wr, wc, fr, fq);
    else {
#pragma unroll
    for (int a = 0; a < 2; ++a)
#pragma unroll
        for (int b = 0; b < 2; ++b)
#pragma unroll
            for (int m = 0; m < 4; ++m)
#pragma unroll
                for (int n = 0; n < 2; ++n) acc[a][b][m][n] = (f32x4){0.f, 0.f, 0.f, 0.f};
    }
    bf16x8 At[4][2], B0[2][2], B1[2][2];
    LAS float* rsl = (LAS float*)(lds + 132096) + (wid * 16 + fr) * 8;
    int cpm = -1;
    const char* cA = a_base(g, cur); const char* cB = b_base(g, cur);
    PG8_STAGE(PG8_SB(0, 0), cB, voffB); PG8_STAGE(PG8_SB(0, 1), cB + hstepB, voffB); PG8_STAGE(PG8_SA(0, 0), cA, voffA); PG8_STAGE(PG8_SA(0, 1), cA + hstepA, voffA);
    if (wr == 1) PG8_BAR;
    PG8_WAIT_V(2); PG8_BAR;
    PG8_STAGE(PG8_SB(1, 0), cB + kstep, voffB); PG8_STAGE(PG8_SA(1, 0), cA + kstep, voffA); PG8_STAGE(PG8_SB(1, 1), cB + hstepB + kstep, voffB);
    if constexpr (Epi::NST > 0) PG8_STAGE(PG8_SA(1, 1), cA + kstep + hstepA, voffA);
    PG8_WAIT_V(0); PG8_BAR;
    for (;;) {
        const bool has_next = S.next(ui + 1, nxt);
        const char* nA = has_next ? a_base(g, nxt) : cA; const char* nB = has_next ? b_base(g, nxt) : cB;
#define PG8_ITER(t, W123, S1) do { \
            const bool last = ((t) == nt - 2); \
            const char* a1 = cA + (size_t)((t) + 1) * kstep; \
            const char* a2 = last ? nA : cA + (size_t)((t) + 2) * kstep; const char* b2 = last ? nB : cB + (size_t)((t) + 2) * kstep; \
            const char* a3 = a2 + kstep; const char* b3 = b2 + kstep; \
            PG8_LDB(B0, 0, 0); PG8_LDB(B1, 0, 1); PG8_SCHED; PG8_LDA(At, 0, 0); if (S1) PG8_STAGE(PG8_SA(1, 1), a1 + hstepA, voffA); \
            PG8_WAIT_VN(W123); PG8_WAIT_L(0); PG8_BAR; PG8_MMA(0, 0, At, B0); PG8_MMA(0, 1, At, B1); PG8_BAR; PG8_SCHED; \
            PG8_LDA(At, 0, 1); PG8_STAGE(PG8_SB(0, 0), b2, voffB); PG8_STAGE(PG8_SB(0, 1), b2 + hstepB, voffB); PG8_STAGE(PG8_SA(0, 0), a2, voffA); \
            PG8_WAIT_VN(W123); PG8_WAIT_L(0); PG8_BAR; PG8_MMA(1, 0, At, B0); PG8_MMA(1, 1, At, B1); PG8_BAR; PG8_SCHED; \
            PG8_LDB(B0, 1, 0); PG8_LDB(B1, 1, 1); PG8_SCHED; PG8_LDA(At, 1, 0); PG8_STAGE(PG8_SA(0, 1), a2 + hstepA, voffA); \
            PG8_WAIT_VN(W123); PG8_WAIT_L(0); PG8_BAR; PG8_MMA(0, 0, At, B0); PG8_MMA(0, 1, At, B1); PG8_BAR; PG8_SCHED; \
            PG8_LDA(At, 1, 1); PG8_STAGE(PG8_SB(1, 0), b3, voffB); PG8_STAGE(PG8_SB(1, 1), b3 + hstepB, voffB); PG8_STAGE(PG8_SA(1, 0), a3, voffA); \
            PG8_WAIT_V(8); PG8_WAIT_L(0); PG8_BAR; PG8_MMA(1, 0, At, B0); PG8_MMA(1, 1, At, B1); PG8_BAR; PG8_SCHED; \
        } while (0)
        if constexpr (Epi::NST > 0) { PG8_ITER(0, 8 + Epi::NST, false); for (int t = 2; t < nt; t += 2) PG8_ITER(t, 8, true); PG8_STAGE(PG8_SA(1, 1), nA + kstep + hstepA, voffA); }
        else { for (int t = 0; t < nt; t += 2) PG8_ITER(t, 8, true); }
#undef PG8_ITER
        if constexpr (ALIGN_EPI) { if (wr == 0) PG8_BAR; }
        if constexpr (Epi::RSTD) {
            if (cur.pm != cpm) { cpm = cur.pm; E.rs_fill(cur, wr, fr, fq, rsl); }
            float rs[2][4]; { const f32x4 a0 = *(const LAS f32x4*)rsl, a1 = *(const LAS f32x4*)(rsl + 4); rs[0][0] = a0[0]; rs[0][1] = a0[1]; rs[0][2] = a0[2]; rs[0][3] = a0[3]; rs[1][0] = a1[0]; rs[1][1] = a1[1]; rs[1][2] = a1[2]; rs[1][3] = a1[3]; }
            E(acc, cur, wr, wc, fr, fq, rs);
        } else { float rs[2][4]; E(acc, cur, wr, wc, fr, fq, rs); }
        if (!has_next) break;
        if constexpr (Epi::CINIT) E.cinit(acc, nxt, wr, wc, fr, fq);
        else {
#pragma unroll
        for (int a = 0; a < 2; ++a)
#pragma unroll
            for (int b = 0; b < 2; ++b)
#pragma unroll
                for (int m = 0; m < 4; ++m)
#pragma unroll
                    for (int n = 0; n < 2; ++n) acc[a][b][m][n] = (f32x4){0.f, 0.f, 0.f, 0.f};
        }
        cur = nxt; cA = nA; cB = nB; ++ui;
        if constexpr (ALIGN_EPI) { if (wr == 1) PG8_BAR; }
    }
    PG8_WAIT_V(0);
    if constexpr (!ALIGN_EPI) { if (wr == 0) PG8_BAR; }
    PG8_BAR;
#undef PG8_SA
#undef PG8_SB
#undef PG8_STAGE
#undef PG8_LDA
#undef PG8_LDB
#undef PG8_MMA
#undef PG8_WAIT_V
#undef PG8_WAIT_VN
#undef PG8_WAIT_L
#undef PG8_BAR
#undef PG8_SCHED
}

typedef f32x4 Acc[2][2][4][2];
__device__ __forceinline__ float row_rstd(const float* part, int row, int fq) {
    const f32x4 p = *(const f32x4*)(part + (size_t)row * 16 + 4 * fq);
    float s = (p[0] + p[1]) + (p[2] + p[3]);
    s = xadd<16>(s); s = xadd<32>(s);
    return __builtin_amdgcn_rsqf(s * (1.0f / DMODEL) + EPS);
}
__device__ __forceinline__ v4u pack8(const f32x4 a, const f32x4 b) { v4u w; w.x = pk2(a[0], a[1]); w.y = pk2(a[2], a[3]); w.z = pk2(b[0], b[1]); w.w = pk2(b[2], b[3]); return w; }

__device__ __forceinline__ void rstd_fill(const float* part, int row0, int fq, LAS float* rsl) {
#pragma unroll
    for (int i = 0; i < 8; i += 2) {
        const float r0 = row_rstd(part, row0 + (i >> 2) * HALF + (i & 3) * 16, fq), r1 = row_rstd(part, row0 + ((i + 1) >> 2) * HALF + ((i + 1) & 3) * 16, fq);
        if (fq == 0) { rsl[i] = r0; rsl[i + 1] = r1; }
        asm volatile("" ::: "memory");
    }
    asm volatile("s_waitcnt lgkmcnt(0)" ::: "memory");
}
__device__ __forceinline__ void rows_rstd(const float* part, int row0, int fq, float (&rs)[2][4]) {
#pragma unroll
    for (int ai = 0; ai < 2; ++ai)
#pragma unroll
        for (int m = 0; m < 4; ++m) rs[ai][m] = row_rstd(part, row0 + ai * HALF + m * 16, fq);
}
struct EpiSwiGLU {
    static constexpr bool PERM = true; static constexpr bool CINIT = false; static constexpr int NST = 8;
    bf16* H; const float* ssq;
    static constexpr bool RSTD = true;
    __device__ __forceinline__ void rs_fill(const Unit& u, int wr, int fr, int fq, LAS float* rsl) const { rstd_fill(ssq, u.pm * BM + wr * 64 + fr, fq, rsl); }
    __device__ __forceinline__ void operator()(const Acc& acc, const Unit& u, int wr, int wc, int fr, int fq, const float (&rsv)[2][4]) const {
        const int row0 = u.pm * BM + wr * 64 + fr, col0 = u.pn * 128 + wc * 32 + 8 * fq;
#pragma unroll
        for (int ai = 0; ai < 2; ++ai)
#pragma unroll
            for (int m = 0; m < 4; ++m) {
                const float rs = rsv[ai][m];
                f32x4 v0, v1;
#pragma unroll
                for (int j = 0; j < 4; ++j) { v0[j] = siluf_(acc[ai][0][m][0][j] * rs) * (acc[ai][1][m][0][j] * rs); v1[j] = siluf_(acc[ai][0][m][1][j] * rs) * (acc[ai][1][m][1][j] * rs); }
                *(v4u*)(H + (size_t)(row0 + ai * HALF + m * 16) * DFFP + col0) = pack8(v0, v1);
            }
    }
};
struct EpiResid {
    static constexpr bool PERM = true, RSTD = false, CINIT = true; static constexpr int NST = 0;
    bf16* xb; float scale, iscale; bool dry; float* ssq;
    __device__ __forceinline__ void cinit(Acc& acc, const Unit& u, int wr, int wc, int fr, int fq) const {
        const int row0 = u.pm * BM + wr * 64 + fr, col0 = u.pn * BM + wc * 32 + 8 * fq;
#pragma unroll
        for (int ai = 0; ai < 2; ++ai)
#pragma unroll
            for (int m = 0; m < 4; ++m) { const size_t off = (size_t)(row0 + ai * HALF + m * 16) * DMODEL + col0;
#pragma unroll
                for (int bj = 0; bj < 2; ++bj) { const v4u w = *(const v4u*)(xb + off + bj * HALF);
                    acc[ai][bj][m][0] = (f32x4){bflo(w.x), bfhi(w.x), bflo(w.y), bfhi(w.y)} * iscale; acc[ai][bj][m][1] = (f32x4){bflo(w.z), bfhi(w.z), bflo(w.w), bfhi(w.w)} * iscale; } }
    }
    __device__ __forceinline__ void operator()(const Acc& acc, const Unit& u, int wr, int wc, int fr, int fq, const float (&)[2][4]) const {
        const int row0 = u.pm * BM + wr * 64 + fr, col0 = u.pn * BM + wc * 32 + 8 * fq;
#pragma unroll
        for (int ai = 0; ai < 2; ++ai)
#pragma unroll
            for (int m = 0; m < 4; ++m) { const int row = row0 + ai * HALF + m * 16; const size_t off = (size_t)row * DMODEL + col0; float ss = 0.f;
#pragma unroll
                for (int bj = 0; bj < 2; ++bj) {
                    const f32x4 v0 = acc[ai][bj][m][0] * scale, v1 = acc[ai][bj][m][1] * scale;
                    ss += (v0[0] * v0[0] + v0[1] * v0[1]) + (v0[2] * v0[2] + v0[3] * v0[3]) + (v1[0] * v1[0] + v1[1] * v1[1]) + (v1[2] * v1[2] + v1[3] * v1[3]);
                    if (!dry) *(v4u*)(xb + off + bj * HALF) = pack8(v0, v1); }
                ss = xadd<16>(ss); ss = xadd<32>(ss);
                if (fq == 0 && !dry) ssq[(size_t)row * 16 + u.pn * 4 + wc] = ss; }
    }
};
struct EpiInProj {
    static constexpr bool PERM = true; static constexpr bool CINIT = false; static constexpr int NST = 16;
    bf16* P; const float* rope; const float* la_bias; const float* ssq;
    static constexpr bool RSTD = true;
    __device__ __forceinline__ void rs_fill(const Unit& u, int wr, int fr, int fq, LAS float* rsl) const { rstd_fill(ssq, u.pm * BM + wr * 64 + fr, fq, rsl); }
    __device__ __forceinline__ void operator()(const Acc& acc, const Unit& u, int wr, int wc, int fr, int fq, const float (&rsv)[2][4]) const {
        const int row0 = u.pm * BM + wr * 64 + fr; const int pn = u.pn;
        if (pn == 10 || pn == 11) {
            const float sc = (pn == 11) ? 0.125f : 1.0f;
#pragma unroll
            for (int ai = 0; ai < 2; ++ai)
#pragma unroll
                for (int m = 0; m < 4; ++m) { const int row = row0 + ai * HALF + m * 16; const int pos = row & (SEQ - 1); const float rs = rsv[ai][m] * sc;
                    const f32x4* cs = (const f32x4*)(rope + ((size_t)pos * 32 + 8 * fq) * 2);
                    f32x4 o1[2], o2[2];
#pragma unroll
                    for (int n = 0; n < 2; ++n) { const f32x4 c01 = cs[2 * n], c23 = cs[2 * n + 1];
                        const float co[4] = {c01[0], c01[2], c23[0], c23[2]}, si[4] = {c01[1], c01[3], c23[1], c23[3]};
#pragma unroll
                        for (int j = 0; j < 4; ++j) { const float t1 = acc[ai][0][m][n][j], t2 = acc[ai][1][m][n][j]; o1[n][j] = (t1 * co[j] - t2 * si[j]) * rs; o2[n][j] = (t1 * si[j] + t2 * co[j]) * rs; } }
                    bf16* rowp = P + (size_t)row * PJ + pn * BM + wc * 64 + 8 * fq;
                    *(v4u*)(rowp) = pack8(o1[0], o1[1]); *(v4u*)(rowp + 32) = pack8(o2[0], o2[1]); }
            return;
        }
        const int col0 = pn * BM + wc * 32 + 8 * fq;
        if (pn == 18) {
            f32x4 bv[2][2];
            int bo = wc * 32 + 8 * fq; asm volatile("" : "+v"(bo));
#pragma unroll
            for (int bj = 0; bj < 2; ++bj)
#pragma unroll
                for (int n = 0; n < 2; ++n) bv[bj][n] = *(const f32x4*)(la_bias + bo + bj * HALF + 4 * n);
#pragma unroll
            for (int ai = 0; ai < 2; ++ai)
#pragma unroll
                for (int m = 0; m < 4; ++m) { bf16* rowp = P + (size_t)(row0 + ai * HALF + m * 16) * PJ + col0; const float rs = rsv[ai][m];
#pragma unroll
                    for (int bj = 0; bj < 2; ++bj) { f32x4 v[2];
#pragma unroll
                        for (int n = 0; n < 2; ++n)
#pragma unroll
                            for (int j = 0; j < 4; ++j) { const float x = acc[ai][bj][m][n][j] * rs + bv[bj][n][j]; v[n][j] = (fminf(x, 0.f) - 0.6931471805599453f * __builtin_amdgcn_logf(1.0f + fast_exp2(-1.4426950408889634f * fabsf(x)))) * (1.0f / 16.0f); }
                        *(v4u*)(rowp + bj * HALF) = pack8(v[0], v[1]); } }
            return;
        }
        const bool silu = (pn >= 2 && pn <= 5);
        const float sc = (pn <= 1) ? C2 : (pn == 14 ? 0.125f : 1.0f);
#pragma unroll
        for (int ai = 0; ai < 2; ++ai)
#pragma unroll
            for (int m = 0; m < 4; ++m) { bf16* rowp = P + (size_t)(row0 + ai * HALF + m * 16) * PJ + col0; const float rs = rsv[ai][m] * sc;
#pragma unroll
                for (int bj = 0; bj < 2; ++bj) { f32x4 v0 = acc[ai][bj][m][0] * rs, v1 = acc[ai][bj][m][1] * rs;
                    if (silu) {
#pragma unroll
                        for (int j = 0; j < 4; ++j) { v0[j] = siluf_(v0[j]); v1[j] = siluf_(v1[j]); } }
                    *(v4u*)(rowp + bj * HALF) = pack8(v0, v1); } }
    }
};
struct EpiGates {
    static constexpr bool PERM = true; static constexpr bool CINIT = false; static constexpr int NST = 16;
    bf16* P; const float* ssq;
    static constexpr bool RSTD = true;
    __device__ __forceinline__ void rs_fill(const Unit& u, int wr, int fr, int fq, LAS float* rsl) const { rstd_fill(ssq, u.pm * BM + wr * 64 + fr, fq, rsl); }
    __device__ __forceinline__ void operator()(const Acc& acc, const Unit& u, int wr, int wc, int fr, int fq, const float (&rsv)[2][4]) const {
        const int row0 = u.pm * BM + wr * 64 + fr, col0 = C_GATE + u.pn * BM + wc * 32 + 8 * fq;
#pragma unroll
        for (int ai = 0; ai < 2; ++ai)
#pragma unroll
            for (int m = 0; m < 4; ++m) { bf16* rowp = P + (size_t)(row0 + ai * HALF + m * 16) * PJ + col0; const float rs = rsv[ai][m];
#pragma unroll
                for (int bj = 0; bj < 2; ++bj) { f32x4 v0, v1;
#pragma unroll
                    for (int j = 0; j < 4; ++j) { v0[j] = sigmoidf_(acc[ai][bj][m][0][j] * rs); v1[j] = sigmoidf_(acc[ai][bj][m][1][j] * rs); }
                    *(v4u*)(rowp + bj * HALF) = pack8(v0, v1); } }
    }
};
struct EpiMerge {
    static constexpr bool PERM = true; static constexpr bool CINIT = false; static constexpr int NST = 16;
    const bf16* P; bf16* O;
    static constexpr bool RSTD = false;
    __device__ __forceinline__ void operator()(const Acc& acc, const Unit& u, int wr, int wc, int fr, int fq, const float (&)[2][4]) const {
        const int row0 = u.pm * BM + wr * 64 + fr, col0 = u.pn * BM + wc * 32 + 8 * fq, gcol0 = C_GATE + u.z * DMODEL + col0;
        const bool add = u.z > 0;
#pragma unroll
        for (int ai = 0; ai < 2; ++ai) {
            v4u gw[4][2], pw[4][2];
#pragma unroll
            for (int m = 0; m < 4; ++m)
#pragma unroll
                for (int bj = 0; bj < 2; ++bj) { const size_t row = (size_t)(row0 + ai * HALF + m * 16);
                    gw[m][bj] = *(const v4u*)(P + row * PJ + gcol0 + bj * HALF);
                    pw[m][bj] = add ? *(const v4u*)(O + row * DMODEL + col0 + bj * HALF) : (v4u){0u, 0u, 0u, 0u}; }
#pragma unroll
            for (int m = 0; m < 4; ++m)
#pragma unroll
                for (int bj = 0; bj < 2; ++bj) { const size_t row = (size_t)(row0 + ai * HALF + m * 16);
                    const v4u g = gw[m][bj], p = pw[m][bj];
                    f32x4 v0 = acc[ai][bj][m][0], v1 = acc[ai][bj][m][1];
                    v0[0] = v0[0] * bflo(g.x) + bflo(p.x); v0[1] = v0[1] * bfhi(g.x) + bfhi(p.x); v0[2] = v0[2] * bflo(g.y) + bflo(p.y); v0[3] = v0[3] * bfhi(g.y) + bfhi(p.y);
                    v1[0] = v1[0] * bflo(g.z) + bflo(p.z); v1[1] = v1[1] * bfhi(g.z) + bfhi(p.z); v1[2] = v1[2] * bflo(g.w) + bflo(p.w); v1[3] = v1[3] * bfhi(g.w) + bfhi(p.w);
                    *(v4u*)(O + row * DMODEL + col0 + bj * HALF) = pack8(v0, v1); }
        }
    }
};
}

#define XB_TMO      128
#define XB_XCNT(j)  (256  + 64 * (j))
#define XB_XSUB(j)  (1280 + 64 * (j))
#define XB_XGEN(j)  (2304 + 64 * (j))
#define XB_TOP      3328
#define XB_TOPGEN   3392
#define XCD_BAR_WORDS 3456
#define XB_SPIN_CAP (1u << 23)
__device__ __forceinline__ unsigned xb_ld(unsigned* p)              { return __hip_atomic_load(p, __ATOMIC_RELAXED, __HIP_MEMORY_SCOPE_AGENT); }
__device__ __forceinline__ unsigned xb_add(unsigned* p, unsigned v) { return __hip_atomic_fetch_add(p, v, __ATOMIC_RELAXED, __HIP_MEMORY_SCOPE_AGENT); }
__device__ __forceinline__ unsigned xb_xcc_id() { return (unsigned)__builtin_amdgcn_s_getreg((3 << 11) | 20) & 0xFu; }
#define XB_SPIN(cond, bar) do { unsigned _sp = 0; while (cond) { __builtin_amdgcn_s_sleep(1); \
    if ((++_sp & 255u) == 0u) { if (xb_ld(&(bar)[XB_TMO])) break; if (_sp > XB_SPIN_CAP) { atomicAdd(&(bar)[XB_TMO], 1u); break; } } } } while (0)
struct XcdBarrier { unsigned* bar; unsigned x; volatile LAS unsigned* st; };
__device__ __forceinline__ XcdBarrier xcd_barrier_post(unsigned* bar, volatile LAS unsigned* st) {
    XcdBarrier b; b.bar = bar; b.x = xb_xcc_id(); b.st = st;
    if (threadIdx.x == 0) (void)xb_add(&bar[XB_XCNT(b.x)], 1u);
    return b;
}
__device__ __forceinline__ void xcd_barrier_complete(unsigned* bar, unsigned x, unsigned& nloc, unsigned& nx) {
    const unsigned G = gridDim.x * gridDim.y * gridDim.z;
    unsigned sum, cnt, mine, sp = 0u;
    for (;;) {
        sum = 0u; cnt = 0u; mine = 0u;
#pragma unroll
        for (unsigned j = 0; j < 16; ++j) { const unsigned c = xb_ld(&bar[XB_XCNT(j)]); sum += c; cnt += (c > 0u) ? 1u : 0u; mine = (j == x) ? c : mine; }
        if (sum == G) break;
        __builtin_amdgcn_s_sleep(1);
        if ((++sp & 255u) == 0u) { if (xb_ld(&bar[XB_TMO])) break; if (sp > XB_SPIN_CAP) { atomicAdd(&bar[XB_TMO], 1u); break; } }
    }
    nloc = mine > 0u ? mine : 1u; nx = cnt > 0u ? cnt : 1u;
}
__device__ __forceinline__ void xcd_barrier(const XcdBarrier& b) {
    asm volatile("s_waitcnt vmcnt(0)" ::: "memory");
    __syncthreads();
    if (threadIdx.x == 0) {
        unsigned* bar = b.bar;
        __builtin_amdgcn_s_waitcnt(0);
        unsigned nloc = b.st[0], nx = b.st[1];
        if (nloc == 0u) { xcd_barrier_complete(bar, b.x, nloc, nx); b.st[0] = nloc; b.st[1] = nx; }
        const unsigned old = xb_add(&bar[XB_XSUB(b.x)], 1u);
        const unsigned gen = old / nloc;
        if (old + 1u == (gen + 1u) * nloc) {
            __builtin_amdgcn_fence(__ATOMIC_RELEASE, "agent");
            asm volatile("s_waitcnt vmcnt(0)" ::: "memory");
            const unsigned og = xb_add(&bar[XB_TOP], 1u);
            const unsigned tg = og / nx;
            if (og + 1u == (tg + 1u) * nx) xb_add(&bar[XB_TOPGEN], 1u);
            else XB_SPIN(xb_ld(&bar[XB_TOPGEN]) == tg, bar);
            __builtin_amdgcn_fence(__ATOMIC_ACQUIRE, "agent");
            xb_add(&bar[XB_XGEN(b.x)], 1u);
            asm volatile("s_waitcnt vmcnt(0)" ::: "memory");
        } else {
            XB_SPIN(xb_ld(&bar[XB_XGEN(b.x)]) == gen, bar);
            __builtin_amdgcn_fence(__ATOMIC_ACQUIRE, "agent");
            asm volatile("s_waitcnt vmcnt(0)" ::: "memory");
        }
    }
    __syncthreads();
}

struct Args {
    const float* x; const float* ffn1_norm; const float* ffn1_w1; const float* ffn1_w3; const float* ffn1_w2; const float* mix_norm; const float* w_in; const float* lam_qk;
    const float* da_norm; const float* ret_norm; const float* gla_a2; const float* gla_ab; const float* gla_norm; const float* wb_a; const float* wb_b; const float* wb_c; const float* w_out;
    const float* ffn2_norm; const float* ffn2_w1; const float* ffn2_w3; const float* ffn2_w2; const float* final_norm;
    float* out; unsigned char* ws; int ph_lo, ph_hi;
};
struct Frame { LAS unsigned char* lds; unsigned char* ws; int vcu, G, wave; };

__device__ __constant__ float LAM_INIT[4] = {0.2f, 0.35550906759f, 0.47071301834f, 0.55605820416f};

__device__ __forceinline__ void conv_tr(const float* src, int ldsrc, bf16* dst, int lddst, LAS float* scr, int lane, bool zero, const float* gain = nullptr) {
    if (zero) {
        const int c = lane & 7;
#pragma unroll
        for (int j = 0; j < 4; ++j) { const int n = (lane >> 3) + 8 * j; *(v4u*)(dst + (size_t)n * lddst + 8 * c) = (v4u){0u, 0u, 0u, 0u}; }
        return;
    }
    float tv[32];
#pragma unroll
    for (int i = 0; i < 32; ++i) tv[i] = src[(size_t)(2 * i + (lane >> 5)) * ldsrc + (lane & 31)];
#pragma unroll
    for (int i = 0; i < 32; ++i) { const int kk = 2 * i + (lane >> 5); const float gk = gain ? gain[kk] : 1.0f; scr[kk * 33 + (lane & 31)] = tv[i] * gk; }
    LDS_WAIT(); asm volatile("" ::: "memory");
    const int c = lane & 7;
#pragma unroll
    for (int j = 0; j < 4; ++j) { const int n = (lane >> 3) + 8 * j; const LAS float* s = scr + (8 * c) * 33 + n;
        v4u o; o.x = pk2(s[0 * 33], s[1 * 33]); o.y = pk2(s[2 * 33], s[3 * 33]); o.z = pk2(s[4 * 33], s[5 * 33]); o.w = pk2(s[6 * 33], s[7 * 33]);
        *(v4u*)(dst + (size_t)n * lddst + 8 * c) = o; }
    LDS_WAIT(); asm volatile("" ::: "memory");
}
__device__ __forceinline__ int inproj_src_col(int g) {
    const int c = 32 * g;
    if (c < 512) return O_AQ + c;
    if (c < 1024) return O_RG + (c - 512);
    if (c < 1536) return O_CG + (c - 1024);
    if (c < 2048) return O_AK + (c - 1536);
    if (c < 2560) return O_AV + (c - 2048);
    if (c < 3072) { const int base = (c < 2816) ? O_RQ : O_RK; const int cc = (c < 2816) ? c - 2560 : c - 2816; const int half = cc >> 7, head = (cc & 127) >> 5; return base + head * 64 + 32 * half; }
    if (c < 3584) return O_RV + (c - 3072);
    if (c < 3840) return O_CQ + (c - 3584);
    if (c < 4096) return O_CK + (c - 3840);
    return O_CV + (c - 4096);
}
constexpr int I_W13 = 16 * 176, I_W2 = 44 * 32, I_WIN = 16 * 144, I_WG = 16 * 96, I_WB = 8 * 32, I_WO = 16 * 32, I_LA = 16 * 8;
constexpr int I_TOTAL = 2 * (I_W13 + I_W2) + I_WIN + I_WG + 3 * I_WB + I_WO + I_LA;

__device__ __forceinline__ void conv_w13(const float* w1, const float* w3, bf16* dst, int r, LAS float* scr, int lane, const float* gain) {
    const int kb = r / 176, g = r % 176, pn = g >> 3, half = (g >> 2) & 1, jj = g & 3, hc0 = pn * 128 + jj * 32;
    const float* src = (half ? w3 : w1) + (size_t)(64 * kb) * DFF + hc0;
    conv_tr(src, DFF, dst + (size_t)(32 * g) * DMODEL + 64 * kb, DMODEL, scr, lane, hc0 >= DFF, gain + 64 * kb);
}
__device__ __forceinline__ void conv_w2(const float* w2, bf16* dst, int r, LAS float* scr, int lane) {
    const int kb = r / 32, nb = r % 32;
    conv_tr(w2 + (size_t)(64 * kb) * DMODEL + 32 * nb, DMODEL, dst + (size_t)(32 * nb) * DFFP + 64 * kb, DFFP, scr, lane, kb >= 43);
}

__device__ __forceinline__ void phase_conv(const Args& a, const Frame& F, int l) {
    unsigned char* ws = F.ws;
    const int tid = opaque_tid(F.wave), lane = tid & 63, wave = F.wave;
    LAS float* scr = (LAS float*)(F.lds + wave * 16384);
    const int gw = F.vcu * 8 + wave, NGW = F.G * 8;
    const float* w1a = uni(a.ffn1_w1) + (size_t)l * DMODEL * DFF; const float* w3a = uni(a.ffn1_w3) + (size_t)l * DMODEL * DFF; const float* w2a = uni(a.ffn1_w2) + (size_t)l * DFF * DMODEL;
    const float* w1b = uni(a.ffn2_w1) + (size_t)l * DMODEL * DFF; const float* w3b = uni(a.ffn2_w3) + (size_t)l * DMODEL * DFF; const float* w2b = uni(a.ffn2_w2) + (size_t)l * DFF * DMODEL;
    const float* win = uni(a.w_in) + (size_t)l * DMODEL * INC;
    const float* g1 = uni(a.ffn1_norm) + l * DMODEL; const float* g2 = uni(a.ffn2_norm) + l * DMODEL; const float* gm = uni(a.mix_norm) + l * DMODEL;
    for (int it = gw; it < I_TOTAL - I_LA; it += NGW) {
        int r = it;
        if (r < I_W13) { conv_w13(w1a, w3a, (bf16*)(ws + W_13A), r, scr, lane, g1); continue; } r -= I_W13;
        if (r < I_W2) { conv_w2(w2a, (bf16*)(ws + W_2A), r, scr, lane); continue; } r -= I_W2;
        if (r < I_W13) { conv_w13(w1b, w3b, (bf16*)(ws + W_13B), r, scr, lane, g2); continue; } r -= I_W13;
        if (r < I_W2) { conv_w2(w2b, (bf16*)(ws + W_2B), r, scr, lane); continue; } r -= I_W2;
        if (r < I_WIN) { const int kb = r / 144, g = r % 144;
            conv_tr(win + (size_t)(64 * kb) * INC + inproj_src_col(g), INC, (bf16*)(ws + W_IN) + (size_t)(32 * g) * DMODEL + 64 * kb, DMODEL, scr, lane, false, gm + 64 * kb); continue; } r -= I_WIN;
        if (r < I_WG) { const int kb = r / 96, g = r % 96;
            conv_tr(win + (size_t)(64 * kb) * INC + O_GATE + 32 * g, INC, (bf16*)(ws + W_G) + (size_t)(32 * g) * DMODEL + 64 * kb, DMODEL, scr, lane, false, gm + 64 * kb); continue; } r -= I_WG;
        if (r < 3 * I_WB) { const int z = r / I_WB, rr = r % I_WB, kb = rr / 32, nb = rr % 32;
            const float* wb = uni(z == 0 ? a.wb_a : (z == 1 ? a.wb_b : a.wb_c)) + (size_t)l * 512 * DMODEL;
            conv_tr(wb + (size_t)(64 * kb) * DMODEL + 32 * nb, DMODEL, (bf16*)(ws + W_B) + (size_t)z * DMODEL * 512 + (size_t)(32 * nb) * 512 + 64 * kb, 512, scr, lane, false); continue; } r -= 3 * I_WB;
        if (r < I_WO) { const int kb = r / 32, nb = r % 32;
            conv_tr(uni(a.w_out) + (size_t)l * DMODEL * DMODEL + (size_t)(64 * kb) * DMODEL + 32 * nb, DMODEL, (bf16*)(ws + W_O) + (size_t)(32 * nb) * DMODEL + 64 * kb, DMODEL, scr, lane, false); continue; } r -= I_WO;
    }
    for (int r = gw; r < I_LA; r += NGW) {
            const int kb = r / 8, cb = r % 8, c8 = lane & 7; const float* a2 = uni(a.gla_a2) + (size_t)l * 16 * 256;
            const float* wrow = win + (size_t)(64 * kb + 8 * c8) * INC + O_CA;
#pragma unroll 1
            for (int j = 0; j < 4; ++j) { const int c = 32 * cb + (lane >> 3) + 8 * j;
                float av[16];
#pragma unroll
                for (int t = 0; t < 16; ++t) av[t] = a2[t * 256 + c];
                float o[8];
#pragma unroll
                for (int q = 0; q < 8; ++q) {
                    float acc = 0.f;
#pragma unroll
                    for (int t4 = 0; t4 < 4; ++t4) { const f32x4 w4 = *(const f32x4*)(wrow + (size_t)q * INC + 4 * t4);
                        acc += (w4[0] * av[4 * t4] + w4[1] * av[4 * t4 + 1]) + (w4[2] * av[4 * t4 + 2] + w4[3] * av[4 * t4 + 3]); }
                    o[q] = acc * gm[64 * kb + 8 * c8 + q]; }
                v4u w; w.x = pk2(o[0], o[1]); w.y = pk2(o[2], o[3]); w.z = pk2(o[4], o[5]); w.w = pk2(o[6], o[7]);
                *(v4u*)((bf16*)(ws + W_IN) + (size_t)(C_LA + c) * DMODEL + 64 * kb + 8 * c8) = w; }
    }
    if (blockIdx.x == 0 && wave == 0) {
        const float* lq = uni(a.lam_qk) + (size_t)l * 256;
        const float s1 = wave_sum(lq[lane] * lq[64 + lane]), s2 = wave_sum(lq[128 + lane] * lq[192 + lane]);
        if (lane == 0) ((float*)(ws + WS_LAM))[l] = __expf(s1) - __expf(s2) + LAM_INIT[l];
    }
}

__device__ __forceinline__ void phase_rope(const Frame& F) {
    const int tid = opaque_tid(F.wave);
    float* rt = (float*)(F.ws + WS_ROPE);
    for (int idx = F.vcu * 512 + tid; idx < SEQ * 32; idx += F.G * 512) {
        const int pos = idx >> 5, i = idx & 31;
        const float inv = exp2f(-(float)i * (13.287712379549449f / 32.0f));
        const float ang = (float)pos * inv;
        double rev = (double)ang * 0.15915494309189535; rev -= floor(rev);
        const float rf = (float)rev;
        rt[2 * idx] = __builtin_amdgcn_cosf(rf); rt[2 * idx + 1] = __builtin_amdgcn_sinf(rf);
    }
}
__device__ __forceinline__ void phase_prep(const Frame& F, const float* x, bf16* xb, float* ssq) {
    const int tid = opaque_tid(F.wave), lane = tid & 63, wave = F.wave;
    const int gw = F.vcu * 8 + wave, NGW = F.G * 8;
    for (int m = gw; m < M; m += NGW) {
        const f32x4* xr = (const f32x4*)(x + (size_t)m * DMODEL) + lane;
        f32x4 v[4]; float s = 0.f;
#pragma unroll
        for (int j = 0; j < 4; ++j) { v[j] = xr[64 * j]; s += (v[j][0] * v[j][0] + v[j][1] * v[j][1]) + (v[j][2] * v[j][2] + v[j][3] * v[j][3]); }
        s = wave_sum(s);
        v2u* o8 = (v2u*)(xb + (size_t)m * DMODEL) + lane;
#pragma unroll
        for (int j = 0; j < 4; ++j) { v2u w; w.x = pk2(v[j][0], v[j][1]); w.y = pk2(v[j][2], v[j][3]); o8[64 * j] = w; }
        if (lane < 16) ssq[(size_t)m * 16 + lane] = (lane == 0) ? s : 0.f;
    }
}
__device__ __forceinline__ void phase_final_norm(const Frame& F, const bf16* xb, float* out, const float* gain, const float* ssq) {
    const int tid = opaque_tid(F.wave), lane = tid & 63, wave = F.wave;
    const int gw = F.vcu * 8 + wave, NGW = F.G * 8;
    f32x4 g[4];
#pragma unroll
    for (int j = 0; j < 4; ++j) g[j] = *((const f32x4*)gain + lane + 64 * j);
    for (int m = gw; m < M; m += NGW) {
        const v2u* xr = (const v2u*)(xb + (size_t)m * DMODEL) + lane; f32x4* orow = (f32x4*)(out + (size_t)m * DMODEL) + lane;
        float sq = ssq[(size_t)m * 16 + (lane & 15)];
        sq = xadd<1>(sq); sq = xadd<2>(sq); sq = xadd<4>(sq); sq = xadd<8>(sq);
        const float rstd = __builtin_amdgcn_rsqf(sq * (1.0f / DMODEL) + EPS);
#pragma unroll
        for (int j = 0; j < 4; ++j) { const v2u w = xr[64 * j]; orow[64 * j] = (f32x4){bflo(w.x), bfhi(w.x), bflo(w.y), bfhi(w.y)} * rstd * g[j]; }
    }
}

__device__ __forceinline__ float ret_logg(int h) { return h == 0 ? -0.031748698314580301f : (h == 1 ? -0.015748356968139168f : (h == 2 ? -0.0078431774610258928f : -0.0039138993211363287f)); }

__device__ __forceinline__ void chunk_cum(LAS float* cum, LAS float* tot, const bf16* prow, int mix, int h, int tid) {
    const int d = tid & 63, seg = tid >> 6;
    if (mix == 0) {
        const float lg = ret_logg(h);
#pragma unroll
        for (int x = 0; x < 8; ++x) { const int t = seg * 8 + x; cum[t * 64 + d] = (float)(t + 1) * lg; }
        __syncthreads(); __syncthreads();
        return;
    }
    float run = 0.f;
#pragma unroll
    for (int x = 0; x < 8; ++x) { const int t = seg * 8 + x; run += bf2f(prow[(size_t)t * PJ + C_LA + h * 64 + d]); cum[t * 64 + d] = run; }
    tot[seg * 64 + d] = run;
    __syncthreads();
    float off = 0.f;
    for (int s = 0; s < seg; ++s) off += tot[s * 64 + d];
#pragma unroll
    for (int x = 0; x < 8; ++x) { const int t = seg * 8 + x; cum[t * 64 + d] += off; }
    __syncthreads();
}

__device__ __forceinline__ void phase_r2(const Args& a, const Frame& F) {
    unsigned char* ws = F.ws; unsigned* ST = (unsigned*)(ws + WS_ST); const float* DEC = (const float*)(ws + WS_DEC);
    const int tid = opaque_tid(F.wave);
    for (int gt = F.vcu * 512 + tid; gt < 32 * 4096; gt += F.G * 512) {
        const int w = gt & 4095, seq = gt >> 12, mix = seq >> 4, bh = seq & 15, h = bh & 3, d0 = (2 * w) & 63;
        unsigned* p = ST + (size_t)seq * 128 * 4096 + w;
        const float* dp = DEC + (size_t)bh * 128 * 64 + d0;
        float s0 = 0.f, s1 = 0.f;
        const float cret = __expf(64.0f * ret_logg(h));
        unsigned ua[8], ub[8]; f32x2 da[8], db[8];
#define R2_LOAD(uu, dd, n0_) do { _Pragma("unroll") for (int i = 0; i < 8; ++i) { uu[i] = p[(size_t)((n0_) + i) * 4096]; dd[i] = mix ? *(const f32x2*)(dp + (size_t)((n0_) + i) * 64) : (f32x2){cret, cret}; } } while (0)
#define R2_SCAN(uu, dd, n0_) do { _Pragma("unroll") for (int i = 0; i < 8; ++i) { p[(size_t)((n0_) + i) * 4096] = pk2(s0, s1); s0 = s0 * dd[i][0] + bflo(uu[i]); s1 = s1 * dd[i][1] + bfhi(uu[i]); } } while (0)
        R2_LOAD(ua, da, 0);
        for (int n0 = 0; n0 < 128; n0 += 16) {
            R2_LOAD(ub, db, n0 + 8);
            R2_SCAN(ua, da, n0);
            if (n0 + 16 < 128) R2_LOAD(ua, da, n0 + 16);
            R2_SCAN(ub, db, n0 + 8);
        }
#undef R2_LOAD
#undef R2_SCAN
    }
}

namespace lin {
typedef float f32x16 __attribute__((ext_vector_type(16)));
typedef short v4i16_t __attribute__((ext_vector_type(4)));
constexpr int L_V = 0, L_S = 16384, L_QE = 32768, L_KE = 40960, L_KD = 40960, L_CUM = 49152, L_TOT = 65536, L_OB = 67584, OB_LD = 132, L_SIN = 101376, L_QE2 = 117760;
__device__ __forceinline__ int crow(int r, int hi) { return (r & 3) + 8 * (r >> 2) + 4 * hi; }
__device__ __forceinline__ bf16x8 trfrag(const LAS unsigned char* p) {
    const v4i16_t lo = __builtin_amdgcn_ds_read_tr16_b64_v4i16((LAS v4i16_t*)(p)), hh = __builtin_amdgcn_ds_read_tr16_b64_v4i16((LAS v4i16_t*)(p + 512));
    return (bf16x8){lo[0], lo[1], lo[2], lo[3], hh[0], hh[1], hh[2], hh[3]};
}
__device__ __forceinline__ void unpack8(const v4u w, float (&f)[8]) { f[0] = bflo(w.x); f[1] = bfhi(w.x); f[2] = bflo(w.y); f[3] = bfhi(w.y); f[4] = bflo(w.z); f[5] = bfhi(w.z); f[6] = bflo(w.w); f[7] = bfhi(w.w); }
__device__ __forceinline__ v4u pack8f(const float (&f)[8]) { v4u w; w.x = pk2(f[0], f[1]); w.y = pk2(f[2], f[3]); w.z = pk2(f[4], f[5]); w.w = pk2(f[6], f[7]); return w; }
__device__ __forceinline__ void dma_v(LAS unsigned char* lds, const bf16* vbase, int wid, int lane) {
    const bf16* vsrc = vbase + (size_t)(16 * (wid & 3) + (lane >> 2)) * PJ + (wid >> 2) * 32 + (lane & 3) * 8;
    __builtin_amdgcn_global_load_lds((const unsigned*)(vsrc), (LAS unsigned*)(lds + L_V + wid * 1024), 16, 0, 0);
    __builtin_amdgcn_global_load_lds((const unsigned*)(vsrc + 64), (LAS unsigned*)(lds + L_V + wid * 1024 + 8192), 16, 0, 0);
}
}

struct RFetch { v4u qw, kw, g0, g1; f32x4 pn0, pn1; unsigned short la[8]; };
__device__ __forceinline__ void chunk_cum_regs(LAS float* cum, LAS float* tot, const unsigned short (&la)[8], int mix, int h, int tid) {
    const int d = tid & 63, seg = tid >> 6;
    if (mix == 0) {
        const float lg = ret_logg(h);
#pragma unroll
        for (int x = 0; x < 8; ++x) { const int t = seg * 8 + x; cum[t * 64 + d] = (float)(t + 1) * lg; }
        __syncthreads(); __syncthreads();
        return;
    }
    float run = 0.f;
#pragma unroll
    for (int x = 0; x < 8; ++x) { const int t = seg * 8 + x; run += bf2f(la[x]); cum[t * 64 + d] = run; }
    tot[seg * 64 + d] = run;
    __syncthreads();
    float off = 0.f;
    for (int s = 0; s < seg; ++s) off += tot[s * 64 + d];
#pragma unroll
    for (int x = 0; x < 8; ++x) { const int t = seg * 8 + x; cum[t * 64 + d] += off; }
    __syncthreads();
}

__device__ __forceinline__ void phase_r1_mfma(const Args& a, const Frame& F) {
    using namespace lin;
    unsigned char* ws = F.ws; const bf16* proj = (const bf16*)(ws + WS_BIG); bf16* ST = (bf16*)(ws + WS_ST); float* DEC = (float*)(ws + WS_DEC);
    bf16* TOT = (bf16*)(ws + WS_TOT); float* DR = (float*)(ws + WS_DR);
    const int tid = opaque_tid(F.wave), lane = tid & 63, wid = F.wave, r32 = lane & 31, hi = lane >> 5;
    LAS unsigned char* lds = F.lds; LAS float* cum = (LAS float*)(lds + L_CUM); LAS float* tot = (LAS float*)(lds + L_TOT);
    const int t = tid >> 3, c = tid & 7;
    const int eb = wid >> 1, db = wid & 1, dcol = 32 * db + r32;
#define R1_FETCH(u_, f_) do { const int mix_ = (u_) >> 11, bh_ = ((u_) >> 7) & 15, n_ = (u_) & 127, h_ = bh_ & 3; \
        const bf16* prow_ = proj + (size_t)((bh_ >> 2) * SEQ + n_ * 64) * PJ; \
        f_.kw = *(const v4u*)(prow_ + (size_t)t * PJ + (mix_ ? C_CK : C_RK) + h_ * 64 + 8 * c); \
        if (mix_) { _Pragma("unroll") for (int x = 0; x < 8; ++x) f_.la[x] = prow_[(size_t)((tid >> 6) * 8 + x) * PJ + C_LA + h_ * 64 + (tid & 63)]; } \
        dma_v(lds, prow_ + (mix_ ? C_CV : C_RV) + h_ * 128, wid, lane); } while (0)
    RFetch cur; cur.qw = cur.g0 = cur.g1 = (v4u){0u, 0u, 0u, 0u};
    int v = F.vcu;
    if (v < 256) R1_FETCH(v * 16, cur);
    for (; v < 256; v += F.G) {
        const int sq = v >> 3, run = v & 7, mix = sq >> 4, bh = sq & 15, h = bh & 3;
        const float cret = __expf(64.0f * ret_logg(h));
        f32x16 state; float pst = 1.0f;
#pragma unroll
        for (int r = 0; r < 16; ++r) state[r] = 0.f;
#pragma unroll 1
        for (int i = 0; i < 16; ++i) {
            const int u = v * 16 + i, n = run * 16 + i;
            chunk_cum_regs(cum, tot, cur.la, mix, h, tid);
            float kf[8]; unpack8(cur.kw, kf);
            { const f32x4 c0 = *(const LAS f32x4*)(cum + t * 64 + 8 * c), c1 = *(const LAS f32x4*)(cum + t * 64 + 8 * c + 4);
              const f32x4 l0 = *(const LAS f32x4*)(cum + 63 * 64 + 8 * c), l1 = *(const LAS f32x4*)(cum + 63 * 64 + 8 * c + 4);
#pragma unroll
              for (int j = 0; j < 4; ++j) { kf[j] *= __expf(l0[j] - c0[j]); kf[4 + j] *= __expf(l1[j] - c1[j]); } }
            *(LAS v4u*)(lds + L_KD + (c >> 2) * 4096 + t * 64 + (c & 3) * 16) = pack8f(kf);
            asm volatile("s_waitcnt vmcnt(0) lgkmcnt(0)" ::: "memory"); __builtin_amdgcn_s_barrier(); asm volatile("" ::: "memory");
            const LAS unsigned char* tp = lds + ((lane >> 4) & 1) * 32 + (lane & 3) * 8 + (4 * hi + ((lane & 15) >> 2)) * 64;
            f32x16 acc;
#pragma unroll
            for (int r = 0; r < 16; ++r) acc[r] = 0.f;
#pragma unroll
            for (int ks = 0; ks < 4; ++ks) acc = __builtin_amdgcn_mfma_f32_32x32x16_bf16(trfrag(tp + L_V + eb * 4096 + ks * 1024), trfrag(tp + L_KD + db * 4096 + ks * 1024), acc, 0, 0, 0);
            const float decv = mix ? __expf(cum[63 * 64 + dcol]) : cret;
            LDS_WAIT(); __builtin_amdgcn_s_barrier(); asm volatile("" ::: "memory");
            { const int un = (i < 15) ? u + 1 : (v + F.G) * 16; if (i < 15 || v + F.G < 256) R1_FETCH(un, cur); }
            {
                LAS unsigned char* sg = lds + L_OB + wid * 2048;
#pragma unroll
                for (int r = 0; r < 16; ++r) *(LAS unsigned short*)(sg + crow(r, hi) * 64 + r32 * 2) = (unsigned short)f2bf(state[r]);
                LDS_WAIT();
                bf16* st = ST + ((size_t)(sq * 128 + n)) * 8192 + (size_t)(32 * eb) * 64 + 32 * db;
#pragma unroll
                for (int j = 0; j < 2; ++j) { const int p = lane + 64 * j, row = p >> 2, c16 = p & 3;
                    *(v4u*)(st + row * 64 + 8 * c16) = *(const LAS v4u*)(sg + row * 64 + c16 * 16); }
            }
            if (mix == 1 && eb == 0 && hi == 0) DEC[(size_t)(bh * 128 + n) * 64 + dcol] = pst;
#pragma unroll
            for (int r = 0; r < 16; ++r) state[r] = state[r] * decv + acc[r];
            pst *= decv;
        }
        bf16* tt = TOT + ((size_t)(sq * 8 + run)) * 8192 + dcol;
#pragma unroll
        for (int r = 0; r < 16; ++r) tt[(32 * eb + crow(r, hi)) * 64] = (bf16)f2bf(state[r]);
        if (eb == 0 && hi == 0) DR[(size_t)(sq * 8 + run) * 64 + dcol] = pst;
    }
#undef R1_FETCH
}

__device__ __forceinline__ void phase_r3_mfma(const Args& a, const Frame& F, int l, bool dry) {
    using namespace lin;
    unsigned char* ws = F.ws; bf16* proj = (bf16*)(ws + WS_BIG); const bf16* ST = (const bf16*)(ws + WS_ST); const float* DEC = (const float*)(ws + WS_DEC);
    const bf16* TOT = (const bf16*)(ws + WS_TOT); const float* DR = (const float*)(ws + WS_DR);
    const int tid = opaque_tid(F.wave), lane = tid & 63, wid = F.wave, r32 = lane & 31, hi = lane >> 5;
    LAS unsigned char* lds = F.lds; LAS float* cum = (LAS float*)(lds + L_CUM); LAS float* tot = (LAS float*)(lds + L_TOT); LAS float* ob = (LAS float*)(lds + L_OB);
    const int t = tid >> 3, c = tid & 7;
#define R3_FETCH(u_, f_) do { const int mix_ = (u_) >> 11, bh_ = ((u_) >> 7) & 15, n_ = (u_) & 127, h_ = bh_ & 3; \
        const bf16* prow_ = proj + (size_t)((bh_ >> 2) * SEQ + n_ * 64) * PJ; \
        f_.qw = *(const v4u*)(prow_ + (size_t)t * PJ + (mix_ ? C_CQ : C_RQ) + h_ * 64 + 8 * c); f_.kw = *(const v4u*)(prow_ + (size_t)t * PJ + (mix_ ? C_CK : C_RK) + h_ * 64 + 8 * c); \
        if (mix_) { _Pragma("unroll") for (int x = 0; x < 8; ++x) f_.la[x] = prow_[(size_t)((tid >> 6) * 8 + x) * PJ + C_LA + h_ * 64 + (tid & 63)]; \
                    const f32x4* pp_ = (const f32x4*)(DEC + (size_t)(bh_ * 128 + n_) * 64 + 8 * c); f_.pn0 = pp_[0]; f_.pn1 = pp_[1]; } \
        { const v4u* gp_ = (const v4u*)(prow_ + (size_t)t * PJ + (mix_ ? C_CG : C_RG) + h_ * 128 + 16 * c); f_.g0 = gp_[0]; f_.g1 = gp_[1]; } \
        dma_v(lds, prow_ + (mix_ ? C_CV : C_RV) + h_ * 128, wid, lane); \
        { const bf16* st_ = ST + ((size_t)((mix_ * 16 + bh_) * 128 + n_)) * 8192; \
          _Pragma("unroll") for (int i_ = 0; i_ < 2; ++i_) { const int p = wid + 8 * i_, cc = p >> 1, e0 = 64 * (p & 1); \
            __builtin_amdgcn_global_load_lds((const unsigned*)(st_ + (size_t)(e0 + lane) * 64 + cc * 8), (LAS unsigned*)(lds + L_S + cc * 2048 + e0 * 16), 16, 0, 0); } } } while (0)
    RFetch cur;
    int v = F.vcu;
    for (; v < 256; v += F.G) {
        const int sq = v >> 3, run = v & 7, mix = sq >> 4, bh = sq & 15, b = bh >> 2, h = bh & 3;
        const float lg64 = 64.0f * ret_logg(h);
        {
            const int e = tid >> 2, d0 = (tid & 3) * 16; float sv[16];
#pragma unroll
            for (int k = 0; k < 16; ++k) sv[k] = 0.f;
#pragma unroll 1
            for (int q = 0; q < run; ++q) {
                const v4u* tp_ = (const v4u*)(TOT + ((size_t)(sq * 8 + q)) * 8192 + e * 64 + d0); const f32x4* dp_ = (const f32x4*)(DR + (size_t)(sq * 8 + q) * 64 + d0);
                float tv[16]; { float t0[8], t1[8]; unpack8(tp_[0], t0); unpack8(tp_[1], t1);
#pragma unroll
                  for (int k = 0; k < 8; ++k) { tv[k] = t0[k]; tv[8 + k] = t1[k]; } }
#pragma unroll
                for (int k4 = 0; k4 < 4; ++k4) { const f32x4 d4 = dp_[k4];
#pragma unroll
                    for (int k = 0; k < 4; ++k) sv[4 * k4 + k] = sv[4 * k4 + k] * d4[k] + tv[4 * k4 + k]; }
            }
            float s0[8], s1[8];
#pragma unroll
            for (int k = 0; k < 8; ++k) { s0[k] = sv[k]; s1[k] = sv[8 + k]; }
            *(LAS v4u*)(lds + L_SIN + ((tid & 3) * 2) * 2048 + e * 16) = pack8f(s0); *(LAS v4u*)(lds + L_SIN + ((tid & 3) * 2 + 1) * 2048 + e * 16) = pack8f(s1);
        }
        R3_FETCH(v * 16, cur);
#pragma unroll 1
        for (int i = 0; i < 16; ++i) {
            const int u = v * 16 + i, n = run * 16 + i;
            bf16* prow = proj + (size_t)(b * SEQ + n * 64) * PJ;
            const int cg = (mix ? C_CG : C_RG) + h * 128;
            const float* gn = uni(mix ? a.gla_norm : a.ret_norm) + l * 128;
            chunk_cum_regs(cum, tot, cur.la, mix, h, tid);
            { float qf[8], kf[8], q2[8]; unpack8(cur.qw, qf); unpack8(cur.kw, kf);
              const f32x4 c0 = *(const LAS f32x4*)(cum + t * 64 + 8 * c), c1 = *(const LAS f32x4*)(cum + t * 64 + 8 * c + 4);
              const float pret = __expf(lg64 * (float)i);
#pragma unroll
              for (int j = 0; j < 4; ++j) { const float e0 = __expf(c0[j]), e1 = __expf(c1[j]); qf[j] *= e0; qf[4 + j] *= e1; kf[j] *= __builtin_amdgcn_rcpf(e0); kf[4 + j] *= __builtin_amdgcn_rcpf(e1);
                  q2[j] = qf[j] * (mix ? cur.pn0[j] : pret); q2[4 + j] = qf[4 + j] * (mix ? cur.pn1[j] : pret); }
              *(LAS v4u*)(lds + L_QE + c * 1024 + t * 16) = pack8f(qf); *(LAS v4u*)(lds + L_KE + c * 1024 + t * 16) = pack8f(kf); *(LAS v4u*)(lds + L_QE2 + c * 1024 + t * 16) = pack8f(q2); }
            const v4u gw0 = cur.g0, gw1 = cur.g1;
            asm volatile("s_waitcnt vmcnt(0) lgkmcnt(0)" ::: "memory"); __builtin_amdgcn_s_barrier(); asm volatile("" ::: "memory");
            {
                const int ib = wid & 1, eb = wid >> 1;
                bf16x8 qe[4];
#pragma unroll
                for (int d0 = 0; d0 < 4; ++d0) qe[d0] = *(const LAS bf16x8*)(lds + L_QE + (2 * d0 + hi) * 1024 + (32 * ib + r32) * 16);
                f32x16 p0, p1;
#pragma unroll
                for (int r = 0; r < 16; ++r) { p0[r] = 0.f; p1[r] = 0.f; }
                const LAS unsigned char* kb = lds + L_KE + hi * 1024 + r32 * 16;
#pragma unroll
                for (int d0 = 0; d0 < 4; ++d0) p0 = __builtin_amdgcn_mfma_f32_32x32x16_bf16(*(const LAS bf16x8*)(kb + d0 * 2048), qe[d0], p0, 0, 0, 0);
                if (ib == 1) {
#pragma unroll
                    for (int d0 = 0; d0 < 4; ++d0) p1 = __builtin_amdgcn_mfma_f32_32x32x16_bf16(*(const LAS bf16x8*)(kb + d0 * 2048 + 512), qe[d0], p1, 0, 0, 0);
#pragma unroll
                    for (int r = 0; r < 16; ++r) if (crow(r, hi) > r32) p1[r] = 0.f;
                } else {
#pragma unroll
                    for (int r = 0; r < 16; ++r) if (crow(r, hi) > r32) p0[r] = 0.f;
                }
                bf16x8 pa[4];
                { v4u w0 = {cvtpk2(p0[0], p0[1]), cvtpk2(p0[2], p0[3]), cvtpk2(p0[4], p0[5]), cvtpk2(p0[6], p0[7])};
                  v4u w1 = {cvtpk2(p0[8], p0[9]), cvtpk2(p0[10], p0[11]), cvtpk2(p0[12], p0[13]), cvtpk2(p0[14], p0[15])};
                  v4u w2 = {cvtpk2(p1[0], p1[1]), cvtpk2(p1[2], p1[3]), cvtpk2(p1[4], p1[5]), cvtpk2(p1[6], p1[7])};
                  v4u w3 = {cvtpk2(p1[8], p1[9]), cvtpk2(p1[10], p1[11]), cvtpk2(p1[12], p1[13]), cvtpk2(p1[14], p1[15])};
                  pa[0] = __builtin_bit_cast(bf16x8, w0); pa[1] = __builtin_bit_cast(bf16x8, w1); pa[2] = __builtin_bit_cast(bf16x8, w2); pa[3] = __builtin_bit_cast(bf16x8, w3); }
                f32x16 o;
#pragma unroll
                for (int r = 0; r < 16; ++r) o[r] = 0.f;
                const LAS unsigned char* vp = lds + L_V + eb * 4096 + ((lane >> 4) & 1) * 32 + (lane & 3) * 8 + (4 * hi + ((lane & 15) >> 2)) * 64;
#pragma unroll
                for (int ks = 0; ks < 4; ++ks) o = __builtin_amdgcn_mfma_f32_32x32x16_bf16(pa[ks], trfrag(vp + ks * 1024), o, 0, 0, 0);
#pragma unroll
                for (int d0 = 0; d0 < 4; ++d0) o = __builtin_amdgcn_mfma_f32_32x32x16_bf16(qe[d0], *(const LAS bf16x8*)(lds + L_S + (2 * d0 + hi) * 2048 + (32 * eb + r32) * 16), o, 0, 0, 0);
#pragma unroll
                for (int d0 = 0; d0 < 4; ++d0) o = __builtin_amdgcn_mfma_f32_32x32x16_bf16(*(const LAS bf16x8*)(lds + L_QE2 + (2 * d0 + hi) * 1024 + (32 * ib + r32) * 16),
                                                                                         *(const LAS bf16x8*)(lds + L_SIN + (2 * d0 + hi) * 2048 + (32 * eb + r32) * 16), o, 0, 0, 0);
#pragma unroll
                for (int r = 0; r < 16; ++r) ob[(32 * ib + crow(r, hi)) * OB_LD + 32 * eb + r32] = o[r];
            }
            LDS_WAIT(); __builtin_amdgcn_s_barrier(); asm volatile("" ::: "memory");
            if (i < 15) R3_FETCH(u + 1, cur);
            {
                const int ii = tid >> 3, sg = tid & 7;
                f32x4 vv[4]; float ss = 0.f;
#pragma unroll
                for (int k = 0; k < 4; ++k) { vv[k] = *(const LAS f32x4*)(ob + ii * OB_LD + 16 * sg + 4 * k); ss += (vv[k][0] * vv[k][0] + vv[k][1] * vv[k][1]) + (vv[k][2] * vv[k][2] + vv[k][3] * vv[k][3]); }
                ss = xadd<1>(ss); ss = xadd<2>(ss); ss = xadd<4>(ss);
                const float rstd = __builtin_amdgcn_rsqf(ss * (1.0f / 128.0f) + EPS);
                v4u* gp = (v4u*)(prow + (size_t)ii * PJ + cg + 16 * sg);
#pragma unroll
                for (int k2 = 0; k2 < 2; ++k2) { const v4u gw = k2 ? gw1 : gw0; float gf[8]; unpack8(gw, gf);
                    const f32x4 g0 = *(const f32x4*)(gn + 16 * sg + 8 * k2), g1 = *(const f32x4*)(gn + 16 * sg + 8 * k2 + 4);
                    float y[8];
#pragma unroll
                    for (int j = 0; j < 4; ++j) { y[j] = vv[2 * k2][j] * rstd * g0[j] * gf[j]; y[4 + j] = vv[2 * k2 + 1][j] * rstd * g1[j] * gf[4 + j]; }
                    if (!dry) gp[k2] = pack8f(y); }
            }
        }
        LDS_WAIT(); __builtin_amdgcn_s_barrier(); asm volatile("" ::: "memory");
    }
#undef R3_FETCH
}

namespace att {
typedef float f32x16 __attribute__((ext_vector_type(16)));
typedef short v4i16_t __attribute__((ext_vector_type(4)));
constexpr int SLOT = 16384, L_K = 0, L_V = 3 * SLOT, L_WS = 6 * SLOT, L_XCH = 0, L_STG = 65536;
constexpr float THR = 8.0f;
__device__ __forceinline__ int crow(int r, int hi) { return (r & 3) + 8 * (r >> 2) + 4 * hi; }
__device__ __forceinline__ float swapmax(float m) { auto rr = __builtin_amdgcn_permlane32_swap(__float_as_uint(m), __float_as_uint(m), false, false); return fmaxf(__uint_as_float(rr[0]), __uint_as_float(rr[1])); }
__device__ __forceinline__ float max3f(float a, float b, float c) { return __builtin_fmaxf(__builtin_fmaxf(a, b), c); }
__device__ __forceinline__ float swapadd(float m) { auto rr = __builtin_amdgcn_permlane32_swap(__float_as_uint(m), __float_as_uint(m), false, false); return __uint_as_float(rr[0]) + __uint_as_float(rr[1]); }
__device__ __forceinline__ unsigned cvtpk(float lo, float hi) { typedef float f2 __attribute__((ext_vector_type(2))); typedef __bf16 b2 __attribute__((ext_vector_type(2))); f2 v = {lo, hi}; b2 b = __builtin_convertvector(v, b2); return __builtin_bit_cast(unsigned, b); }

__device__ __forceinline__ void attn_unit(LAS unsigned char* lds, bf16* proj, int tid, int wid, int b, int h, int qb, float lam, float post, const float* gn, bool dry) {
    const int lane = tid & 63, r32 = lane & 31, hi = lane >> 5, mp = wid & 1, rw = wid >> 1;
    const size_t rowbase = (size_t)b * SEQ; const int q0 = qb * 128;
    const int NT = 2 * qb + 2, NTw = 2 * qb + 1 + (rw >> 1);
    const bf16* Kh = proj + rowbase * PJ + C_AK + h * 128; const bf16* Vh = proj + rowbase * PJ + C_AV + h * 128;
    const unsigned kvoff = (unsigned)(lane * PJ + wid * 8) * 2u;
    const unsigned vvoff = (unsigned)((16 * (wid & 3) + (lane >> 2)) * PJ + (wid >> 2) * 32 + (lane & 3) * 8) * 2u;
    const unsigned kdst = L_K + wid * 1024, vdst = L_V + wid * 1024;
    const unsigned ldsb = (unsigned)(size_t)lds;
#define ATT_DMA(t, slot) do { const char* kt_ = (const char*)uni(Kh + (size_t)(t) * 64 * PJ); const char* vt_ = (const char*)uni(Vh + (size_t)(t) * 64 * PJ); \
        const unsigned kd_ = (unsigned)__builtin_amdgcn_readfirstlane((int)(ldsb + kdst + (slot) * SLOT)), vd_ = (unsigned)__builtin_amdgcn_readfirstlane((int)(ldsb + vdst + (slot) * SLOT)); \
        glds16s<0>(kt_, kvoff, kd_); glds16s<0>(kt_ + 128, kvoff, kd_ + 8192); glds16s<0>(vt_, vvoff, vd_); glds16s<0>(vt_ + 128, vvoff, vd_ + 8192); } while (0)
#define ATT_DMA1(t, slot, P_) do { const char* bt_ = (const char*)uni(((P_) < 2 ? Kh : Vh) + (size_t)(t) * 64 * PJ) + ((P_) & 1) * 128; \
        const unsigned dd_ = (unsigned)__builtin_amdgcn_readfirstlane((int)(ldsb + ((P_) < 2 ? kdst : vdst) + (slot) * SLOT + ((P_) & 1) * 8192)); \
        glds16s<0>(bt_, (P_) < 2 ? kvoff : vvoff, dd_); } while (0)
    bf16x8 qr[4];
    { const bf16* qp = proj + (rowbase + q0 + 32 * rw + r32) * PJ + C_AQ + h * 128 + mp * 64 + hi * 8;
#pragma unroll
      for (int d0 = 0; d0 < 4; ++d0) qr[d0] = *(const bf16x8*)(qp + d0 * 16); }
    ATT_DMA(0, 0); ATT_DMA(1, 1);
    f32x16 o[4];
#pragma unroll
    for (int d = 0; d < 4; ++d)
#pragma unroll
        for (int r = 0; r < 16; ++r) o[d][r] = 0.f;
    float mref = 0.f, lsum = 0.f;
    float one_ = 1.0f; asm volatile("" : "+v"(one_));
    f32x16 negm;
#pragma unroll
    for (int r = 0; r < 16; ++r) negm[r] = 0.f;
    volatile LAS float* wsf = (volatile LAS float*)(lds + L_WS) + wid * 64;
    const LAS unsigned char* kb0 = lds + L_K + mp * 8192 + hi * 1024 + r32 * 16;
    const LAS unsigned char* vp0 = lds + L_V + ((lane >> 4) & 1) * 32 + (lane & 3) * 8 + (4 * hi + ((lane & 15) >> 2)) * 64;
#define ATT_KLOAD(slot) do { _Pragma("unroll") for (int d0 = 0; d0 < 4; ++d0) { kf[2 * d0] = *(const LAS bf16x8*)(kb0 + (slot) * SLOT + d0 * 2048); kf[2 * d0 + 1] = *(const LAS bf16x8*)(kb0 + (slot) * SLOT + d0 * 2048 + 512); } } while (0)
#define ATT_VLOAD(dst, slot, d0_) do { _Pragma("unroll") for (int ks_ = 0; ks_ < 4; ++ks_) { \
        const v4i16_t lo_ = __builtin_amdgcn_ds_read_tr16_b64_v4i16((LAS v4i16_t*)(vp0 + (slot) * SLOT + (d0_) * 4096 + ks_ * 1024)); \
        const v4i16_t hh_ = __builtin_amdgcn_ds_read_tr16_b64_v4i16((LAS v4i16_t*)(vp0 + (slot) * SLOT + (d0_) * 4096 + ks_ * 1024 + 512)); \
        dst[ks_] = (bf16x8){lo_[0], lo_[1], lo_[2], lo_[3], hh_[0], hh_[1], hh_[2], hh_[3]}; } } while (0)
#define ATT_PV(d0_, vf_) do { _Pragma("unroll") for (int ks_ = 0; ks_ < 4; ++ks_) o[d0_] = __builtin_amdgcn_mfma_f32_32x32x16_bf16(pa[ks_], vf_[ks_], o[d0_], 0, 0, 0); } while (0)
    asm volatile("s_waitcnt vmcnt(4)" ::: "memory"); LDS_WAIT(); __builtin_amdgcn_s_barrier(); asm volatile("" ::: "memory");
    bf16x8 kf[8];
    ATT_KLOAD(0);
#define ATT_PARTA(FIRST_, p0, p1) \
            float ra = max3f(p0[0], p0[1], p1[0]), rb = max3f(p0[2], p0[3], p1[1]); ra = max3f(ra, p1[2], p1[3]); \
            _Pragma("unroll") for (int r = 4; r < 16; r += 4) { ra = max3f(ra, p0[r], p0[r + 1]); rb = max3f(rb, p0[r + 2], p0[r + 3]); ra = max3f(ra, p1[r], p1[r + 1]); rb = max3f(rb, p1[r + 2], p1[r + 3]); } \
            float rm = swapmax(fmaxf(ra, rb)); \
            if ((FIRST_) || __any(rm > THR)) { \
                const float dl = (FIRST_) ? rm : fmaxf(rm, 0.f); \
                mref += dl; \
                _Pragma("unroll") for (int r = 0; r < 16; ++r) { p0[r] -= dl; p1[r] -= dl; negm[r] = -mref; } \
                fres_ = fast_exp2(-dl); lsum *= fres_; need_ = !(FIRST_); }
#define ATT_PARTB(p0, p1, pk) \
            { float sacc = 0.f, sbcc = 0.f; \
            _Pragma("unroll") for (int r = 0; r < 16; ++r) { p0[r] = fast_exp2(p0[r]); p1[r] = fast_exp2(p1[r]); sacc += p0[r]; sbcc = __builtin_fmaf(p1[r], one_, sbcc); } \
            lsum += sacc + sbcc; \
            { v4u w0 = {cvtpk(p0[0], p0[1]), cvtpk(p0[2], p0[3]), cvtpk(p0[4], p0[5]), cvtpk(p0[6], p0[7])}; \
              v4u w1 = {cvtpk(p0[8], p0[9]), cvtpk(p0[10], p0[11]), cvtpk(p0[12], p0[13]), cvtpk(p0[14], p0[15])}; \
              v4u w2 = {cvtpk(p1[0], p1[1]), cvtpk(p1[2], p1[3]), cvtpk(p1[4], p1[5]), cvtpk(p1[6], p1[7])}; \
              v4u w3 = {cvtpk(p1[8], p1[9]), cvtpk(p1[10], p1[11]), cvtpk(p1[12], p1[13]), cvtpk(p1[14], p1[15])}; \
              pk[0] = __builtin_bit_cast(bf16x8, w0); pk[1] = __builtin_bit_cast(bf16x8, w1); pk[2] = __builtin_bit_cast(bf16x8, w2); pk[3] = __builtin_bit_cast(bf16x8, w3); } }
#define ATT_POST() \
            if (need_) { if (hi == 0) wsf[r32] = fres_; \
                _Pragma("unroll") for (int r = 0; r < 16; ++r) { const float fr = wsf[crow(r, hi)]; \
                    _Pragma("unroll") for (int d = 0; d < 4; ++d) o[d][r] *= fr; } }
#define ATT_SB() __builtin_amdgcn_sched_barrier(0)
#define ATT_QK(p0, p1) do { p0 = __builtin_amdgcn_mfma_f32_32x32x16_bf16(kf[0], qr[0], negm, 0, 0, 0); p1 = __builtin_amdgcn_mfma_f32_32x32x16_bf16(kf[1], qr[0], negm, 0, 0, 0); \
        _Pragma("unroll") for (int d0 = 1; d0 < 4; ++d0) { p0 = __builtin_amdgcn_mfma_f32_32x32x16_bf16(kf[2 * d0], qr[d0], p0, 0, 0, 0); p1 = __builtin_amdgcn_mfma_f32_32x32x16_bf16(kf[2 * d0 + 1], qr[d0], p1, 0, 0, 0); } } while (0)
#define ATT_STEP(T_, SL_, SL1_, SL2_, G_DMA, ACT_, ACTN_) do { \
        if (ACTN_) ATT_KLOAD(SL1_); \
        if (G_DMA) ATT_DMA1((T_) + 2, SL2_, 0); \
        if (ACT_) { ATT_PV(0, va); ATT_VLOAD(va, SL_, 2); } \
        ATT_SB(); \
        if (G_DMA) ATT_DMA1((T_) + 2, SL2_, 1); \
        bool need_ = false; float fres_ = 1.0f; \
        if (ACTN_) { ATT_QK(ps0, ps1); ATT_SB(); if (G_DMA) ATT_DMA1((T_) + 2, SL2_, 2); ATT_PARTA(false, ps0, ps1) } \
        else if (G_DMA) ATT_DMA1((T_) + 2, SL2_, 2); \
        ATT_SB(); \
        if (G_DMA) ATT_DMA1((T_) + 2, SL2_, 3); \
        if (ACT_) { ATT_PV(1, vb); ATT_VLOAD(vb, SL_, 3); ATT_PV(2, va); ATT_PV(3, vb); } \
        if (ACTN_) { ATT_PARTB(ps0, ps1, pn) asm volatile("" :: "v"(pn[0]), "v"(pn[1]), "v"(pn[2]), "v"(pn[3]), "v"(lsum)); }        \
        _Pragma("unroll") for (int g_ = 0; g_ < 12; ++g_) { __builtin_amdgcn_sched_group_barrier(0x008, 1, 0); __builtin_amdgcn_sched_group_barrier(0x100, 1, 0); __builtin_amdgcn_sched_group_barrier(0x002, 7, 0); } \
        ATT_SB(); \
        if (ACTN_) { ATT_POST() _Pragma("unroll") for (int i_ = 0; i_ < 4; ++i_) pa[i_] = pn[i_]; \
            ATT_VLOAD(va, SL1_, 0); ATT_VLOAD(vb, SL1_, 1); } \
        ATT_SB(); \
    } while (0)
#define ATT_BARRIER() do { asm volatile("s_waitcnt vmcnt(0)" ::: "memory"); __builtin_amdgcn_s_barrier(); asm volatile("" ::: "memory"); } while (0)
    f32x16 ps0, ps1; bf16x8 pa[4], pn[4];
#pragma unroll
    for (int i = 0; i < 4; ++i) { pa[i] = (bf16x8){0, 0, 0, 0, 0, 0, 0, 0}; pn[i] = pa[i]; }
    bf16x8 va[4], vb[4];
    ATT_QK(ps0, ps1);
    ATT_VLOAD(va, 0, 0); ATT_VLOAD(vb, 0, 1);
    { bool need_ = false; float fres_ = 1.0f; ATT_PARTA(true, ps0, ps1) ATT_PARTB(ps0, ps1, pa) (void)need_; (void)fres_; }
    int t = 0;
    for (; t + 5 <= NT; t += 3) {
        ATT_BARRIER(); ATT_STEP(t, 0, 1, 2, true, true, true);
        ATT_BARRIER(); ATT_STEP(t + 1, 1, 2, 0, true, true, true);
        ATT_BARRIER(); ATT_STEP(t + 2, 2, 0, 1, true, true, true);
    }
    {
        int sl = 0, sl1 = 1, sl2 = 2;
        for (; t < NT; ++t) {
            if (t + 1 < NT) ATT_BARRIER();
            ATT_STEP(t, sl, sl1, sl2, (t + 2 < NT), (t < NTw), (t + 1 < NTw));
            const int s0 = sl; sl = sl1; sl1 = sl2; sl2 = s0;
        }
    }
#undef ATT_STEP
#undef ATT_PARTA
#undef ATT_PARTB
#undef ATT_POST
#undef ATT_BARRIER
#undef ATT_QK
#undef ATT_FAST
#undef ATT_SB
#undef ATT_KLOAD
#undef ATT_VLOAD
#undef ATT_PV
    int lane_e = lane; asm volatile("" : "+v"(lane_e)); const int r32e = lane_e & 31, hie = lane_e >> 5;
    lsum = swapadd(lsum);
    if (hie == 0) wsf[r32e] = 1.0f / lsum;
#pragma unroll
    for (int r = 0; r < 16; ++r) { const float fr = wsf[crow(r, hie)];
#pragma unroll
        for (int d = 0; d < 4; ++d) o[d][r] *= fr; }
    LDS_WAIT(); __builtin_amdgcn_s_barrier(); asm volatile("" ::: "memory");
    LAS float* xch = (LAS float*)(lds + L_XCH) + rw * 4096 + lane_e;
    if (mp == 1) {
#pragma unroll
        for (int d = 0; d < 4; ++d)
#pragma unroll
            for (int r = 0; r < 16; ++r) xch[(d * 16 + r) * 64] = o[d][r];
    }
    LDS_WAIT(); __builtin_amdgcn_s_barrier(); asm volatile("" ::: "memory");
    if (mp == 0) {
        float ss[16];
#pragma unroll
        for (int r = 0; r < 16; ++r) ss[r] = 0.f;
#pragma unroll
        for (int d = 0; d < 4; ++d)
#pragma unroll
            for (int r = 0; r < 16; ++r) { const float y = o[d][r] - lam * xch[(d * 16 + r) * 64]; o[d][r] = y; ss[r] += y * y; }
#pragma unroll
        for (int r = 0; r < 16; ++r) {
            ss[r] = xadd<1>(ss[r]); ss[r] = xadd<2>(ss[r]); ss[r] = xadd<4>(ss[r]); ss[r] = xadd<8>(ss[r]); ss[r] = xadd<16>(ss[r]);
            ss[r] = post * __builtin_amdgcn_rsqf(ss[r] * (1.0f / 128.0f) + EPS);
        }
        LAS bf16* stg = (LAS bf16*)(lds + L_STG + rw * 8192);
#pragma unroll
        for (int d = 0; d < 4; ++d) { const float g = gn[32 * d + r32e];
#pragma unroll
            for (int r = 0; r < 16; ++r) stg[crow(r, hie) * 128 + 32 * d + r32e] = (bf16)f2bf(o[d][r] * ss[r] * g); }
        LDS_WAIT();
        bf16* orow = proj + (rowbase + q0 + 32 * rw) * PJ + C_AQ + h * 128;
#pragma unroll
        for (int i = 0; i < 8; ++i) { const int row = i * 4 + (lane_e >> 4), ch = lane_e & 15;
            const v4u v = *(const LAS v4u*)(stg + row * 128 + ch * 8); if (!dry) *(v4u*)(orow + (size_t)row * PJ + ch * 8) = v; }
    }
    LDS_WAIT(); __builtin_amdgcn_s_barrier(); asm volatile("" ::: "memory");
#undef ATT_DMA
#undef ATT_DMA1
}
}

__device__ __forceinline__ void phase_attn(const Args& a, const Frame& F, int l, bool dry) {
    unsigned char* ws = F.ws; bf16* proj = (bf16*)(ws + WS_BIG);
    const float lam = ((const float*)(ws + WS_LAM))[l];
    const float post = 1.0f - LAM_INIT[l];
    const float* gn = uni(a.da_norm) + l * 128;
    const int tid = opaque_tid(F.wave);
    for (int v = F.vcu; v < 256; v += F.G) {
        const int bh = v >> 4, s = v & 15;
#pragma unroll 1
        for (int i = 0; i < 4; ++i) {
            const int qb = (i == 0) ? 63 - s : (i == 1) ? 32 + s : (i == 2) ? 31 - s : s;
            att::attn_unit(F.lds, proj, tid, F.wave, bh >> 2, bh & 3, qb, lam, post, gn, dry);
        }
    }
}


constexpr int NPH = 12;
constexpr int N_PHASES = DEPTH * NPH + 1;
#ifndef REP_UP
#define REP_UP 1
#endif
#ifndef REP_DOWN
#define REP_DOWN 1
#endif
#ifndef REP_INPROJ
#define REP_INPROJ 1
#endif
#ifndef REP_R
#define REP_R 1
#endif
#ifndef REP_ATTN
#define REP_ATTN 1
#endif
#ifndef REP_G
#define REP_G 1
#endif
#ifndef REP_M
#define REP_M 1
#endif
#ifndef REP_R2
#define REP_R2 1
#endif
#ifndef REP_NORM
#define REP_NORM 1
#endif
#ifndef MK_PER_PHASE
#define MK_PER_PHASE 0
#endif

__global__ void __launch_bounds__(512, 2) mk_fwd(Args a) {
    extern __shared__ __attribute__((aligned(16))) unsigned char lds_raw[];
    Frame F;
    F.lds = (LAS unsigned char*)lds_raw; F.ws = uni(a.ws); F.wave = __builtin_amdgcn_readfirstlane((int)threadIdx.x >> 6);
    F.G = gridDim.x; { const int bx = blockIdx.x; F.vcu = (F.G % 8 == 0) ? (bx % 8) * (F.G / 8) + bx / 8 : bx; }
    volatile LAS unsigned* MISC = (volatile LAS unsigned*)(F.lds + MISC_OFF);
    if (threadIdx.x < 32) MISC[threadIdx.x] = 0u;
    __syncthreads();
    XcdBarrier bar; bar.bar = (unsigned*)(F.ws + WS_CTL); bar.x = 0; bar.st = nullptr;
    if (!MK_PER_PHASE) bar = xcd_barrier_post((unsigned*)(F.ws + WS_CTL), MISC + 8);
    const int lo = a.ph_lo, hi = a.ph_hi;
#define RUN(k) (lo <= (k) && (k) < hi)
#define SEAM(k) do { if (RUN(k) && RUN((k) + 1)) xcd_barrier(bar); } while (0)
    unsigned char* ws = F.ws; float* const outp = uni(a.out);
    bf16* XB = (bf16*)(ws + WS_HN); bf16* BIG = (bf16*)(ws + WS_BIG); bf16* MG = (bf16*)(ws + WS_ST); float* SSQ = (float*)(ws + WS_SSQ);
    const int cid = (int)blockIdx.x;

    if (RUN(0)) phase_rope(F);
    for (int l = 0; l < DEPTH; ++l) {
        const int pb = l * NPH;
        if (RUN(pb)) {
            for (int rep = 0; rep < REP_NORM; ++rep) {
            phase_conv(a, F, l);
            if (l == 0) phase_prep(F, uni(a.x), XB, SSQ);
            }
        }
        SEAM(pb);
        for (int hf = 0; hf < 2; ++hf) {
            const int p0 = pb + (hf ? 10 : 1);
            const float* ssq_in = SSQ + (size_t)(hf ? 2 : 0) * M * 16;
            float* ssq_out = SSQ + (size_t)(hf ? 0 : 1) * M * 16;
            if (RUN(p0)) {
                pg8::Gemm g{(const char*)XB, (const char*)(ws + (hf ? W_13B : W_13A)), DMODEL, DMODEL, DMODEL, 0, 0};
                pg8::Order<(2 * DFFP) / 256, 1> S; S.init(F.G, cid, F.wave);
                pg8::EpiSwiGLU E{BIG, ssq_in};
                for (int rep = 0; rep < REP_UP; ++rep)
                pg8::gemm_phase<pg8::EpiSwiGLU, true>(F.lds, g, S, E);
            }
            SEAM(p0);
            if (RUN(p0 + 1)) {
                pg8::Gemm g{(const char*)BIG, (const char*)(ws + (hf ? W_2B : W_2A)), DFFP, DFFP, DFFP, 0, 0};
                pg8::Order<(DMODEL) / 256, 1> S; S.init(F.G, cid, F.wave);
                for (int rep = 0; rep < REP_DOWN; ++rep) {
                pg8::EpiResid E{XB, 0.5f, 2.0f, rep < REP_DOWN - 1, ssq_out};
                pg8::gemm_phase<pg8::EpiResid, true>(F.lds, g, S, E); }
            }
            SEAM(p0 + 1);
            if (hf == 0) {
                const float* ssq_mix = ssq_out;
                if (RUN(pb + 3)) {
                    pg8::Gemm g{(const char*)XB, (const char*)(ws + W_IN), DMODEL, DMODEL, DMODEL, 0, 0};
                    pg8::Order<(PJ) / 256, 1> S; S.init(F.G, cid, F.wave);
                    pg8::EpiInProj E{BIG, (const float*)(ws + WS_ROPE), uni(a.gla_ab) + l * 256, ssq_mix};
                    for (int rep = 0; rep < REP_INPROJ; ++rep)
                    pg8::gemm_phase<pg8::EpiInProj, true>(F.lds, g, S, E);
                }
                SEAM(pb + 3);
                if (RUN(pb + 4)) for (int rep = 0; rep < REP_R; ++rep) phase_r1_mfma(a, F);
                SEAM(pb + 4);
                if (RUN(pb + 6)) {
                    for (int rep = 0; rep < REP_R; ++rep) phase_r3_mfma(a, F, l, rep < REP_R - 1);
                    for (int rep = 0; rep < REP_ATTN; ++rep) phase_attn(a, F, l, rep < REP_ATTN - 1);
                }
                SEAM(pb + 6);
                if (RUN(pb + 7)) {
                    pg8::Gemm g{(const char*)XB, (const char*)(ws + W_G), DMODEL, DMODEL, DMODEL, 0, 0};
                    pg8::Order<(3 * DMODEL) / 256, 1> S; S.init(F.G, cid, F.wave);
                    pg8::EpiGates E{BIG, ssq_mix};
                    for (int rep = 0; rep < REP_G; ++rep)
                    pg8::gemm_phase<pg8::EpiGates, true>(F.lds, g, S, E);
                }
                SEAM(pb + 7);
                if (RUN(pb + 8)) {
                    pg8::Gemm g{(const char*)BIG, (const char*)(ws + W_B), PJ, 512, 512, 512 * 2, (size_t)DMODEL * 512 * 2};
                    pg8::Order<(DMODEL) / 256, 3> S; S.init(F.G, cid, F.wave);
                    pg8::EpiMerge E{BIG, MG};
                    for (int rep = 0; rep < REP_M; ++rep)
                    pg8::gemm_phase<pg8::EpiMerge, true>(F.lds, g, S, E);
                }
                SEAM(pb + 8);
                if (RUN(pb + 9)) {
                    pg8::Gemm g{(const char*)MG, (const char*)(ws + W_O), DMODEL, DMODEL, DMODEL, 0, 0};
                    pg8::Order<(DMODEL) / 256, 1> S; S.init(F.G, cid, F.wave);
                    pg8::EpiResid E{XB, 1.0f, 1.0f, false, SSQ + (size_t)2 * M * 16};
                    pg8::gemm_phase<pg8::EpiResid, true>(F.lds, g, S, E);
                }
                SEAM(pb + 9);
            }
        }
    }
    if (RUN(DEPTH * NPH)) phase_final_norm(F, XB, outp, uni(a.final_norm), SSQ);
#undef RUN
#undef SEAM
}

extern "C" void kernel_launch(void* const* d_in, const int* in_sizes, int n_in, void* d_out, int out_size, void* d_ws, size_t ws_size, hipStream_t stream) {
    static int grid = 0;
    if (grid == 0) {
        if (n_in != 22 || in_sizes[0] != M * DMODEL || out_size != M * DMODEL || ws_size < WS_END) { fprintf(stderr, "kernel_launch: unexpected shapes (n_in %d, ws %zu)\n", n_in, ws_size); grid = -1; return; }
        int dev = 0, cus = 0, per_cu = 0;
        if (hipGetDevice(&dev) != hipSuccess || hipDeviceGetAttribute(&cus, hipDeviceAttributeMultiprocessorCount, dev) != hipSuccess) { grid = -1; return; }
        if (hipFuncSetAttribute((const void*)mk_fwd, hipFuncAttributeMaxDynamicSharedMemorySize, LDS_BYTES) != hipSuccess) { fprintf(stderr, "kernel_launch: hipFuncSetAttribute failed\n"); grid = -1; return; }
        if (hipOccupancyMaxActiveBlocksPerMultiprocessor(&per_cu, (const void*)mk_fwd, 512, LDS_BYTES) != hipSuccess || per_cu < 1) fprintf(stderr, "kernel_launch: occupancy query says %d\n", per_cu);
        (void)hipGetLastError();
        grid = cus;
    }
    if (grid < 0) return;
    if (hipMemsetAsync((char*)d_ws + WS_CTL, 0, CTL_ZERO_BYTES, stream) != hipSuccess) return;
    Args a{};
    a.x = (const float*)d_in[0]; a.ffn1_norm = (const float*)d_in[1]; a.ffn1_w1 = (const float*)d_in[2]; a.ffn1_w3 = (const float*)d_in[3]; a.ffn1_w2 = (const float*)d_in[4];
    a.mix_norm = (const float*)d_in[5]; a.w_in = (const float*)d_in[6]; a.lam_qk = (const float*)d_in[7]; a.da_norm = (const float*)d_in[8]; a.ret_norm = (const float*)d_in[9];
    a.gla_a2 = (const float*)d_in[10]; a.gla_ab = (const float*)d_in[11]; a.gla_norm = (const float*)d_in[12]; a.wb_a = (const float*)d_in[13]; a.wb_b = (const float*)d_in[14];
    a.wb_c = (const float*)d_in[15]; a.w_out = (const float*)d_in[16]; a.ffn2_norm = (const float*)d_in[17]; a.ffn2_w1 = (const float*)d_in[18]; a.ffn2_w3 = (const float*)d_in[19];
    a.ffn2_w2 = (const float*)d_in[20]; a.final_norm = (const float*)d_in[21];
    a.out = (float*)d_out; a.ws = (unsigned char*)d_ws;
#if MK_PER_PHASE
    for (int p = 0; p < N_PHASES; ++p) { a.ph_lo = p; a.ph_hi = p + 1; hipLaunchKernelGGL(mk_fwd, dim3(grid), dim3(512), LDS_BYTES, stream, a); }
#else
    a.ph_lo = 0; a.ph_hi = N_PHASES;
    hipLaunchKernelGGL(mk_fwd, dim3(grid), dim3(512), LDS_BYTES, stream, a);
#endif
}
```

```cpp
#include <hip/hip_runtime.h>
#include <cstdio>
#include <cstdint>

#define GAS __attribute__((address_space(1)))
#define LAS __attribute__((address_space(3)))
typedef unsigned short bf16;
typedef unsigned v4u __attribute__((ext_vector_type(4)));
typedef unsigned v2u __attribute__((ext_vector_type(2)));
typedef float f32x4 __attribute__((ext_vector_type(4)));
typedef float f32x2 __attribute__((ext_vector_type(2)));
typedef short bf16x8 __attribute__((ext_vector_type(8)));

constexpr int BATCH = 4, SEQ = 8192, DMODEL = 1024, DEPTH = 4, M = BATCH * SEQ;
constexpr int NH = 4;
constexpr int DFF = 2752, DFFP = 2816;
constexpr int INC = 7696;
constexpr int PJ = 4864;
constexpr int C_AQ = 0, C_RG = 512, C_CG = 1024, C_AK = 1536, C_AV = 2048, C_RQ = 2560, C_RK = 2816, C_RV = 3072, C_CQ = 3584, C_CK = 3840, C_CV = 4096, C_LA = 4608;
constexpr int C_GATE = 1536;
constexpr int O_AQ = 0, O_AK = 512, O_AV = 1024, O_RQ = 1536, O_RK = 1792, O_RV = 2048, O_RG = 2560, O_CQ = 3072, O_CK = 3328, O_CV = 3584, O_CG = 4096, O_CA = 4608, O_GATE = 4624;
constexpr float EPS = 1e-6f;
constexpr float C2 = 0.125f * 1.4426950408889634f;

constexpr size_t MiB = 1u << 20;
constexpr size_t WS_CTL = 0, CTL_ZERO_BYTES = 64 * 1024;
constexpr size_t WS_LAM = 256 * 1024;
constexpr size_t WS_DEC = 1 * MiB;
constexpr size_t WS_ROPE = 2 * MiB;
constexpr size_t WS_SSQ = 4 * MiB;
constexpr size_t WS_W = 10 * MiB;
constexpr size_t W_13A = WS_W, W_2A = W_13A + 11 * MiB, W_13B = W_2A + 11 * MiB / 2, W_2B = W_13B + 11 * MiB, W_IN = W_2B + 11 * MiB / 2,
                 W_G = W_IN + 19 * MiB / 2, W_B = W_G + 6 * MiB, W_O = W_B + 3 * MiB, W_END = W_O + 2 * MiB;
constexpr size_t WS_HN = 64 * MiB;
constexpr size_t WS_ST = 128 * MiB;
constexpr size_t WS_BIG = 192 * MiB;
constexpr size_t WS_TOT = 496 * MiB;
constexpr size_t WS_DR = 500 * MiB;
constexpr size_t WS_END = 501 * MiB;
static_assert(W_END <= WS_HN, "weight region");

constexpr int RING_BYTES = 131072;
constexpr int MISC_OFF = RING_BYTES + 320;
constexpr int LDS_BYTES = 147456;

__device__ __forceinline__ float bf2f(unsigned h) { return __uint_as_float(h << 16); }
__device__ __forceinline__ float bflo(unsigned w) { return __uint_as_float(w << 16); }
__device__ __forceinline__ float bfhi(unsigned w) { return __uint_as_float(w & 0xffff0000u); }
__device__ __forceinline__ unsigned f2bf(float f) { unsigned u = __float_as_uint(f); return (u + 0x7fffu + ((u >> 16) & 1u)) >> 16; }
__device__ __forceinline__ unsigned pk2(float lo, float hi) { typedef float f2_ __attribute__((ext_vector_type(2))); typedef __bf16 b2_ __attribute__((ext_vector_type(2))); f2_ v = {lo, hi}; b2_ b = __builtin_convertvector(v, b2_); return __builtin_bit_cast(unsigned, b); }
template <int K> __device__ __forceinline__ float xadd(float v) {
    if constexpr (K == 32) { auto rr = __builtin_amdgcn_permlane32_swap(__float_as_uint(v), __float_as_uint(v), false, false); return __uint_as_float(rr[0]) + __uint_as_float(rr[1]); }
    else return v + __int_as_float(__builtin_amdgcn_ds_swizzle(__float_as_int(v), (K << 10) | 0x1f));
}
__device__ __forceinline__ float wave_sum(float v) { v = xadd<1>(v); v = xadd<2>(v); v = xadd<4>(v); v = xadd<8>(v); v = xadd<16>(v); v = xadd<32>(v); return v; }
__device__ __forceinline__ float fast_exp2(float x) { return __builtin_amdgcn_exp2f(x); }
__device__ __forceinline__ float sigmoidf_(float x) { return __builtin_amdgcn_rcpf(1.0f + fast_exp2(-1.4426950408889634f * x)); }
__device__ __forceinline__ float siluf_(float x) { return x * sigmoidf_(x); }
template <class T> __device__ __forceinline__ T* uni(T* p) {
    const unsigned long long v = (unsigned long long)p;
    const unsigned lo = __builtin_amdgcn_readfirstlane((unsigned)v), hi = __builtin_amdgcn_readfirstlane((unsigned)(v >> 32));
    return (T*)(GAS T*)(((unsigned long long)hi << 32) | lo);
}
__device__ __forceinline__ int opaque_tid(int wave) { int z = 0; asm volatile("" : "+v"(z)); const int lane = __builtin_amdgcn_mbcnt_hi(-1, __builtin_amdgcn_mbcnt_lo(-1, z)); return wave * 64 + lane; }
__device__ __forceinline__ unsigned cvtpk2(float lo, float hi) { typedef float f2 __attribute__((ext_vector_type(2))); typedef __bf16 b2 __attribute__((ext_vector_type(2))); f2 v = {lo, hi}; b2 b = __builtin_convertvector(v, b2); return __builtin_bit_cast(unsigned, b); }
__device__ __forceinline__ void glds16(const void* gsrc, unsigned lds_dst) { unsigned keep;
    asm volatile("s_mov_b32 %0, m0\n\ts_mov_b32 m0, %2\n\ts_nop 0\n\tglobal_load_lds_dwordx4 %1, off\n\ts_mov_b32 m0, %0" : "=&s"(keep) : "v"(gsrc), "s"(lds_dst) : "memory"); }
template <int IMM> __device__ __forceinline__ void glds16s(const void* sbase, unsigned voff, unsigned lds_dst) { unsigned keep;
    asm volatile("s_mov_b32 %0, m0\n\ts_mov_b32 m0, %3\n\ts_nop 0\n\tglobal_load_lds_dwordx4 %1, %2 offset:%c4\n\ts_mov_b32 m0, %0" : "=&s"(keep) : "v"(voff), "s"(sbase), "s"(lds_dst), "i"(IMM) : "memory"); }
#define LDS_WAIT() asm volatile("s_waitcnt lgkmcnt(0)" ::: "memory")
#define VM_WAIT() asm volatile("s_waitcnt vmcnt(0)" ::: "memory")

namespace pg8 {
constexpr int BM = 256, BK = 64, HALF = 128, HTB = HALF * BK * 2, NXCD = 8, WGM = 8;
__host__ __device__ __forceinline__ int lds_byte(int r, int c) { const int x = (-(r >> 2)) & 3; return (r >> 3) * 1024 + (c >> 5) * 512 + (r & 7) * 64 + (((((c >> 3) & 3) ^ x)) << 4) + (c & 7) * 2; }
__host__ __device__ __forceinline__ void stage_rc(int b, int& R, int& C) { const int blk = b / 1024, i = (b % 1024) / 16; R = blk * 8 + ((i & 31) >> 2); const int x = (-(R >> 2)) & 3; C = ((i >> 5) * 4 + ((i & 3) ^ x)) * 8 + (b % 16) / 2; }
__host__ __device__ __forceinline__ int perm32(int rho) { const int n = rho >> 4, i = rho & 15; return 8 * (i >> 2) + 4 * n + (i & 3); }

struct Unit { int pm, pn, z; };
struct Gemm { const char* A; const char* B; int lda, ldb, K; size_t zA, zB; };
__device__ __forceinline__ const char* a_base(const Gemm& g, const Unit& u) { return g.A + (size_t)u.pm * 256 * g.lda * 2 + (size_t)u.z * g.zA; }
__device__ __forceinline__ const char* b_base(const Gemm& g, const Unit& u) { return g.B + (size_t)u.pn * 256 * g.ldb * 2 + (size_t)u.z * g.zB; }

template <int NN, int NZ> struct Order {
    static constexpr int nM = M / BM, nN = NN, nwg = nM * nN, nz = NZ;
    int G, c, wave;
    __device__ void init(int G_, int c_, int wave_) { G = G_; c = c_; wave = wave_; }
    __device__ bool next(int i, Unit& u) const {
        const int t = i / NZ; u.z = i - t * NZ;
        const int L = t * G + c; if (L >= nwg) return false;
        static_assert(nwg % NXCD == 0 && nM % WGM == 0, "tile counts");
        int wgid = L; { constexpr int q = nwg / NXCD; const int xcd = wgid % NXCD, off = wgid / NXCD; wgid = xcd * q + off; }
        constexpr int nig = WGM * nN; const int gid = wgid / nig, fm = gid * WGM, w = wgid - gid * nig;
        u.pm = fm + (w % WGM); u.pn = w / WGM; return true;
    }
};

template <class Epi, bool ALIGN_EPI, class Sched>
__device__ __forceinline__ void gemm_phase(LAS unsigned char* lds, const Gemm g, const Sched& S, const Epi& E) {
    const int tid = opaque_tid(S.wave), wid = S.wave, lane = tid & 63, wr = wid >> 2, wc = wid & 3, fr = lane & 15, fq = lane >> 4;
    const int nt = g.K / BK;
    unsigned voffA[2], voffB[2];
#pragma unroll
    for (int i = 0; i < 2; ++i) { int R, C; stage_rc(tid * 16 + i * 8192, R, C); const int Rb = Epi::PERM ? ((R & ~31) + perm32(R & 31)) : R;
        voffA[i] = (unsigned)(R * g.lda + C) * 2u; voffB[i] = (unsigned)(Rb * g.ldb + C) * 2u; }
    const size_t kstep = (size_t)(BK * 2);
    const size_t hstepA = (size_t)HALF * g.lda * 2, hstepB = (size_t)HALF * g.ldb * 2;
    const unsigned ldsw = (unsigned)wid * 1024u; const unsigned ldsb = (unsigned)(size_t)lds;
    const int aoff = lds_byte(wr * 64 + fr, fq * 8), boff = lds_byte(wc * 32 + fr, fq * 8);
#define PG8_SA(b, h) (((b) * 2 + (h)) * HTB)
#define PG8_SB(b, h) ((4 + (b) * 2 + (h)) * HTB)
#define PG8_STAGE(bufoff, gbase, voff) do { _Pragma("unroll") for (int _i = 0; _i < 2; ++_i) \
        glds16s<0>(uni((const char*)(gbase)), (voff)[_i], (unsigned)__builtin_amdgcn_readfirstlane((int)(ldsb + (bufoff) + ldsw + _i * 8192))); } while (0)
#define PG8_LDA(dst, b, h) do { _Pragma("unroll") for (int m = 0; m < 4; ++m) _Pragma("unroll") for (int k = 0; k < 2; ++k) dst[m][k] = *(const LAS bf16x8*)(lds + PG8_SA(b, h) + aoff + m * 2048 + k * 512); } while (0)
#define PG8_LDB(dst, b, h) do { _Pragma("unroll") for (int n = 0; n < 2; ++n) _Pragma("unroll") for (int k = 0; k < 2; ++k) dst[n][k] = *(const LAS bf16x8*)(lds + PG8_SB(b, h) + boff + n * 2048 + k * 512); } while (0)
#define PG8_MMA(ai, bj, At, Bt) do { __builtin_amdgcn_s_setprio(1); _Pragma("unroll") for (int m = 0; m < 4; ++m) _Pragma("unroll") for (int n = 0; n < 2; ++n) _Pragma("unroll") for (int k = 0; k < 2; ++k) \
        acc[ai][bj][m][n] = __builtin_amdgcn_mfma_f32_16x16x32_bf16(Bt[n][k], At[m][k], acc[ai][bj][m][n], 0, 0, 0); __builtin_amdgcn_s_setprio(0); } while (0)
#define PG8_WAIT_V(n) asm volatile("s_waitcnt vmcnt(" #n ")" ::: "memory")
#define PG8_WAIT_VN(n) asm volatile("s_waitcnt vmcnt(%0)" :: "n"(n) : "memory")
#define PG8_WAIT_L(n) asm volatile("s_waitcnt lgkmcnt(" #n ")" ::: "memory")
#define PG8_BAR __builtin_amdgcn_s_barrier()
#define PG8_SCHED __builtin_amdgcn_sched_barrier(0)
    Unit cur, nxt; int ui = 0;
    if (!S.next(0, cur)) return;
    f32x4 acc[2][2][4][2];
    if constexpr (Epi::CINIT) E.cinit(acc, cur, wr, wc, fr, fq);
    else {
#pragma unroll
    for (int a = 0; a < 2; ++a)
#pragma unroll
        for (int b = 0; b < 2; ++b)
#pragma unroll
            for (int m = 0; m < 4; ++m)
#pragma unroll
                for (int n = 0; n < 2; ++n) acc[a][b][m][n] = (f32x4){0.f, 0.f, 0.f, 0.f};
    }
    bf16x8 At[4][2], B0[2][2], B1[2][2];
    LAS float* rsl = (LAS float*)(lds + 132096) + (wid * 16 + fr) * 8;
    int cpm = -1;
    const char* cA = a_base(g, cur); const char* cB = b_base(g, cur);
    PG8_STAGE(PG8_SB(0, 0), cB, voffB); PG8_STAGE(PG8_SB(0, 1), cB + hstepB, voffB); PG8_STAGE(PG8_SA(0, 0), cA, voffA); PG8_STAGE(PG8_SA(0, 1), cA + hstepA, voffA);
    if (wr == 1) PG8_BAR;
    PG8_WAIT_V(2); PG8_BAR;
    PG8_STAGE(PG8_SB(1, 0), cB + kstep, voffB); PG8_STAGE(PG8_SA(1, 0), cA + kstep, voffA); PG8_STAGE(PG8_SB(1, 1), cB + hstepB + kstep, voffB);
    if constexpr (Epi::NST > 0) PG8_STAGE(PG8_SA(1, 1), cA + kstep + hstepA, voffA);
    PG8_WAIT_V(0); PG8_BAR;
    for (;;) {
        const bool has_next = S.next(ui + 1, nxt);
        const char* nA = has_next ? a_base(g, nxt) : cA; const char* nB = has_next ? b_base(g, nxt) : cB;
#define PG8_ITER(t, W123, S1) do { \
            const bool last = ((t) == nt - 2); \
            const char* a1 = cA + (size_t)((t) + 1) * kstep; \
            const char* a2 = last ? nA : cA + (size_t)((t) + 2) * kstep; const char* b2 = last ? nB : cB + (size_t)((t) + 2) * kstep; \
            const char* a3 = a2 + kstep; const char* b3 = b2 + kstep; \
            PG8_LDB(B0, 0, 0); PG8_LDB(B1, 0, 1); PG8_SCHED; PG8_LDA(At, 0, 0); if (S1) PG8_STAGE(PG8_SA(1, 1), a1 + hstepA, voffA); \
            PG8_WAIT_VN(W123); PG8_WAIT_L(0); PG8_BAR; PG8_MMA(0, 0, At, B0); PG8_MMA(0, 1, At, B1); PG8_BAR; PG8_SCHED; \
            PG8_LDA(At, 0, 1); PG8_STAGE(PG8_SB(0, 0), b2, voffB); PG8_STAGE(PG8_SB(0, 1), b2 + hstepB, voffB); PG8_STAGE(PG8_SA(0, 0), a2, voffA); \
            PG8_WAIT_VN(W123); PG8_WAIT_L(0); PG8_BAR; PG8_MMA(1, 0, At, B0); PG8_MMA(1, 1, At, B1); PG8_BAR; PG8_SCHED; \
            PG8_LDB(B0, 1, 0); PG8_LDB(B1, 1, 1); PG8_SCHED; PG8_LDA(At, 1, 0); PG8_STAGE(PG8_SA(0, 1), a2 + hstepA, voffA); \
            PG8_WAIT_VN(W123); PG8_WAIT_L(0); PG8_BAR; PG8_MMA(0, 0, At, B0); PG8_MMA(0, 1, At, B1); PG8_BAR; PG8_SCHED; \
            PG8_LDA(At, 1, 1); PG8_STAGE(PG8_SB(1, 0), b3, voffB); PG8_STAGE(PG8_SB(1, 1), b3 + hstepB, voffB); PG8_STAGE(PG8_SA(1, 0), a3, voffA); \
            PG8_WAIT_V(8); PG8_WAIT_L(0); PG8_BAR; PG8_MMA(1, 0, At, B0); PG8_MMA(1, 1, At, B1); PG8_BAR; PG8_SCHED; \
        } while (0)
        if constexpr (Epi::NST > 0) { PG8_ITER(0, 8 + Epi::NST, false); for (int t = 2; t < nt; t += 2) PG8_ITER(t, 8, true); PG8_STAGE(PG8_SA(1, 1), nA + kstep + hstepA, voffA); }
        else { for (int t = 0; t < nt; t += 2) PG8_ITER(t, 8, true); }
#undef PG8_ITER
        if constexpr (ALIGN_EPI) { if (wr == 0) PG8_BAR; }
        if constexpr (Epi::RSTD) {
            if (cur.pm != cpm) { cpm = cur.pm; E.rs_fill(cur, wr, fr, fq, rsl); }
            float rs[2][4]; { const f32x4 a0 = *(const LAS f32x4*)rsl, a1 = *(const LAS f32x4*)(rsl + 4); rs[0][0] = a0[0]; rs[0][1] = a0[1]; rs[0][2] = a0[2]; rs[0][3] = a0[3]; rs[1][0] = a1[0]; rs[1][1] = a1[1]; rs[1][2] = a1[2]; rs[1][3] = a1[3]; }
            E(acc, cur, wr, wc, fr, fq, rs);
        } else { float rs[2][4]; E(acc, cur, wr, wc, fr, fq, rs); }
        if (!has_next) break;
        if constexpr (Epi::CINIT) E.cinit(acc, nxt, wr, wc, fr, fq);
        else {
#pragma unroll
        for (int a = 0; a < 2; ++a)
#pragma unroll
            for (int b = 0; b < 2; ++b)
#pragma unroll
                for (int m = 0; m < 4; ++m)
#pragma unroll
                    for (int n = 0; n < 2; ++n) acc[a][b][m][n] = (f32x4){0.f, 0.f, 0.f, 0.f};
        }
        cur = nxt; cA = nA; cB = nB; ++ui;
        if constexpr (ALIGN_EPI) { if (wr == 1) PG8_BAR; }
    }
    PG8_WAIT_V(0);
    if constexpr (!ALIGN_EPI) { if (wr == 0) PG8_BAR; }
    PG8_BAR;
#undef PG8_SA
#undef PG8_SB
#undef PG8_STAGE
#undef PG8_LDA
#undef PG8_LDB
#undef PG8_MMA
#undef PG8_WAIT_V
#undef PG8_WAIT_VN
#undef PG8_WAIT_L
#undef PG8_BAR
#undef PG8_SCHED
}

typedef f32x4 Acc[2][2][4][2];
__device__ __forceinline__ float row_rstd(const float* part, int row, int fq) {
    const f32x4 p = *(const f32x4*)(part + (size_t)row * 16 + 4 * fq);
    float s = (p[0] + p[1]) + (p[2] + p[3]);
    s = xadd<16>(s); s = xadd<32>(s);
    return __builtin_amdgcn_rsqf(s * (1.0f / DMODEL) + EPS);
}
__device__ __forceinline__ v4u pack8(const f32x4 a, const f32x4 b) { v4u w; w.x = pk2(a[0], a[1]); w.y = pk2(a[2], a[3]); w.z = pk2(b[0], b[1]); w.w = pk2(b[2], b[3]); return w; }

__device__ __forceinline__ void rstd_fill(const float* part, int row0, int fq, LAS float* rsl) {
#pragma unroll
    for (int i = 0; i < 8; i += 2) {
        const float r0 = row_rstd(part, row0 + (i >> 2) * HALF + (i & 3) * 16, fq), r1 = row_rstd(part, row0 + ((i + 1) >> 2) * HALF + ((i + 1) & 3) * 16, fq);
        if (fq == 0) { rsl[i] = r0; rsl[i + 1] = r1; }
        asm volatile("" ::: "memory");
    }
    asm volatile("s_waitcnt lgkmcnt(0)" ::: "memory");
}
__device__ __forceinline__ void rows_rstd(const float* part, int row0, int fq, float (&rs)[2][4]) {
#pragma unroll
    for (int ai = 0; ai < 2; ++ai)
#pragma unroll
        for (int m = 0; m < 4; ++m) rs[ai][m] = row_rstd(part, row0 + ai * HALF + m * 16, fq);
}
struct EpiSwiGLU {
    static constexpr bool PERM = true; static constexpr bool CINIT = false; static constexpr int NST = 8;
    bf16* H; const float* ssq;
    static constexpr bool RSTD = true;
    __device__ __forceinline__ void rs_fill(const Unit& u, int wr, int fr, int fq, LAS float* rsl) const { rstd_fill(ssq, u.pm * BM + wr * 64 + fr, fq, rsl); }
    __device__ __forceinline__ void operator()(const Acc& acc, const Unit& u, int wr, int wc, int fr, int fq, const float (&rsv)[2][4]) const {
        const int row0 = u.pm * BM + wr * 64 + fr, col0 = u.pn * 128 + wc * 32 + 8 * fq;
#pragma unroll
        for (int ai = 0; ai < 2; ++ai)
#pragma unroll
            for (int m = 0; m < 4; ++m) {
                const float rs = rsv[ai][m];
                f32x4 v0, v1;
#pragma unroll
                for (int j = 0; j < 4; ++j) { v0[j] = siluf_(acc[ai][0][m][0][j] * rs) * (acc[ai][1][m][0][j] * rs); v1[j] = siluf_(acc[ai][0][m][1][j] * rs) * (acc[ai][1][m][1][j] * rs); }
                *(v4u*)(H + (size_t)(row0 + ai * HALF + m * 16) * DFFP + col0) = pack8(v0, v1);
            }
    }
};
struct EpiResid {
    static constexpr bool PERM = true, RSTD = false, CINIT = true; static constexpr int NST = 0;
    bf16* xb; float scale, iscale; bool dry; float* ssq;
    __device__ __forceinline__ void cinit(Acc& acc, const Unit& u, int wr, int wc, int fr, int fq) const {
        const int row0 = u.pm * BM + wr * 64 + fr, col0 = u.pn * BM + wc * 32 + 8 * fq;
#pragma unroll
        for (int ai = 0; ai < 2; ++ai)
#pragma unroll
            for (int m = 0; m < 4; ++m) { const size_t off = (size_t)(row0 + ai * HALF + m * 16) * DMODEL + col0;
#pragma unroll
                for (int bj = 0; bj < 2; ++bj) { const v4u w = *(const v4u*)(xb + off + bj * HALF);
                    acc[ai][bj][m][0] = (f32x4){bflo(w.x), bfhi(w.x), bflo(w.y), bfhi(w.y)} * iscale; acc[ai][bj][m][1] = (f32x4){bflo(w.z), bfhi(w.z), bflo(w.w), bfhi(w.w)} * iscale; } }
    }
    __device__ __forceinline__ void operator()(const Acc& acc, const Unit& u, int wr, int wc, int fr, int fq, const float (&)[2][4]) const {
        const int row0 = u.pm * BM + wr * 64 + fr, col0 = u.pn * BM + wc * 32 + 8 * fq;
#pragma unroll
        for (int ai = 0; ai < 2; ++ai)
#pragma unroll
            for (int m = 0; m < 4; ++m) { const int row = row0 + ai * HALF + m * 16; const size_t off = (size_t)row * DMODEL + col0; float ss = 0.f;
#pragma unroll
                for (int bj = 0; bj < 2; ++bj) {
                    const f32x4 v0 = acc[ai][bj][m][0] * scale, v1 = acc[ai][bj][m][1] * scale;
                    ss += (v0[0] * v0[0] + v0[1] * v0[1]) + (v0[2] * v0[2] + v0[3] * v0[3]) + (v1[0] * v1[0] + v1[1] * v1[1]) + (v1[2] * v1[2] + v1[3] * v1[3]);
                    if (!dry) *(v4u*)(xb + off + bj * HALF) = pack8(v0, v1); }
                ss = xadd<16>(ss); ss = xadd<32>(ss);
                if (fq == 0 && !dry) ssq[(size_t)row * 16 + u.pn * 4 + wc] = ss; }
    }
};
struct EpiInProj {
    static constexpr bool PERM = true; static constexpr bool CINIT = false; static constexpr int NST = 16;
    bf16* P; const float* rope; const float* la_bias; const float* ssq;
    static constexpr bool RSTD = true;
    __device__ __forceinline__ void rs_fill(const Unit& u, int wr, int fr, int fq, LAS float* rsl) const { rstd_fill(ssq, u.pm * BM + wr * 64 + fr, fq, rsl); }
    __device__ __forceinline__ void operator()(const Acc& acc, const Unit& u, int wr, int wc, int fr, int fq, const float (&rsv)[2][4]) const {
        const int row0 = u.pm * BM + wr * 64 + fr; const int pn = u.pn;
        if (pn == 10 || pn == 11) {
            const float sc = (pn == 11) ? 0.125f : 1.0f;
#pragma unroll
            for (int ai = 0; ai < 2; ++ai)
#pragma unroll
                for (int m = 0; m < 4; ++m) { const int row = row0 + ai * HALF + m * 16; const int pos = row & (SEQ - 1); const float rs = rsv[ai][m] * sc;
                    const f32x4* cs = (const f32x4*)(rope + ((size_t)pos * 32 + 8 * fq) * 2);
                    f32x4 o1[2], o2[2];
#pragma unroll
                    for (int n = 0; n < 2; ++n) { const f32x4 c01 = cs[2 * n], c23 = cs[2 * n + 1];
                        const float co[4] = {c01[0], c01[2], c23[0], c23[2]}, si[4] = {c01[1], c01[3], c23[1], c23[3]};
#pragma unroll
                        for (int j = 0; j < 4; ++j) { const float t1 = acc[ai][0][m][n][j], t2 = acc[ai][1][m][n][j]; o1[n][j] = (t1 * co[j] - t2 * si[j]) * rs; o2[n][j] = (t1 * si[j] + t2 * co[j]) * rs; } }
                    bf16* rowp = P + (size_t)row * PJ + pn * BM + wc * 64 + 8 * fq;
                    *(v4u*)(rowp) = pack8(o1[0], o1[1]); *(v4u*)(rowp + 32) = pack8(o2[0], o2[1]); }
            return;
        }
        const int col0 = pn * BM + wc * 32 + 8 * fq;
        if (pn == 18) {
            f32x4 bv[2][2];
            int bo = wc * 32 + 8 * fq; asm volatile("" : "+v"(bo));
#pragma unroll
            for (int bj = 0; bj < 2; ++bj)
#pragma unroll
                for (int n = 0; n < 2; ++n) bv[bj][n] = *(const f32x4*)(la_bias + bo + bj * HALF + 4 * n);
#pragma unroll
            for (int ai = 0; ai < 2; ++ai)
#pragma unroll
                for (int m = 0; m < 4; ++m) { bf16* rowp = P + (size_t)(row0 + ai * HALF + m * 16) * PJ + col0; const float rs = rsv[ai][m];
#pragma unroll
                    for (int bj = 0; bj < 2; ++bj) { f32x4 v[2];
#pragma unroll
                        for (int n = 0; n < 2; ++n)
#pragma unroll
                            for (int j = 0; j < 4; ++j) { const float x = acc[ai][bj][m][n][j] * rs + bv[bj][n][j]; v[n][j] = (fminf(x, 0.f) - 0.6931471805599453f * __builtin_amdgcn_logf(1.0f + fast_exp2(-1.4426950408889634f * fabsf(x)))) * (1.0f / 16.0f); }
                        *(v4u*)(rowp + bj * HALF) = pack8(v[0], v[1]); } }
            return;
        }
        const bool silu = (pn >= 2 && pn <= 5);
        const float sc = (pn <= 1) ? C2 : (pn == 14 ? 0.125f : 1.0f);
#pragma unroll
        for (int ai = 0; ai < 2; ++ai)
#pragma unroll
            for (int m = 0; m < 4; ++m) { bf16* rowp = P + (size_t)(row0 + ai * HALF + m * 16) * PJ + col0; const float rs = rsv[ai][m] * sc;
#pragma unroll
                for (int bj = 0; bj < 2; ++bj) { f32x4 v0 = acc[ai][bj][m][0] * rs, v1 = acc[ai][bj][m][1] * rs;
                    if (silu) {
#pragma unroll
                        for (int j = 0; j < 4; ++j) { v0[j] = siluf_(v0[j]); v1[j] = siluf_(v1[j]); } }
                    *(v4u*)(rowp + bj * HALF) = pack8(v0, v1); } }
    }
};
struct EpiGates {
    static constexpr bool PERM = true; static constexpr bool CINIT = false; static constexpr int NST = 16;
    bf16* P; const float* ssq;
    static constexpr bool RSTD = true;
    __device__ __forceinline__ void rs_fill(const Unit& u, int wr, int fr, int fq, LAS float* rsl) const { rstd_fill(ssq, u.pm * BM + wr * 64 + fr, fq, rsl); }
    __device__ __forceinline__ void operator()(const Acc& acc, const Unit& u, int wr, int wc, int fr, int fq, const float (&rsv)[2][4]) const {
        const int row0 = u.pm * BM + wr * 64 + fr, col0 = C_GATE + u.pn * BM + wc * 32 + 8 * fq;
#pragma unroll
        for (int ai = 0; ai < 2; ++ai)
#pragma unroll
            for (int m = 0; m < 4; ++m) { bf16* rowp = P + (size_t)(row0 + ai * HALF + m * 16) * PJ + col0; const float rs = rsv[ai][m];
#pragma unroll
                for (int bj = 0; bj < 2; ++bj) { f32x4 v0, v1;
#pragma unroll
                    for (int j = 0; j < 4; ++j) { v0[j] = sigmoidf_(acc[ai][bj][m][0][j] * rs); v1[j] = sigmoidf_(acc[ai][bj][m][1][j] * rs); }
                    *(v4u*)(rowp + bj * HALF) = pack8(v0, v1); } }
    }
};
struct EpiMerge {
    static constexpr bool PERM = true; static constexpr bool CINIT = false; static constexpr int NST = 16;
    const bf16* P; bf16* O;
    static constexpr bool RSTD = false;
    __device__ __forceinline__ void operator()(const Acc& acc, const Unit& u, int wr, int wc, int fr, int fq, const float (&)[2][4]) const {
        const int row0 = u.pm * BM + wr * 64 + fr, col0 = u.pn * BM + wc * 32 + 8 * fq, gcol0 = C_GATE + u.z * DMODEL + col0;
        const bool add = u.z > 0;
#pragma unroll
        for (int ai = 0; ai < 2; ++ai) {
            v4u gw[4][2], pw[4][2];
#pragma unroll
            for (int m = 0; m < 4; ++m)
#pragma unroll
                for (int bj = 0; bj < 2; ++bj) { const size_t row = (size_t)(row0 + ai * HALF + m * 16);
                    gw[m][bj] = *(const v4u*)(P + row * PJ + gcol0 + bj * HALF);
                    pw[m][bj] = add ? *(const v4u*)(O + row * DMODEL + col0 + bj * HALF) : (v4u){0u, 0u, 0u, 0u}; }
#pragma unroll
            for (int m = 0; m < 4; ++m)
#pragma unroll
                for (int bj = 0; bj < 2; ++bj) { const size_t row = (size_t)(row0 + ai * HALF + m * 16);
                    const v4u g = gw[m][bj], p = pw[m][bj];
                    f32x4 v0 = acc[ai][bj][m][0], v1 = acc[ai][bj][m][1];
                    v0[0] = v0[0] * bflo(g.x) + bflo(p.x); v0[1] = v0[1] * bfhi(g.x) + bfhi(p.x); v0[2] = v0[2] * bflo(g.y) + bflo(p.y); v0[3] = v0[3] * bfhi(g.y) + bfhi(p.y);
                    v1[0] = v1[0] * bflo(g.z) + bflo(p.z); v1[1] = v1[1] * bfhi(g.z) + bfhi(p.z); v1[2] = v1[2] * bflo(g.w) + bflo(p.w); v1[3] = v1[3] * bfhi(g.w) + bfhi(p.w);
                    *(v4u*)(O + row * DMODEL + col0 + bj * HALF) = pack8(v0, v1); }
        }
    }
};
}

#define XB_TMO      128
#define XB_XCNT(j)  (256  + 64 * (j))
#define XB_XSUB(j)  (1280 + 64 * (j))
#define XB_XGEN(j)  (2304 + 64 * (j))
#define XB_TOP      3328
#define XB_TOPGEN   3392
#define XCD_BAR_WORDS 3456
#define XB_SPIN_CAP (1u << 23)
__device__ __forceinline__ unsigned xb_ld(unsigned* p)              { return __hip_atomic_load(p, __ATOMIC_RELAXED, __HIP_MEMORY_SCOPE_AGENT); }
__device__ __forceinline__ unsigned xb_add(unsigned* p, unsigned v) { return __hip_atomic_fetch_add(p, v, __ATOMIC_RELAXED, __HIP_MEMORY_SCOPE_AGENT); }
__device__ __forceinline__ unsigned xb_xcc_id() { return (unsigned)__builtin_amdgcn_s_getreg((3 << 11) | 20) & 0xFu; }
#define XB_SPIN(cond, bar) do { unsigned _sp = 0; while (cond) { __builtin_amdgcn_s_sleep(1); \
    if ((++_sp & 255u) == 0u) { if (xb_ld(&(bar)[XB_TMO])) break; if (_sp > XB_SPIN_CAP) { atomicAdd(&(bar)[XB_TMO], 1u); break; } } } } while (0)
struct XcdBarrier { unsigned* bar; unsigned x; volatile LAS unsigned* st; };
__device__ __forceinline__ XcdBarrier xcd_barrier_post(unsigned* bar, volatile LAS unsigned* st) {
    XcdBarrier b; b.bar = bar; b.x = xb_xcc_id(); b.st = st;
    if (threadIdx.x == 0) (void)xb_add(&bar[XB_XCNT(b.x)], 1u);
    return b;
}
__device__ __forceinline__ void xcd_barrier_complete(unsigned* bar, unsigned x, unsigned& nloc, unsigned& nx) {
    const unsigned G = gridDim.x * gridDim.y * gridDim.z;
    unsigned sum, cnt, mine, sp = 0u;
    for (;;) {
        sum = 0u; cnt = 0u; mine = 0u;
#pragma unroll
        for (unsigned j = 0; j < 16; ++j) { const unsigned c = xb_ld(&bar[XB_XCNT(j)]); sum += c; cnt += (c > 0u) ? 1u : 0u; mine = (j == x) ? c : mine; }
        if (sum == G) break;
        __builtin_amdgcn_s_sleep(1);
        if ((++sp & 255u) == 0u) { if (xb_ld(&bar[XB_TMO])) break; if (sp > XB_SPIN_CAP) { atomicAdd(&bar[XB_TMO], 1u); break; } }
    }
    nloc = mine > 0u ? mine : 1u; nx = cnt > 0u ? cnt : 1u;
}
__device__ __forceinline__ void xcd_barrier(const XcdBarrier& b) {
    asm volatile("s_waitcnt vmcnt(0)" ::: "memory");
    __syncthreads();
    if (threadIdx.x == 0) {
        unsigned* bar = b.bar;
        __builtin_amdgcn_s_waitcnt(0);
        unsigned nloc = b.st[0], nx = b.st[1];
        if (nloc == 0u) { xcd_barrier_complete(bar, b.x, nloc, nx); b.st[0] = nloc; b.st[1] = nx; }
        const unsigned old = xb_add(&bar[XB_XSUB(b.x)], 1u);
        const unsigned gen = old / nloc;
        if (old + 1u == (gen + 1u) * nloc) {
            __builtin_amdgcn_fence(__ATOMIC_RELEASE, "agent");
            asm volatile("s_waitcnt vmcnt(0)" ::: "memory");
            const unsigned og = xb_add(&bar[XB_TOP], 1u);
            const unsigned tg = og / nx;
            if (og + 1u == (tg + 1u) * nx) xb_add(&bar[XB_TOPGEN], 1u);
            else XB_SPIN(xb_ld(&bar[XB_TOPGEN]) == tg, bar);
            __builtin_amdgcn_fence(__ATOMIC_ACQUIRE, "agent");
            xb_add(&bar[XB_XGEN(b.x)], 1u);
            asm volatile("s_waitcnt vmcnt(0)" ::: "memory");
        } else {
            XB_SPIN(xb_ld(&bar[XB_XGEN(b.x)]) == gen, bar);
            __builtin_amdgcn_fence(__ATOMIC_ACQUIRE, "agent");
            asm volatile("s_waitcnt vmcnt(0)" ::: "memory");
        }
    }
    __syncthreads();
}

struct Args {
    const float* x; const float* ffn1_norm; const float* ffn1_w1; const float* ffn1_w3; const float* ffn1_w2; const float* mix_norm; const float* w_in; const float* lam_qk;
    const float* da_norm; const float* ret_norm; const float* gla_a2; const float* gla_ab; const float* gla_norm; const float* wb_a; const float* wb_b; const float* wb_c; const float* w_out;
    const float* ffn2_norm; const float* ffn2_w1; const float* ffn2_w3; const float* ffn2_w2; const float* final_norm;
    float* out; unsigned char* ws; int ph_lo, ph_hi;
};
struct Frame { LAS unsigned char* lds; unsigned char* ws; int vcu, G, wave; };

__device__ __constant__ float LAM_INIT[4] = {0.2f, 0.35550906759f, 0.47071301834f, 0.55605820416f};

__device__ __forceinline__ void conv_tr(const float* src, int ldsrc, bf16* dst, int lddst, LAS float* scr, int lane, bool zero, const float* gain = nullptr) {
    if (zero) {
        const int c = lane & 7;
#pragma unroll
        for (int j = 0; j < 4; ++j) { const int n = (lane >> 3) + 8 * j; *(v4u*)(dst + (size_t)n * lddst + 8 * c) = (v4u){0u, 0u, 0u, 0u}; }
        return;
    }
    const int n4 = lane & 7, kg = lane >> 3;
    f32x4 tv[8];
#pragma unroll
    for (int j = 0; j < 8; ++j) tv[j] = *(const f32x4*)(src + (size_t)(8 * kg + j) * ldsrc + 4 * n4);
    if (gain) { const f32x4 g0 = *(const f32x4*)(gain + 8 * kg), g1 = *(const f32x4*)(gain + 8 * kg + 4);
#pragma unroll
        for (int j = 0; j < 4; ++j) { tv[j] = tv[j] * g0[j]; tv[4 + j] = tv[4 + j] * g1[j]; } }
#pragma unroll
    for (int i = 0; i < 4; ++i) { v4u o; o.x = pk2(tv[0][i], tv[1][i]); o.y = pk2(tv[2][i], tv[3][i]); o.z = pk2(tv[4][i], tv[5][i]); o.w = pk2(tv[6][i], tv[7][i]);
        *(v4u*)(dst + (size_t)(4 * n4 + i) * lddst + 8 * kg) = o; }
    (void)scr;
}
__device__ __forceinline__ int inproj_src_col(int g) {
    const int c = 32 * g;
    if (c < 512) return O_AQ + c;
    if (c < 1024) return O_RG + (c - 512);
    if (c < 1536) return O_CG + (c - 1024);
    if (c < 2048) return O_AK + (c - 1536);
    if (c < 2560) return O_AV + (c - 2048);
    if (c < 3072) { const int base = (c < 2816) ? O_RQ : O_RK; const int cc = (c < 2816) ? c - 2560 : c - 2816; const int half = cc >> 7, head = (cc & 127) >> 5; return base + head * 64 + 32 * half; }
    if (c < 3584) return O_RV + (c - 3072);
    if (c < 3840) return O_CQ + (c - 3584);
    if (c < 4096) return O_CK + (c - 3840);
    return O_CV + (c - 4096);
}
constexpr int I_W13 = 16 * 176, I_W2 = 44 * 32, I_WIN = 16 * 144, I_WG = 16 * 96, I_WB = 8 * 32, I_WO = 16 * 32, I_LA = 16 * 8;
constexpr int I_TOTAL = 2 * (I_W13 + I_W2) + I_WIN + I_WG + 3 * I_WB + I_WO + I_LA;

__device__ __forceinline__ void conv_w13(const float* w1, const float* w3, bf16* dst, int r, LAS float* scr, int lane, const float* gain) {
    const int kb = r / 176, g = r % 176, pn = g >> 3, half = (g >> 2) & 1, jj = g & 3, hc0 = pn * 128 + jj * 32;
    const float* src = (half ? w3 : w1) + (size_t)(64 * kb) * DFF + hc0;
    conv_tr(src, DFF, dst + (size_t)(32 * g) * DMODEL + 64 * kb, DMODEL, scr, lane, hc0 >= DFF, gain + 64 * kb);
}
__device__ __forceinline__ void conv_w2(const float* w2, bf16* dst, int r, LAS float* scr, int lane) {
    const int kb = r / 32, nb = r % 32;
    conv_tr(w2 + (size_t)(64 * kb) * DMODEL + 32 * nb, DMODEL, dst + (size_t)(32 * nb) * DFFP + 64 * kb, DFFP, scr, lane, kb >= 43);
}

__device__ __forceinline__ void conv_item(const Args& a, unsigned char* wd, int l, int it, int lane) {
    LAS float* scr = nullptr;
    const float* win = uni(a.w_in) + (size_t)l * DMODEL * INC;
    const float* gm = uni(a.mix_norm) + l * DMODEL;
    int r = it;
    if (r < I_W13) { conv_w13(uni(a.ffn1_w1) + (size_t)l * DMODEL * DFF, uni(a.ffn1_w3) + (size_t)l * DMODEL * DFF, (bf16*)(wd + W_13A), r, scr, lane, uni(a.ffn1_norm) + l * DMODEL); return; } r -= I_W13;
    if (r < I_W2) { conv_w2(uni(a.ffn1_w2) + (size_t)l * DFF * DMODEL, (bf16*)(wd + W_2A), r, scr, lane); return; } r -= I_W2;
    if (r < I_W13) { conv_w13(uni(a.ffn2_w1) + (size_t)l * DMODEL * DFF, uni(a.ffn2_w3) + (size_t)l * DMODEL * DFF, (bf16*)(wd + W_13B), r, scr, lane, uni(a.ffn2_norm) + l * DMODEL); return; } r -= I_W13;
    if (r < I_W2) { conv_w2(uni(a.ffn2_w2) + (size_t)l * DFF * DMODEL, (bf16*)(wd + W_2B), r, scr, lane); return; } r -= I_W2;
    if (r < I_WIN) { const int kb = r / 144, g = r % 144;
        conv_tr(win + (size_t)(64 * kb) * INC + inproj_src_col(g), INC, (bf16*)(wd + W_IN) + (size_t)(32 * g) * DMODEL + 64 * kb, DMODEL, scr, lane, false, gm + 64 * kb); return; } r -= I_WIN;
    if (r < I_WG) { const int kb = r / 96, g = r % 96;
        conv_tr(win + (size_t)(64 * kb) * INC + O_GATE + 32 * g, INC, (bf16*)(wd + W_G) + (size_t)(32 * g) * DMODEL + 64 * kb, DMODEL, scr, lane, false, gm + 64 * kb); return; } r -= I_WG;
    if (r < 3 * I_WB) { const int z = r / I_WB, rr = r % I_WB, kb = rr / 32, nb = rr % 32;
        const float* wb = uni(z == 0 ? a.wb_a : (z == 1 ? a.wb_b : a.wb_c)) + (size_t)l * 512 * DMODEL;
        conv_tr(wb + (size_t)(64 * kb) * DMODEL + 32 * nb, DMODEL, (bf16*)(wd + W_B) + (size_t)z * DMODEL * 512 + (size_t)(32 * nb) * 512 + 64 * kb, 512, scr, lane, false); return; } r -= 3 * I_WB;
    if (r < I_WO) { const int kb = r / 32, nb = r % 32;
        conv_tr(uni(a.w_out) + (size_t)l * DMODEL * DMODEL + (size_t)(64 * kb) * DMODEL + 32 * nb, DMODEL, (bf16*)(wd + W_O) + (size_t)(32 * nb) * DMODEL + 64 * kb, DMODEL, scr, lane, false); return; }
}
__device__ __forceinline__ void conv_la_item(const Args& a, unsigned char* wd, int l, int r, int lane) {
    const float* win = uni(a.w_in) + (size_t)l * DMODEL * INC;
    const float* gm = uni(a.mix_norm) + l * DMODEL;
    const int kb = r / 8, cb = r % 8, c8 = lane & 7; const float* a2 = uni(a.gla_a2) + (size_t)l * 16 * 256;
    const float* wrow = win + (size_t)(64 * kb + 8 * c8) * INC + O_CA;
#pragma unroll 1
    for (int j = 0; j < 4; ++j) { const int c = 32 * cb + (lane >> 3) + 8 * j;
        float av[16];
#pragma unroll
        for (int t = 0; t < 16; ++t) av[t] = a2[t * 256 + c];
        float o[8];
#pragma unroll
        for (int q = 0; q < 8; ++q) {
            float acc = 0.f;
#pragma unroll
            for (int t4 = 0; t4 < 4; ++t4) { const f32x4 w4 = *(const f32x4*)(wrow + (size_t)q * INC + 4 * t4);
                acc += (w4[0] * av[4 * t4] + w4[1] * av[4 * t4 + 1]) + (w4[2] * av[4 * t4 + 2] + w4[3] * av[4 * t4 + 3]); }
            o[q] = acc * gm[64 * kb + 8 * c8 + q]; }
        v4u w; w.x = pk2(o[0], o[1]); w.y = pk2(o[2], o[3]); w.z = pk2(o[4], o[5]); w.w = pk2(o[6], o[7]);
        *(v4u*)((bf16*)(wd + W_IN) + (size_t)(C_LA + c) * DMODEL + 64 * kb + 8 * c8) = w; }
}
__device__ __forceinline__ void conv_lam(const Args& a, unsigned char* ws, int l, int lane) {
    const float* lq = uni(a.lam_qk) + (size_t)l * 256;
    const float s1 = wave_sum(lq[lane] * lq[64 + lane]), s2 = wave_sum(lq[128 + lane] * lq[192 + lane]);
    if (lane == 0) ((float*)(ws + WS_LAM))[l] = __expf(s1) - __expf(s2) + LAM_INIT[l];
}
__device__ __forceinline__ void phase_conv(const Args& a, const Frame& F, int l, unsigned char* wd) {
    const int tid = opaque_tid(F.wave), lane = tid & 63, wave = F.wave;
    const int gw = F.vcu * 8 + wave, NGW = F.G * 8;
    for (int it = gw; it < I_TOTAL - I_LA; it += NGW) conv_item(a, wd, l, it, lane);
    for (int r = gw; r < I_LA; r += NGW) conv_la_item(a, wd, l, r, lane);
    if (gw == 0) conv_lam(a, F.ws, l, lane);
}

__device__ __forceinline__ void phase_rope(const Frame& F) {
    const int tid = opaque_tid(F.wave);
    float* rt = (float*)(F.ws + WS_ROPE);
    for (int idx = F.vcu * 512 + tid; idx < SEQ * 32; idx += F.G * 512) {
        const int pos = idx >> 5, i = idx & 31;
        const float inv = exp2f(-(float)i * (13.287712379549449f / 32.0f));
        const float ang = (float)pos * inv;
        double rev = (double)ang * 0.15915494309189535; rev -= floor(rev);
        const float rf = (float)rev;
        rt[2 * idx] = __builtin_amdgcn_cosf(rf); rt[2 * idx + 1] = __builtin_amdgcn_sinf(rf);
    }
}
__device__ __forceinline__ void phase_prep(const Frame& F, const float* x, bf16* xb, float* ssq) {
    const int tid = opaque_tid(F.wave), lane = tid & 63, wave = F.wave;
    const int gw = F.vcu * 8 + wave, NGW = F.G * 8;
    for (int m = gw; m < M; m += NGW) {
        const f32x4* xr = (const f32x4*)(x + (size_t)m * DMODEL) + lane;
        f32x4 v[4]; float s = 0.f;
#pragma unroll
        for (int j = 0; j < 4; ++j) { v[j] = xr[64 * j]; s += (v[j][0] * v[j][0] + v[j][1] * v[j][1]) + (v[j][2] * v[j][2] + v[j][3] * v[j][3]); }
        s = wave_sum(s);
        v2u* o8 = (v2u*)(xb + (size_t)m * DMODEL) + lane;
#pragma unroll
        for (int j = 0; j < 4; ++j) { v2u w; w.x = pk2(v[j][0], v[j][1]); w.y = pk2(v[j][2], v[j][3]); o8[64 * j] = w; }
        if (lane < 16) ssq[(size_t)m * 16 + lane] = (lane == 0) ? s : 0.f;
    }
}
__device__ __forceinline__ void phase_final_norm(const Frame& F, const bf16* xb, float* out, const float* gain, const float* ssq) {
    const int tid = opaque_tid(F.wave), lane = tid & 63, wave = F.wave;
    const int gw = F.vcu * 8 + wave, NGW = F.G * 8;
    f32x4 g[4];
#pragma unroll
    for (int j = 0; j < 4; ++j) g[j] = *((const f32x4*)gain + lane + 64 * j);
    for (int m = gw; m < M; m += NGW) {
        const v2u* xr = (const v2u*)(xb + (size_t)m * DMODEL) + lane; f32x4* orow = (f32x4*)(out + (size_t)m * DMODEL) + lane;
        float sq = ssq[(size_t)m * 16 + (lane & 15)];
        sq = xadd<1>(sq); sq = xadd<2>(sq); sq = xadd<4>(sq); sq = xadd<8>(sq);
        const float rstd = __builtin_amdgcn_rsqf(sq * (1.0f / DMODEL) + EPS);
#pragma unroll
        for (int j = 0; j < 4; ++j) { const v2u w = xr[64 * j]; orow[64 * j] = (f32x4){bflo(w.x), bfhi(w.x), bflo(w.y), bfhi(w.y)} * rstd * g[j]; }
    }
}

__device__ __forceinline__ float ret_logg(int h) { return h == 0 ? -0.031748698314580301f : (h == 1 ? -0.015748356968139168f : (h == 2 ? -0.0078431774610258928f : -0.0039138993211363287f)); }

__device__ __forceinline__ void chunk_cum(LAS float* cum, LAS float* tot, const bf16* prow, int mix, int h, int tid) {
    const int d = tid & 63, seg = tid >> 6;
    if (mix == 0) {
        const float lg = ret_logg(h);
#pragma unroll
        for (int x = 0; x < 8; ++x) { const int t = seg * 8 + x; cum[t * 64 + d] = (float)(t + 1) * lg; }
        __syncthreads(); __syncthreads();
        return;
    }
    float run = 0.f;
#pragma unroll
    for (int x = 0; x < 8; ++x) { const int t = seg * 8 + x; run += bf2f(prow[(size_t)t * PJ + C_LA + h * 64 + d]); cum[t * 64 + d] = run; }
    tot[seg * 64 + d] = run;
    __syncthreads();
    float off = 0.f;
    for (int s = 0; s < seg; ++s) off += tot[s * 64 + d];
#pragma unroll
    for (int x = 0; x < 8; ++x) { const int t = seg * 8 + x; cum[t * 64 + d] += off; }
    __syncthreads();
}

__device__ __forceinline__ void phase_r2(const Args& a, const Frame& F) {
    unsigned char* ws = F.ws; unsigned* ST = (unsigned*)(ws + WS_ST); const float* DEC = (const float*)(ws + WS_DEC);
    const int tid = opaque_tid(F.wave);
    for (int gt = F.vcu * 512 + tid; gt < 32 * 4096; gt += F.G * 512) {
        const int w = gt & 4095, seq = gt >> 12, mix = seq >> 4, bh = seq & 15, h = bh & 3, d0 = (2 * w) & 63;
        unsigned* p = ST + (size_t)seq * 128 * 4096 + w;
        const float* dp = DEC + (size_t)bh * 128 * 64 + d0;
        float s0 = 0.f, s1 = 0.f;
        const float cret = __expf(64.0f * ret_logg(h));
        unsigned ua[8], ub[8]; f32x2 da[8], db[8];
#define R2_LOAD(uu, dd, n0_) do { _Pragma("unroll") for (int i = 0; i < 8; ++i) { uu[i] = p[(size_t)((n0_) + i) * 4096]; dd[i] = mix ? *(const f32x2*)(dp + (size_t)((n0_) + i) * 64) : (f32x2){cret, cret}; } } while (0)
#define R2_SCAN(uu, dd, n0_) do { _Pragma("unroll") for (int i = 0; i < 8; ++i) { p[(size_t)((n0_) + i) * 4096] = pk2(s0, s1); s0 = s0 * dd[i][0] + bflo(uu[i]); s1 = s1 * dd[i][1] + bfhi(uu[i]); } } while (0)
        R2_LOAD(ua, da, 0);
        for (int n0 = 0; n0 < 128; n0 += 16) {
            R2_LOAD(ub, db, n0 + 8);
            R2_SCAN(ua, da, n0);
            if (n0 + 16 < 128) R2_LOAD(ua, da, n0 + 16);
            R2_SCAN(ub, db, n0 + 8);
        }
#undef R2_LOAD
#undef R2_SCAN
    }
}

namespace lin {
typedef float f32x16 __attribute__((ext_vector_type(16)));
typedef short v4i16_t __attribute__((ext_vector_type(4)));
constexpr int L_V = 0, L_S = 16384, L_QE = 32768, L_KE = 40960, L_KD = 40960, L_CUM = 49152, L_TOT = 65536, L_OB = 67584, OB_LD = 132, L_SIN = 101376, L_QE2 = 117760;
__device__ __forceinline__ int crow(int r, int hi) { return (r & 3) + 8 * (r >> 2) + 4 * hi; }
__device__ __forceinline__ bf16x8 trfrag(const LAS unsigned char* p) {
    const v4i16_t lo = __builtin_amdgcn_ds_read_tr16_b64_v4i16((LAS v4i16_t*)(p)), hh = __builtin_amdgcn_ds_read_tr16_b64_v4i16((LAS v4i16_t*)(p + 512));
    return (bf16x8){lo[0], lo[1], lo[2], lo[3], hh[0], hh[1], hh[2], hh[3]};
}
__device__ __forceinline__ void unpack8(const v4u w, float (&f)[8]) { f[0] = bflo(w.x); f[1] = bfhi(w.x); f[2] = bflo(w.y); f[3] = bfhi(w.y); f[4] = bflo(w.z); f[5] = bfhi(w.z); f[6] = bflo(w.w); f[7] = bfhi(w.w); }
__device__ __forceinline__ v4u pack8f(const float (&f)[8]) { v4u w; w.x = pk2(f[0], f[1]); w.y = pk2(f[2], f[3]); w.z = pk2(f[4], f[5]); w.w = pk2(f[6], f[7]); return w; }
__device__ __forceinline__ void dma_v(LAS unsigned char* lds, const bf16* vbase, int wid, int lane) {
    const bf16* vsrc = vbase + (size_t)(16 * (wid & 3) + (lane >> 2)) * PJ + (wid >> 2) * 32 + (lane & 3) * 8;
    __builtin_amdgcn_global_load_lds((const unsigned*)(vsrc), (LAS unsigned*)(lds + L_V + wid * 1024), 16, 0, 0);
    __builtin_amdgcn_global_load_lds((const unsigned*)(vsrc + 64), (LAS unsigned*)(lds + L_V + wid * 1024 + 8192), 16, 0, 0);
}
}

struct RFetch { v4u qw, kw, g0, g1; f32x4 pn0, pn1; unsigned short la[8]; };
__device__ __forceinline__ void chunk_cum_regs(LAS float* cum, LAS float* tot, const unsigned short (&la)[8], int mix, int h, int tid) {
    const int d = tid & 63, seg = tid >> 6;
    if (mix == 0) {
        const float lg = ret_logg(h);
#pragma unroll
        for (int x = 0; x < 8; ++x) { const int t = seg * 8 + x; cum[t * 64 + d] = (float)(t + 1) * lg; }
        __syncthreads(); __syncthreads();
        return;
    }
    float run = 0.f;
#pragma unroll
    for (int x = 0; x < 8; ++x) { const int t = seg * 8 + x; run += bf2f(la[x]); cum[t * 64 + d] = run; }
    tot[seg * 64 + d] = run;
    __syncthreads();
    float off = 0.f;
    for (int s = 0; s < seg; ++s) off += tot[s * 64 + d];
#pragma unroll
    for (int x = 0; x < 8; ++x) { const int t = seg * 8 + x; cum[t * 64 + d] += off; }
    __syncthreads();
}

__device__ __forceinline__ void phase_r1_mfma(const Args& a, const Frame& F) {
    using namespace lin;
    unsigned char* ws = F.ws; const bf16* proj = (const bf16*)(ws + WS_BIG); bf16* ST = (bf16*)(ws + WS_ST); float* DEC = (float*)(ws + WS_DEC);
    bf16* TOT = (bf16*)(ws + WS_TOT); float* DR = (float*)(ws + WS_DR);
    const int tid = opaque_tid(F.wave), lane = tid & 63, wid = F.wave, r32 = lane & 31, hi = lane >> 5;
    LAS unsigned char* lds = F.lds; LAS float* cum = (LAS float*)(lds + L_CUM); LAS float* tot = (LAS float*)(lds + L_TOT);
    const int t = tid >> 3, c = tid & 7;
    const int eb = wid >> 1, db = wid & 1, dcol = 32 * db + r32;
#define R1_FETCH(u_, f_) do { const int mix_ = (u_) >> 11, bh_ = ((u_) >> 7) & 15, n_ = (u_) & 127, h_ = bh_ & 3; \
        const bf16* prow_ = proj + (size_t)((bh_ >> 2) * SEQ + n_ * 64) * PJ; \
        f_.kw = *(const v4u*)(prow_ + (size_t)t * PJ + (mix_ ? C_CK : C_RK) + h_ * 64 + 8 * c); \
        if (mix_) { _Pragma("unroll") for (int x = 0; x < 8; ++x) f_.la[x] = prow_[(size_t)((tid >> 6) * 8 + x) * PJ + C_LA + h_ * 64 + (tid & 63)]; } \
        dma_v(lds, prow_ + (mix_ ? C_CV : C_RV) + h_ * 128, wid, lane); } while (0)
    RFetch cur; cur.qw = cur.g0 = cur.g1 = (v4u){0u, 0u, 0u, 0u};
    int v = F.vcu;
    if (v < 256) R1_FETCH(v * 16, cur);
    for (; v < 256; v += F.G) {
        const int sq = v >> 3, run = v & 7, mix = sq >> 4, bh = sq & 15, h = bh & 3;
        const float cret = __expf(64.0f * ret_logg(h));
        f32x16 state; float pst = 1.0f;
#pragma unroll
        for (int r = 0; r < 16; ++r) state[r] = 0.f;
#pragma unroll 1
        for (int i = 0; i < 16; ++i) {
            const int u = v * 16 + i, n = run * 16 + i;
            chunk_cum_regs(cum, tot, cur.la, mix, h, tid);
            float kf[8]; unpack8(cur.kw, kf);
            { const f32x4 c0 = *(const LAS f32x4*)(cum + t * 64 + 8 * c), c1 = *(const LAS f32x4*)(cum + t * 64 + 8 * c + 4);
              const f32x4 l0 = *(const LAS f32x4*)(cum + 63 * 64 + 8 * c), l1 = *(const LAS f32x4*)(cum + 63 * 64 + 8 * c + 4);
#pragma unroll
              for (int j = 0; j < 4; ++j) { kf[j] *= __expf(l0[j] - c0[j]); kf[4 + j] *= __expf(l1[j] - c1[j]); } }
            *(LAS v4u*)(lds + L_KD + (c >> 2) * 4096 + t * 64 + (c & 3) * 16) = pack8f(kf);
            asm volatile("s_waitcnt vmcnt(0) lgkmcnt(0)" ::: "memory"); __builtin_amdgcn_s_barrier(); asm volatile("" ::: "memory");
            const LAS unsigned char* tp = lds + ((lane >> 4) & 1) * 32 + (lane & 3) * 8 + (4 * hi + ((lane & 15) >> 2)) * 64;
            f32x16 acc;
#pragma unroll
            for (int r = 0; r < 16; ++r) acc[r] = 0.f;
#pragma unroll
            for (int ks = 0; ks < 4; ++ks) acc = __builtin_amdgcn_mfma_f32_32x32x16_bf16(trfrag(tp + L_V + eb * 4096 + ks * 1024), trfrag(tp + L_KD + db * 4096 + ks * 1024), acc, 0, 0, 0);
            const float decv = mix ? __expf(cum[63 * 64 + dcol]) : cret;
            LDS_WAIT(); __builtin_amdgcn_s_barrier(); asm volatile("" ::: "memory");
            { const int un = (i < 15) ? u + 1 : (v + F.G) * 16; if (i < 15 || v + F.G < 256) R1_FETCH(un, cur); }
            {
                LAS unsigned char* sg = lds + L_OB + wid * 2048;
#pragma unroll
                for (int r = 0; r < 16; ++r) *(LAS unsigned short*)(sg + crow(r, hi) * 64 + r32 * 2) = (unsigned short)f2bf(state[r]);
                LDS_WAIT();
                bf16* st = ST + ((size_t)(sq * 128 + n)) * 8192 + (size_t)(32 * eb) * 64 + 32 * db;
#pragma unroll
                for (int j = 0; j < 2; ++j) { const int p = lane + 64 * j, row = p >> 2, c16 = p & 3;
                    *(v4u*)(st + row * 64 + 8 * c16) = *(const LAS v4u*)(sg + row * 64 + c16 * 16); }
            }
            if (mix == 1 && eb == 0 && hi == 0) DEC[(size_t)(bh * 128 + n) * 64 + dcol] = pst;
#pragma unroll
            for (int r = 0; r < 16; ++r) state[r] = state[r] * decv + acc[r];
            pst *= decv;
        }
        bf16* tt = TOT + ((size_t)(sq * 8 + run)) * 8192 + dcol;
#pragma unroll
        for (int r = 0; r < 16; ++r) tt[(32 * eb + crow(r, hi)) * 64] = (bf16)f2bf(state[r]);
        if (eb == 0 && hi == 0) DR[(size_t)(sq * 8 + run) * 64 + dcol] = pst;
    }
#undef R1_FETCH
}

__device__ __forceinline__ void phase_r3_mfma(const Args& a, const Frame& F, int l, bool dry) {
    using namespace lin;
    unsigned char* ws = F.ws; bf16* proj = (bf16*)(ws + WS_BIG); const bf16* ST = (const bf16*)(ws + WS_ST); const float* DEC = (const float*)(ws + WS_DEC);
    const bf16* TOT = (const bf16*)(ws + WS_TOT); const float* DR = (const float*)(ws + WS_DR);
    const int tid = opaque_tid(F.wave), lane = tid & 63, wid = F.wave, r32 = lane & 31, hi = lane >> 5;
    LAS unsigned char* lds = F.lds; LAS float* cum = (LAS float*)(lds + L_CUM); LAS float* tot = (LAS float*)(lds + L_TOT); LAS float* ob = (LAS float*)(lds + L_OB);
    const int t = tid >> 3, c = tid & 7;
#define R3_FETCH(u_, f_) do { const int mix_ = (u_) >> 11, bh_ = ((u_) >> 7) & 15, n_ = (u_) & 127, h_ = bh_ & 3; \
        const bf16* prow_ = proj + (size_t)((bh_ >> 2) * SEQ + n_ * 64) * PJ; \
        f_.qw = *(const v4u*)(prow_ + (size_t)t * PJ + (mix_ ? C_CQ : C_RQ) + h_ * 64 + 8 * c); f_.kw = *(const v4u*)(prow_ + (size_t)t * PJ + (mix_ ? C_CK : C_RK) + h_ * 64 + 8 * c); \
        if (mix_) { _Pragma("unroll") for (int x = 0; x < 8; ++x) f_.la[x] = prow_[(size_t)((tid >> 6) * 8 + x) * PJ + C_LA + h_ * 64 + (tid & 63)]; \
                    const f32x4* pp_ = (const f32x4*)(DEC + (size_t)(bh_ * 128 + n_) * 64 + 8 * c); f_.pn0 = pp_[0]; f_.pn1 = pp_[1]; } \
        { const v4u* gp_ = (const v4u*)(prow_ + (size_t)t * PJ + (mix_ ? C_CG : C_RG) + h_ * 128 + 16 * c); f_.g0 = gp_[0]; f_.g1 = gp_[1]; } \
        dma_v(lds, prow_ + (mix_ ? C_CV : C_RV) + h_ * 128, wid, lane); \
        { const bf16* st_ = ST + ((size_t)((mix_ * 16 + bh_) * 128 + n_)) * 8192; \
          _Pragma("unroll") for (int i_ = 0; i_ < 2; ++i_) { const int p = wid + 8 * i_, cc = p >> 1, e0 = 64 * (p & 1); \
            __builtin_amdgcn_global_load_lds((const unsigned*)(st_ + (size_t)(e0 + lane) * 64 + cc * 8), (LAS unsigned*)(lds + L_S + cc * 2048 + e0 * 16), 16, 0, 0); } } } while (0)
    RFetch cur;
    int v = F.vcu;
    for (; v < 256; v += F.G) {
        const int sq = v >> 3, run = v & 7, mix = sq >> 4, bh = sq & 15, b = bh >> 2, h = bh & 3;
        const float lg64 = 64.0f * ret_logg(h);
        {
            const int e = tid >> 2, d0 = (tid & 3) * 16; float sv[16];
#pragma unroll
            for (int k = 0; k < 16; ++k) sv[k] = 0.f;
#pragma unroll 1
            for (int q = 0; q < run; ++q) {
                const v4u* tp_ = (const v4u*)(TOT + ((size_t)(sq * 8 + q)) * 8192 + e * 64 + d0); const f32x4* dp_ = (const f32x4*)(DR + (size_t)(sq * 8 + q) * 64 + d0);
                float tv[16]; { float t0[8], t1[8]; unpack8(tp_[0], t0); unpack8(tp_[1], t1);
#pragma unroll
                  for (int k = 0; k < 8; ++k) { tv[k] = t0[k]; tv[8 + k] = t1[k]; } }
#pragma unroll
                for (int k4 = 0; k4 < 4; ++k4) { const f32x4 d4 = dp_[k4];
#pragma unroll
                    for (int k = 0; k < 4; ++k) sv[4 * k4 + k] = sv[4 * k4 + k] * d4[k] + tv[4 * k4 + k]; }
            }
            float s0[8], s1[8];
#pragma unroll
            for (int k = 0; k < 8; ++k) { s0[k] = sv[k]; s1[k] = sv[8 + k]; }
            *(LAS v4u*)(lds + L_SIN + ((tid & 3) * 2) * 2048 + e * 16) = pack8f(s0); *(LAS v4u*)(lds + L_SIN + ((tid & 3) * 2 + 1) * 2048 + e * 16) = pack8f(s1);
        }
        R3_FETCH(v * 16, cur);
#pragma unroll 1
        for (int i = 0; i < 16; ++i) {
            const int u = v * 16 + i, n = run * 16 + i;
            bf16* prow = proj + (size_t)(b * SEQ + n * 64) * PJ;
            const int cg = (mix ? C_CG : C_RG) + h * 128;
            const float* gn = uni(mix ? a.gla_norm : a.ret_norm) + l * 128;
            chunk_cum_regs(cum, tot, cur.la, mix, h, tid);
            { float qf[8], kf[8], q2[8]; unpack8(cur.qw, qf); unpack8(cur.kw, kf);
              const f32x4 c0 = *(const LAS f32x4*)(cum + t * 64 + 8 * c), c1 = *(const LAS f32x4*)(cum + t * 64 + 8 * c + 4);
              const float pret = __expf(lg64 * (float)i);
#pragma unroll
              for (int j = 0; j < 4; ++j) { const float e0 = __expf(c0[j]), e1 = __expf(c1[j]); qf[j] *= e0; qf[4 + j] *= e1; kf[j] *= __builtin_amdgcn_rcpf(e0); kf[4 + j] *= __builtin_amdgcn_rcpf(e1);
                  q2[j] = qf[j] * (mix ? cur.pn0[j] : pret); q2[4 + j] = qf[4 + j] * (mix ? cur.pn1[j] : pret); }
              *(LAS v4u*)(lds + L_QE + c * 1024 + t * 16) = pack8f(qf); *(LAS v4u*)(lds + L_KE + c * 1024 + t * 16) = pack8f(kf); *(LAS v4u*)(lds + L_QE2 + c * 1024 + t * 16) = pack8f(q2); }
            const v4u gw0 = cur.g0, gw1 = cur.g1;
            asm volatile("s_waitcnt vmcnt(0) lgkmcnt(0)" ::: "memory"); __builtin_amdgcn_s_barrier(); asm volatile("" ::: "memory");
            {
                const int ib = wid & 1, eb = wid >> 1;
                bf16x8 qe[4];
#pragma unroll
                for (int d0 = 0; d0 < 4; ++d0) qe[d0] = *(const LAS bf16x8*)(lds + L_QE + (2 * d0 + hi) * 1024 + (32 * ib + r32) * 16);
                f32x16 p0, p1;
#pragma unroll
                for (int r = 0; r < 16; ++r) { p0[r] = 0.f; p1[r] = 0.f; }
                const LAS unsigned char* kb = lds + L_KE + hi * 1024 + r32 * 16;
#pragma unroll
                for (int d0 = 0; d0 < 4; ++d0) p0 = __builtin_amdgcn_mfma_f32_32x32x16_bf16(*(const LAS bf16x8*)(kb + d0 * 2048), qe[d0], p0, 0, 0, 0);
                if (ib == 1) {
#pragma unroll
                    for (int d0 = 0; d0 < 4; ++d0) p1 = __builtin_amdgcn_mfma_f32_32x32x16_bf16(*(const LAS bf16x8*)(kb + d0 * 2048 + 512), qe[d0], p1, 0, 0, 0);
#pragma unroll
                    for (int r = 0; r < 16; ++r) if (crow(r, hi) > r32) p1[r] = 0.f;
                } else {
#pragma unroll
                    for (int r = 0; r < 16; ++r) if (crow(r, hi) > r32) p0[r] = 0.f;
                }
                bf16x8 pa[4];
                { v4u w0 = {cvtpk2(p0[0], p0[1]), cvtpk2(p0[2], p0[3]), cvtpk2(p0[4], p0[5]), cvtpk2(p0[6], p0[7])};
                  v4u w1 = {cvtpk2(p0[8], p0[9]), cvtpk2(p0[10], p0[11]), cvtpk2(p0[12], p0[13]), cvtpk2(p0[14], p0[15])};
                  v4u w2 = {cvtpk2(p1[0], p1[1]), cvtpk2(p1[2], p1[3]), cvtpk2(p1[4], p1[5]), cvtpk2(p1[6], p1[7])};
                  v4u w3 = {cvtpk2(p1[8], p1[9]), cvtpk2(p1[10], p1[11]), cvtpk2(p1[12], p1[13]), cvtpk2(p1[14], p1[15])};
                  pa[0] = __builtin_bit_cast(bf16x8, w0); pa[1] = __builtin_bit_cast(bf16x8, w1); pa[2] = __builtin_bit_cast(bf16x8, w2); pa[3] = __builtin_bit_cast(bf16x8, w3); }
                f32x16 o;
#pragma unroll
                for (int r = 0; r < 16; ++r) o[r] = 0.f;
                const LAS unsigned char* vp = lds + L_V + eb * 4096 + ((lane >> 4) & 1) * 32 + (lane & 3) * 8 + (4 * hi + ((lane & 15) >> 2)) * 64;
#pragma unroll
                for (int ks = 0; ks < 4; ++ks) o = __builtin_amdgcn_mfma_f32_32x32x16_bf16(pa[ks], trfrag(vp + ks * 1024), o, 0, 0, 0);
#pragma unroll
                for (int d0 = 0; d0 < 4; ++d0) o = __builtin_amdgcn_mfma_f32_32x32x16_bf16(qe[d0], *(const LAS bf16x8*)(lds + L_S + (2 * d0 + hi) * 2048 + (32 * eb + r32) * 16), o, 0, 0, 0);
#pragma unroll
                for (int d0 = 0; d0 < 4; ++d0) o = __builtin_amdgcn_mfma_f32_32x32x16_bf16(*(const LAS bf16x8*)(lds + L_QE2 + (2 * d0 + hi) * 1024 + (32 * ib + r32) * 16),
                                                                                         *(const LAS bf16x8*)(lds + L_SIN + (2 * d0 + hi) * 2048 + (32 * eb + r32) * 16), o, 0, 0, 0);
#pragma unroll
                for (int r = 0; r < 16; ++r) ob[(32 * ib + crow(r, hi)) * OB_LD + 32 * eb + r32] = o[r];
            }
            LDS_WAIT(); __builtin_amdgcn_s_barrier(); asm volatile("" ::: "memory");
            if (i < 15) R3_FETCH(u + 1, cur);
            {
                const int ii = tid >> 3, sg = tid & 7;
                f32x4 vv[4]; float ss = 0.f;
#pragma unroll
                for (int k = 0; k < 4; ++k) { vv[k] = *(const LAS f32x4*)(ob + ii * OB_LD + 16 * sg + 4 * k); ss += (vv[k][0] * vv[k][0] + vv[k][1] * vv[k][1]) + (vv[k][2] * vv[k][2] + vv[k][3] * vv[k][3]); }
                ss = xadd<1>(ss); ss = xadd<2>(ss); ss = xadd<4>(ss);
                const float rstd = __builtin_amdgcn_rsqf(ss * (1.0f / 128.0f) + EPS);
                v4u* gp = (v4u*)(prow + (size_t)ii * PJ + cg + 16 * sg);
#pragma unroll
                for (int k2 = 0; k2 < 2; ++k2) { const v4u gw = k2 ? gw1 : gw0; float gf[8]; unpack8(gw, gf);
                    const f32x4 g0 = *(const f32x4*)(gn + 16 * sg + 8 * k2), g1 = *(const f32x4*)(gn + 16 * sg + 8 * k2 + 4);
                    float y[8];
#pragma unroll
                    for (int j = 0; j < 4; ++j) { y[j] = vv[2 * k2][j] * rstd * g0[j] * gf[j]; y[4 + j] = vv[2 * k2 + 1][j] * rstd * g1[j] * gf[4 + j]; }
                    if (!dry) gp[k2] = pack8f(y); }
            }
        }
        LDS_WAIT(); __builtin_amdgcn_s_barrier(); asm volatile("" ::: "memory");
    }
#undef R3_FETCH
}

namespace att {
typedef float f32x16 __attribute__((ext_vector_type(16)));
typedef short v4i16_t __attribute__((ext_vector_type(4)));
constexpr int SLOT = 16384, L_K = 0, L_V = 3 * SLOT, L_WS = 6 * SLOT, L_XCH = 0, L_STG = 65536;
constexpr float THR = 8.0f;
__device__ __forceinline__ int crow(int r, int hi) { return (r & 3) + 8 * (r >> 2) + 4 * hi; }
__device__ __forceinline__ float swapmax(float m) { auto rr = __builtin_amdgcn_permlane32_swap(__float_as_uint(m), __float_as_uint(m), false, false); return fmaxf(__uint_as_float(rr[0]), __uint_as_float(rr[1])); }
__device__ __forceinline__ float max3f(float a, float b, float c) { return __builtin_fmaxf(__builtin_fmaxf(a, b), c); }
__device__ __forceinline__ float swapadd(float m) { auto rr = __builtin_amdgcn_permlane32_swap(__float_as_uint(m), __float_as_uint(m), false, false); return __uint_as_float(rr[0]) + __uint_as_float(rr[1]); }
__device__ __forceinline__ unsigned cvtpk(float lo, float hi) { typedef float f2 __attribute__((ext_vector_type(2))); typedef __bf16 b2 __attribute__((ext_vector_type(2))); f2 v = {lo, hi}; b2 b = __builtin_convertvector(v, b2); return __builtin_bit_cast(unsigned, b); }

__device__ __forceinline__ void attn_unit(LAS unsigned char* lds, bf16* proj, int tid, int wid, int b, int h, int qb, float lam, float post, const float* gn, bool dry) {
    const int lane = tid & 63, r32 = lane & 31, hi = lane >> 5, mp = wid & 1, rw = wid >> 1;
    const size_t rowbase = (size_t)b * SEQ; const int q0 = qb * 128;
    const int NT = 2 * qb + 2, NTw = 2 * qb + 1 + (rw >> 1);
    const bf16* Kh = proj + rowbase * PJ + C_AK + h * 128; const bf16* Vh = proj + rowbase * PJ + C_AV + h * 128;
    const unsigned kvoff = (unsigned)(lane * PJ + wid * 8) * 2u;
    const unsigned vvoff = (unsigned)((16 * (wid & 3) + (lane >> 2)) * PJ + (wid >> 2) * 32 + (lane & 3) * 8) * 2u;
    const unsigned kdst = L_K + wid * 1024, vdst = L_V + wid * 1024;
    const unsigned ldsb = (unsigned)(size_t)lds;
#define ATT_DMA(t, slot) do { const char* kt_ = (const char*)uni(Kh + (size_t)(t) * 64 * PJ); const char* vt_ = (const char*)uni(Vh + (size_t)(t) * 64 * PJ); \
        const unsigned kd_ = (unsigned)__builtin_amdgcn_readfirstlane((int)(ldsb + kdst + (slot) * SLOT)), vd_ = (unsigned)__builtin_amdgcn_readfirstlane((int)(ldsb + vdst + (slot) * SLOT)); \
        glds16s<0>(kt_, kvoff, kd_); glds16s<0>(kt_ + 128, kvoff, kd_ + 8192); glds16s<0>(vt_, vvoff, vd_); glds16s<0>(vt_ + 128, vvoff, vd_ + 8192); } while (0)
#define ATT_DMA1(t, slot, P_) do { const char* bt_ = (const char*)uni(((P_) < 2 ? Kh : Vh) + (size_t)(t) * 64 * PJ) + ((P_) & 1) * 128; \
        const unsigned dd_ = (unsigned)__builtin_amdgcn_readfirstlane((int)(ldsb + ((P_) < 2 ? kdst : vdst) + (slot) * SLOT + ((P_) & 1) * 8192)); \
        glds16s<0>(bt_, (P_) < 2 ? kvoff : vvoff, dd_); } while (0)
    bf16x8 qr[4];
    { const bf16* qp = proj + (rowbase + q0 + 32 * rw + r32) * PJ + C_AQ + h * 128 + mp * 64 + hi * 8;
#pragma unroll
      for (int d0 = 0; d0 < 4; ++d0) qr[d0] = *(const bf16x8*)(qp + d0 * 16); }
    ATT_DMA(0, 0); ATT_DMA(1, 1);
    f32x16 o[4];
#pragma unroll
    for (int d = 0; d < 4; ++d)
#pragma unroll
        for (int r = 0; r < 16; ++r) o[d][r] = 0.f;
    float mref = 0.f, lsum = 0.f;
    float one_ = 1.0f; asm volatile("" : "+v"(one_));
    f32x16 negm;
#pragma unroll
    for (int r = 0; r < 16; ++r) negm[r] = 0.f;
    volatile LAS float* wsf = (volatile LAS float*)(lds + L_WS) + wid * 64;
    const LAS unsigned char* kb0 = lds + L_K + mp * 8192 + hi * 1024 + r32 * 16;
    const LAS unsigned char* vp0 = lds + L_V + ((lane >> 4) & 1) * 32 + (lane & 3) * 8 + (4 * hi + ((lane & 15) >> 2)) * 64;
#define ATT_KLOAD(slot) do { _Pragma("unroll") for (int d0 = 0; d0 < 4; ++d0) { kf[2 * d0] = *(const LAS bf16x8*)(kb0 + (slot) * SLOT + d0 * 2048); kf[2 * d0 + 1] = *(const LAS bf16x8*)(kb0 + (slot) * SLOT + d0 * 2048 + 512); } } while (0)
#define ATT_VLOAD(dst, slot, d0_) do { _Pragma("unroll") for (int ks_ = 0; ks_ < 4; ++ks_) { \
        const v4i16_t lo_ = __builtin_amdgcn_ds_read_tr16_b64_v4i16((LAS v4i16_t*)(vp0 + (slot) * SLOT + (d0_) * 4096 + ks_ * 1024)); \
        const v4i16_t hh_ = __builtin_amdgcn_ds_read_tr16_b64_v4i16((LAS v4i16_t*)(vp0 + (slot) * SLOT + (d0_) * 4096 + ks_ * 1024 + 512)); \
        dst[ks_] = (bf16x8){lo_[0], lo_[1], lo_[2], lo_[3], hh_[0], hh_[1], hh_[2], hh_[3]}; } } while (0)
#define ATT_PV(d0_, vf_) do { _Pragma("unroll") for (int ks_ = 0; ks_ < 4; ++ks_) o[d0_] = __builtin_amdgcn_mfma_f32_32x32x16_bf16(pa[ks_], vf_[ks_], o[d0_], 0, 0, 0); } while (0)
    asm volatile("s_waitcnt vmcnt(4)" ::: "memory"); LDS_WAIT(); __builtin_amdgcn_s_barrier(); asm volatile("" ::: "memory");
    bf16x8 kf[8];
    ATT_KLOAD(0);
#define ATT_PARTA(FIRST_, p0, p1) \
            float ra = max3f(p0[0], p0[1], p1[0]), rb = max3f(p0[2], p0[3], p1[1]); ra = max3f(ra, p1[2], p1[3]); \
            _Pragma("unroll") for (int r = 4; r < 16; r += 4) { ra = max3f(ra, p0[r], p0[r + 1]); rb = max3f(rb, p0[r + 2], p0[r + 3]); ra = max3f(ra, p1[r], p1[r + 1]); rb = max3f(rb, p1[r + 2], p1[r + 3]); } \
            float rm = swapmax(fmaxf(ra, rb)); \
            if ((FIRST_) || __any(rm > THR)) { \
                const float dl = (FIRST_) ? rm : fmaxf(rm, 0.f); \
                mref += dl; \
                _Pragma("unroll") for (int r = 0; r < 16; ++r) { p0[r] -= dl; p1[r] -= dl; negm[r] = -mref; } \
                fres_ = fast_exp2(-dl); lsum *= fres_; need_ = !(FIRST_); }
#define ATT_PARTB(p0, p1, pk) \
            { float sacc = 0.f, sbcc = 0.f; \
            _Pragma("unroll") for (int r = 0; r < 16; ++r) { p0[r] = fast_exp2(p0[r]); p1[r] = fast_exp2(p1[r]); sacc += p0[r]; sbcc = __builtin_fmaf(p1[r], one_, sbcc); } \
            lsum += sacc + sbcc; \
            { v4u w0 = {cvtpk(p0[0], p0[1]), cvtpk(p0[2], p0[3]), cvtpk(p0[4], p0[5]), cvtpk(p0[6], p0[7])}; \
              v4u w1 = {cvtpk(p0[8], p0[9]), cvtpk(p0[10], p0[11]), cvtpk(p0[12], p0[13]), cvtpk(p0[14], p0[15])}; \
              v4u w2 = {cvtpk(p1[0], p1[1]), cvtpk(p1[2], p1[3]), cvtpk(p1[4], p1[5]), cvtpk(p1[6], p1[7])}; \
              v4u w3 = {cvtpk(p1[8], p1[9]), cvtpk(p1[10], p1[11]), cvtpk(p1[12], p1[13]), cvtpk(p1[14], p1[15])}; \
              pk[0] = __builtin_bit_cast(bf16x8, w0); pk[1] = __builtin_bit_cast(bf16x8, w1); pk[2] = __builtin_bit_cast(bf16x8, w2); pk[3] = __builtin_bit_cast(bf16x8, w3); } }
#define ATT_POST() \
            if (need_) { if (hi == 0) wsf[r32] = fres_; \
                _Pragma("unroll") for (int r = 0; r < 16; ++r) { const float fr = wsf[crow(r, hi)]; \
                    _Pragma("unroll") for (int d = 0; d < 4; ++d) o[d][r] *= fr; } }
#define ATT_SB() __builtin_amdgcn_sched_barrier(0)
#define ATT_QK(p0, p1) do { p0 = __builtin_amdgcn_mfma_f32_32x32x16_bf16(kf[0], qr[0], negm, 0, 0, 0); p1 = __builtin_amdgcn_mfma_f32_32x32x16_bf16(kf[1], qr[0], negm, 0, 0, 0); \
        _Pragma("unroll") for (int d0 = 1; d0 < 4; ++d0) { p0 = __builtin_amdgcn_mfma_f32_32x32x16_bf16(kf[2 * d0], qr[d0], p0, 0, 0, 0); p1 = __builtin_amdgcn_mfma_f32_32x32x16_bf16(kf[2 * d0 + 1], qr[d0], p1, 0, 0, 0); } } while (0)
#define ATT_STEP(T_, SL_, SL1_, SL2_, G_DMA, ACT_, ACTN_) do { \
        if (ACTN_) ATT_KLOAD(SL1_); \
        if (G_DMA) ATT_DMA1((T_) + 2, SL2_, 0); \
        if (ACT_) { ATT_PV(0, va); ATT_VLOAD(va, SL_, 2); } \
        ATT_SB(); \
        if (G_DMA) ATT_DMA1((T_) + 2, SL2_, 1); \
        bool need_ = false; float fres_ = 1.0f; \
        if (ACTN_) { ATT_QK(ps0, ps1); ATT_SB(); if (G_DMA) ATT_DMA1((T_) + 2, SL2_, 2); ATT_PARTA(false, ps0, ps1) } \
        else if (G_DMA) ATT_DMA1((T_) + 2, SL2_, 2); \
        ATT_SB(); \
        if (G_DMA) ATT_DMA1((T_) + 2, SL2_, 3); \
        if (ACT_) { ATT_PV(1, vb); ATT_VLOAD(vb, SL_, 3); ATT_PV(2, va); ATT_PV(3, vb); } \
        if (ACTN_) { ATT_PARTB(ps0, ps1, pn) asm volatile("" :: "v"(pn[0]), "v"(pn[1]), "v"(pn[2]), "v"(pn[3]), "v"(lsum)); }        \
        _Pragma("unroll") for (int g_ = 0; g_ < 12; ++g_) { __builtin_amdgcn_sched_group_barrier(0x008, 1, 0); __builtin_amdgcn_sched_group_barrier(0x100, 1, 0); __builtin_amdgcn_sched_group_barrier(0x002, 7, 0); } \
        ATT_SB(); \
        if (ACTN_) { ATT_POST() _Pragma("unroll") for (int i_ = 0; i_ < 4; ++i_) pa[i_] = pn[i_]; \
            ATT_VLOAD(va, SL1_, 0); ATT_VLOAD(vb, SL1_, 1); } \
        ATT_SB(); \
    } while (0)
#define ATT_BARRIER() do { asm volatile("s_waitcnt vmcnt(0)" ::: "memory"); __builtin_amdgcn_s_barrier(); asm volatile("" ::: "memory"); } while (0)
    f32x16 ps0, ps1; bf16x8 pa[4], pn[4];
#pragma unroll
    for (int i = 0; i < 4; ++i) { pa[i] = (bf16x8){0, 0, 0, 0, 0, 0, 0, 0}; pn[i] = pa[i]; }
    bf16x8 va[4], vb[4];
    ATT_QK(ps0, ps1);
    ATT_VLOAD(va, 0, 0); ATT_VLOAD(vb, 0, 1);
    { bool need_ = false; float fres_ = 1.0f; ATT_PARTA(true, ps0, ps1) ATT_PARTB(ps0, ps1, pa) (void)need_; (void)fres_; }
    int t = 0;
    for (; t + 5 <= NT; t += 3) {
        ATT_BARRIER(); ATT_STEP(t, 0, 1, 2, true, true, true);
        ATT_BARRIER(); ATT_STEP(t + 1, 1, 2, 0, true, true, true);
        ATT_BARRIER(); ATT_STEP(t + 2, 2, 0, 1, true, true, true);
    }
    {
        int sl = 0, sl1 = 1, sl2 = 2;
        for (; t < NT; ++t) {
            if (t + 1 < NT) ATT_BARRIER();
            ATT_STEP(t, sl, sl1, sl2, (t + 2 < NT), (t < NTw), (t + 1 < NTw));
            const int s0 = sl; sl = sl1; sl1 = sl2; sl2 = s0;
        }
    }
#undef ATT_STEP
#undef ATT_PARTA
#undef ATT_PARTB
#undef ATT_POST
#undef ATT_BARRIER
#undef ATT_QK
#undef ATT_FAST
#undef ATT_SB
#undef ATT_KLOAD
#undef ATT_VLOAD
#undef ATT_PV
    int lane_e = lane; asm volatile("" : "+v"(lane_e)); const int r32e = lane_e & 31, hie = lane_e >> 5;
    lsum = swapadd(lsum);
    if (hie == 0) wsf[r32e] = 1.0f / lsum;
#pragma unroll
    for (int r = 0; r < 16; ++r) { const float fr = wsf[crow(r, hie)];
#pragma unroll
        for (int d = 0; d < 4; ++d) o[d][r] *= fr; }
    LDS_WAIT(); __builtin_amdgcn_s_barrier(); asm volatile("" ::: "memory");
    LAS float* xch = (LAS float*)(lds + L_XCH) + rw * 4096 + lane_e;
    if (mp == 1) {
#pragma unroll
        for (int d = 0; d < 4; ++d)
#pragma unroll
            for (int r = 0; r < 16; ++r) xch[(d * 16 + r) * 64] = o[d][r];
    }
    LDS_WAIT(); __builtin_amdgcn_s_barrier(); asm volatile("" ::: "memory");
    if (mp == 0) {
        float ss[16];
#pragma unroll
        for (int r = 0; r < 16; ++r) ss[r] = 0.f;
#pragma unroll
        for (int d = 0; d < 4; ++d)
#pragma unroll
            for (int r = 0; r < 16; ++r) { const float y = o[d][r] - lam * xch[(d * 16 + r) * 64]; o[d][r] = y; ss[r] += y * y; }
#pragma unroll
        for (int r = 0; r < 16; ++r) {
            ss[r] = xadd<1>(ss[r]); ss[r] = xadd<2>(ss[r]); ss[r] = xadd<4>(ss[r]); ss[r] = xadd<8>(ss[r]); ss[r] = xadd<16>(ss[r]);
            ss[r] = post * __builtin_amdgcn_rsqf(ss[r] * (1.0f / 128.0f) + EPS);
        }
        LAS bf16* stg = (LAS bf16*)(lds + L_STG + rw * 8192);
#pragma unroll
        for (int d = 0; d < 4; ++d) { const float g = gn[32 * d + r32e];
#pragma unroll
            for (int r = 0; r < 16; ++r) stg[crow(r, hie) * 128 + 32 * d + r32e] = (bf16)f2bf(o[d][r] * ss[r] * g); }
        LDS_WAIT();
        bf16* orow = proj + (rowbase + q0 + 32 * rw) * PJ + C_AQ + h * 128;
#pragma unroll
        for (int i = 0; i < 8; ++i) { const int row = i * 4 + (lane_e >> 4), ch = lane_e & 15;
            const v4u v = *(const LAS v4u*)(stg + row * 128 + ch * 8); if (!dry) *(v4u*)(orow + (size_t)row * PJ + ch * 8) = v; }
    }
    LDS_WAIT(); __builtin_amdgcn_s_barrier(); asm volatile("" ::: "memory");
#undef ATT_DMA
#undef ATT_DMA1
}
}

__device__ __forceinline__ void phase_attn(const Args& a, const Frame& F, int l, bool dry, unsigned char* wnext) {
    unsigned char* ws = F.ws; bf16* proj = (bf16*)(ws + WS_BIG);
    const float lam = ((const float*)(ws + WS_LAM))[l];
    const float post = 1.0f - LAM_INIT[l];
    const float* gn = uni(a.da_norm) + l * 128;
    const int tid = opaque_tid(F.wave);
    for (int v = F.vcu; v < 256; v += F.G) {
        const int bh = v >> 4, s = v & 15;
#pragma unroll 1
        for (int i = 0; i < 4; ++i) {
            const int qb = (i == 0) ? 63 - s : (i == 1) ? 32 + s : (i == 2) ? 31 - s : s;
            att::attn_unit(F.lds, proj, tid, F.wave, bh >> 2, bh & 3, qb, lam, post, gn, dry);
            if (wnext != nullptr && v == F.vcu) {
                int lane = tid & 63; asm volatile("" : "+v"(lane));
                const int gw = F.vcu * 8 + F.wave, NGW = F.G * 8;
                for (int k = 2 * i; (i == 3) || k < 2 * i + 2; ++k) { const int it = gw + k * NGW; if (it >= I_TOTAL - I_LA) break; conv_item(a, wnext, l + 1, it, lane); }
                if (i == 3) { for (int r = gw; r < I_LA; r += NGW) conv_la_item(a, wnext, l + 1, r, lane); if (gw == 0) conv_lam(a, F.ws, l + 1, lane); }
            }
        }
    }
}


constexpr int NPH = 12;
constexpr int N_PHASES = DEPTH * NPH + 1;
#ifndef REP_UP
#define REP_UP 1
#endif
#ifndef REP_DOWN
#define REP_DOWN 1
#endif
#ifndef REP_INPROJ
#define REP_INPROJ 1
#endif
#ifndef REP_R
#define REP_R 1
#endif
#ifndef REP_ATTN
#define REP_ATTN 1
#endif
#ifndef REP_G
#define REP_G 1
#endif
#ifndef REP_M
#define REP_M 1
#endif
#ifndef REP_R2
#define REP_R2 1
#endif
#ifndef REP_NORM
#define REP_NORM 1
#endif
#ifndef MK_PER_PHASE
#define MK_PER_PHASE 0
#endif

__global__ void __launch_bounds__(512, 2) mk_fwd(Args a) {
    extern __shared__ __attribute__((aligned(16))) unsigned char lds_raw[];
    Frame F;
    F.lds = (LAS unsigned char*)lds_raw; F.ws = uni(a.ws); F.wave = __builtin_amdgcn_readfirstlane((int)threadIdx.x >> 6);
    F.G = gridDim.x; { const int bx = blockIdx.x; F.vcu = (F.G % 8 == 0) ? (bx % 8) * (F.G / 8) + bx / 8 : bx; }
    volatile LAS unsigned* MISC = (volatile LAS unsigned*)(F.lds + MISC_OFF);
    if (threadIdx.x < 32) MISC[threadIdx.x] = 0u;
    __syncthreads();
    XcdBarrier bar; bar.bar = (unsigned*)(F.ws + WS_CTL); bar.x = 0; bar.st = nullptr;
    if (!MK_PER_PHASE) bar = xcd_barrier_post((unsigned*)(F.ws + WS_CTL), MISC + 8);
    const int lo = a.ph_lo, hi = a.ph_hi;
#define RUN(k) (lo <= (k) && (k) < hi)
#define SEAM(k) do { if (RUN(k) && RUN((k) + 1)) xcd_barrier(bar); } while (0)
    unsigned char* ws = F.ws; float* const outp = uni(a.out);
    bf16* XB = (bf16*)(ws + WS_HN); bf16* BIG = (bf16*)(ws + WS_BIG); bf16* MG = (bf16*)(ws + WS_ST); float* SSQ = (float*)(ws + WS_SSQ);
    const int cid = (int)blockIdx.x;

    if (RUN(0)) phase_rope(F);
    for (int l = 0; l < DEPTH; ++l) {
        const int pb = l * NPH;
        unsigned char* const wb1 = (unsigned char*)((unsigned long long)outp - WS_W);
        unsigned char* const wcur = (l & 1) ? wb1 : ws; unsigned char* const wnxt = (l + 1 < DEPTH) ? ((l & 1) ? ws : wb1) : nullptr;
        if (RUN(pb)) {
            for (int rep = 0; rep < REP_NORM; ++rep) {
            if (l == 0) phase_conv(a, F, 0, ws);
            if (l == 0) phase_prep(F, uni(a.x), XB, SSQ);
            }
        }
        if (l == 0) SEAM(pb);
        for (int hf = 0; hf < 2; ++hf) {
            const int p0 = pb + (hf ? 10 : 1);
            const float* ssq_in = SSQ + (size_t)(hf ? 2 : 0) * M * 16;
            float* ssq_out = SSQ + (size_t)(hf ? 0 : 1) * M * 16;
            if (RUN(p0)) {
                pg8::Gemm g{(const char*)XB, (const char*)(wcur + (hf ? W_13B : W_13A)), DMODEL, DMODEL, DMODEL, 0, 0};
                pg8::Order<(2 * DFFP) / 256, 1> S; S.init(F.G, cid, F.wave);
                pg8::EpiSwiGLU E{BIG, ssq_in};
                for (int rep = 0; rep < REP_UP; ++rep)
                pg8::gemm_phase<pg8::EpiSwiGLU, true>(F.lds, g, S, E);
            }
            SEAM(p0);
            if (RUN(p0 + 1)) {
                pg8::Gemm g{(const char*)BIG, (const char*)(wcur + (hf ? W_2B : W_2A)), DFFP, DFFP, DFFP, 0, 0};
                pg8::Order<(DMODEL) / 256, 1> S; S.init(F.G, cid, F.wave);
                for (int rep = 0; rep < REP_DOWN; ++rep) {
                pg8::EpiResid E{XB, 0.5f, 2.0f, rep < REP_DOWN - 1, ssq_out};
                pg8::gemm_phase<pg8::EpiResid, true>(F.lds, g, S, E); }
            }
            SEAM(p0 + 1);
            if (hf == 0) {
                const float* ssq_mix = ssq_out;
                if (RUN(pb + 3)) {
                    pg8::Gemm g{(const char*)XB, (const char*)(wcur + W_IN), DMODEL, DMODEL, DMODEL, 0, 0};
                    pg8::Order<(PJ) / 256, 1> S; S.init(F.G, cid, F.wave);
                    pg8::EpiInProj E{BIG, (const float*)(ws + WS_ROPE), uni(a.gla_ab) + l * 256, ssq_mix};
                    for (int rep = 0; rep < REP_INPROJ; ++rep)
                    pg8::gemm_phase<pg8::EpiInProj, true>(F.lds, g, S, E);
                }
                SEAM(pb + 3);
                if (RUN(pb + 4)) for (int rep = 0; rep < REP_R; ++rep) phase_r1_mfma(a, F);
                SEAM(pb + 4);
                if (RUN(pb + 6)) {
                    for (int rep = 0; rep < REP_R; ++rep) phase_r3_mfma(a, F, l, rep < REP_R - 1);
                    for (int rep = 0; rep < REP_ATTN; ++rep) phase_attn(a, F, l, rep < REP_ATTN - 1, rep == REP_ATTN - 1 ? wnxt : nullptr);
                }
                SEAM(pb + 6);
                if (RUN(pb + 7)) {
                    pg8::Gemm g{(const char*)XB, (const char*)(wcur + W_G), DMODEL, DMODEL, DMODEL, 0, 0};
                    pg8::Order<(3 * DMODEL) / 256, 1> S; S.init(F.G, cid, F.wave);
                    pg8::EpiGates E{BIG, ssq_mix};
                    for (int rep = 0; rep < REP_G; ++rep)
                    pg8::gemm_phase<pg8::EpiGates, true>(F.lds, g, S, E);
                }
                SEAM(pb + 7);
                if (RUN(pb + 8)) {
                    pg8::Gemm g{(const char*)BIG, (const char*)(wcur + W_B), PJ, 512, 512, 512 * 2, (size_t)DMODEL * 512 * 2};
                    pg8::Order<(DMODEL) / 256, 3> S; S.init(F.G, cid, F.wave);
                    pg8::EpiMerge E{BIG, MG};
                    for (int rep = 0; rep < REP_M; ++rep)
                    pg8::gemm_phase<pg8::EpiMerge, true>(F.lds, g, S, E);
                }
                SEAM(pb + 8);
                if (RUN(pb + 9)) {
                    pg8::Gemm g{(const char*)MG, (const char*)(wcur + W_O), DMODEL, DMODEL, DMODEL, 0, 0};
                    pg8::Order<(DMODEL) / 256, 1> S; S.init(F.G, cid, F.wave);
                    pg8::EpiResid E{XB, 1.0f, 1.0f, false, SSQ + (size_t)2 * M * 16};
                    pg8::gemm_phase<pg8::EpiResid, true>(F.lds, g, S, E);
                }
                SEAM(pb + 9);
            }
        }
    }
    if (RUN(DEPTH * NPH)) phase_final_norm(F, XB, outp, uni(a.final_norm), SSQ);
#undef RUN
#undef SEAM
}

extern "C" void kernel_launch(void* const* d_in, const int* in_sizes, int n_in, void* d_out, int out_size, void* d_ws, size_t ws_size, hipStream_t stream) {
    static int grid = 0;
    if (grid == 0) {
        if (n_in != 22 || in_sizes[0] != M * DMODEL || out_size != M * DMODEL || ws_size < WS_END) { fprintf(stderr, "kernel_launch: unexpected shapes (n_in %d, ws %zu)\n", n_in, ws_size); grid = -1; return; }
        int dev = 0, cus = 0, per_cu = 0;
        if (hipGetDevice(&dev) != hipSuccess || hipDeviceGetAttribute(&cus, hipDeviceAttributeMultiprocessorCount, dev) != hipSuccess) { grid = -1; return; }
        if (hipFuncSetAttribute((const void*)mk_fwd, hipFuncAttributeMaxDynamicSharedMemorySize, LDS_BYTES) != hipSuccess) { fprintf(stderr, "kernel_launch: hipFuncSetAttribute failed\n"); grid = -1; return; }
        if (hipOccupancyMaxActiveBlocksPerMultiprocessor(&per_cu, (const void*)mk_fwd, 512, LDS_BYTES) != hipSuccess || per_cu < 1) fprintf(stderr, "kernel_launch: occupancy query says %d\n", per_cu);
        (void)hipGetLastError();
        grid = cus;
    }
    if (grid < 0) return;
    if (hipMemsetAsync((char*)d_ws + WS_CTL, 0, CTL_ZERO_BYTES, stream) != hipSuccess) return;
    Args a{};
    a.x = (const float*)d_in[0]; a.ffn1_norm = (const float*)d_in[1]; a.ffn1_w1 = (const float*)d_in[2]; a.ffn1_w3 = (const float*)d_in[3]; a.ffn1_w2 = (const float*)d_in[4];
    a.mix_norm = (const float*)d_in[5]; a.w_in = (const float*)d_in[6]; a.lam_qk = (const float*)d_in[7]; a.da_norm = (const float*)d_in[8]; a.ret_norm = (const float*)d_in[9];
    a.gla_a2 = (const float*)d_in[10]; a.gla_ab = (const float*)d_in[11]; a.gla_norm = (const float*)d_in[12]; a.wb_a = (const float*)d_in[13]; a.wb_b = (const float*)d_in[14];
    a.wb_c = (const float*)d_in[15]; a.w_out = (const float*)d_in[16]; a.ffn2_norm = (const float*)d_in[17]; a.ffn2_w1 = (const float*)d_in[18]; a.ffn2_w3 = (const float*)d_in[19];
    a.ffn2_w2 = (const float*)d_in[20]; a.final_norm = (const float*)d_in[21];
    a.out = (float*)d_out; a.ws = (unsigned char*)d_ws;
#if MK_PER_PHASE
    for (int p = 0; p < N_PHASES; ++p) { a.ph_lo = p; a.ph_hi = p + 1; hipLaunchKernelGGL(mk_fwd, dim3(grid), dim3(512), LDS_BYTES, stream, a); }
#else
    a.ph_lo = 0; a.ph_hi = N_PHASES;
    hipLaunchKernelGGL(mk_fwd, dim3(grid), dim3(512), LDS_BYTES, stream, a);
#endif
}
```

```cpp
#include <hip/hip_runtime.h>
#include <cstdio>
#include <cstdint>

#define GAS __attribute__((address_space(1)))
#define LAS __attribute__((address_space(3)))
typedef unsigned short bf16;
typedef unsigned v4u __attribute__((ext_vector_type(4)));
typedef unsigned v2u __attribute__((ext_vector_type(2)));
typedef float f32x4 __attribute__((ext_vector_type(4)));
typedef float f32x2 __attribute__((ext_vector_type(2)));
typedef short bf16x8 __attribute__((ext_vector_type(8)));

constexpr int BATCH = 4, SEQ = 8192, DMODEL = 1024, DEPTH = 4, M = BATCH * SEQ;
constexpr int NH = 4;
constexpr int DFF = 2752, DFFP = 2816;
constexpr int INC = 7696;
constexpr int PJ = 4864;
constexpr int C_AQ = 0, C_RG = 512, C_CG = 1024, C_AK = 1536, C_AV = 2048, C_RQ = 2560, C_RK = 2816, C_RV = 3072, C_CQ = 3584, C_CK = 3840, C_CV = 4096, C_LA = 4608;
constexpr int C_GATE = 1536;
constexpr int O_AQ = 0, O_AK = 512, O_AV = 1024, O_RQ = 1536, O_RK = 1792, O_RV = 2048, O_RG = 2560, O_CQ = 3072, O_CK = 3328, O_CV = 3584, O_CG = 4096, O_CA = 4608, O_GATE = 4624;
constexpr float EPS = 1e-6f;
constexpr float C2 = 0.125f * 1.4426950408889634f;

constexpr size_t MiB = 1u << 20;
constexpr size_t WS_CTL = 0, CTL_ZERO_BYTES = 64 * 1024;
constexpr size_t WS_LAM = 256 * 1024;
constexpr size_t WS_DEC = 1 * MiB;
constexpr size_t WS_ROPE = 2 * MiB;
constexpr size_t WS_SSQ = 4 * MiB;
constexpr size_t WS_W = 10 * MiB;
constexpr size_t W_13A = WS_W, W_2A = W_13A + 11 * MiB, W_13B = W_2A + 11 * MiB / 2, W_2B = W_13B + 11 * MiB, W_IN = W_2B + 11 * MiB / 2,
                 W_G = W_IN + 19 * MiB / 2, W_B = W_G + 6 * MiB, W_O = W_B + 3 * MiB, W_END = W_O + 2 * MiB;
constexpr size_t WS_HN = 64 * MiB;
constexpr size_t WS_ST = 128 * MiB;
constexpr size_t WS_BIG = 192 * MiB;
constexpr size_t WS_TOT = 496 * MiB;
constexpr size_t WS_DR = 500 * MiB;
constexpr size_t WS_END = 501 * MiB;
static_assert(W_END <= WS_HN, "weight region");

constexpr int RING_BYTES = 131072;
constexpr int MISC_OFF = RING_BYTES + 320;
constexpr int LDS_BYTES = 147456;

__device__ __forceinline__ float bf2f(unsigned h) { return __uint_as_float(h << 16); }
__device__ __forceinline__ float bflo(unsigned w) { return __uint_as_float(w << 16); }
__device__ __forceinline__ float bfhi(unsigned w) { return __uint_as_float(w & 0xffff0000u); }
__device__ __forceinline__ unsigned f2bf(float f) { unsigned u = __float_as_uint(f); return (u + 0x7fffu + ((u >> 16) & 1u)) >> 16; }
__device__ __forceinline__ unsigned pk2(float lo, float hi) { typedef float f2_ __attribute__((ext_vector_type(2))); typedef __bf16 b2_ __attribute__((ext_vector_type(2))); f2_ v = {lo, hi}; b2_ b = __builtin_convertvector(v, b2_); return __builtin_bit_cast(unsigned, b); }
template <int K> __device__ __forceinline__ float xadd(float v) {
    if constexpr (K == 32) { auto rr = __builtin_amdgcn_permlane32_swap(__float_as_uint(v), __float_as_uint(v), false, false); return __uint_as_float(rr[0]) + __uint_as_float(rr[1]); }
    else return v + __int_as_float(__builtin_amdgcn_ds_swizzle(__float_as_int(v), (K << 10) | 0x1f));
}
__device__ __forceinline__ float wave_sum(float v) { v = xadd<1>(v); v = xadd<2>(v); v = xadd<4>(v); v = xadd<8>(v); v = xadd<16>(v); v = xadd<32>(v); return v; }
__device__ __forceinline__ float fast_exp2(float x) { return __builtin_amdgcn_exp2f(x); }
__device__ __forceinline__ float sigmoidf_(float x) { return __builtin_amdgcn_rcpf(1.0f + fast_exp2(-1.4426950408889634f * x)); }
__device__ __forceinline__ float siluf_(float x) { return x * sigmoidf_(x); }
template <class T> __device__ __forceinline__ T* uni(T* p) {
    const unsigned long long v = (unsigned long long)p;
    const unsigned lo = __builtin_amdgcn_readfirstlane((unsigned)v), hi = __builtin_amdgcn_readfirstlane((unsigned)(v >> 32));
    return (T*)(GAS T*)(((unsigned long long)hi << 32) | lo);
}
__device__ __forceinline__ int opaque_tid(int wave) { int z = 0; asm volatile("" : "+v"(z)); const int lane = __builtin_amdgcn_mbcnt_hi(-1, __builtin_amdgcn_mbcnt_lo(-1, z)); return wave * 64 + lane; }
__device__ __forceinline__ unsigned cvtpk2(float lo, float hi) { typedef float f2 __attribute__((ext_vector_type(2))); typedef __bf16 b2 __attribute__((ext_vector_type(2))); f2 v = {lo, hi}; b2 b = __builtin_convertvector(v, b2); return __builtin_bit_cast(unsigned, b); }
__device__ __forceinline__ void glds16(const void* gsrc, unsigned lds_dst) { unsigned keep;
    asm volatile("s_mov_b32 %0, m0\n\ts_mov_b32 m0, %2\n\ts_nop 0\n\tglobal_load_lds_dwordx4 %1, off\n\ts_mov_b32 m0, %0" : "=&s"(keep) : "v"(gsrc), "s"(lds_dst) : "memory"); }
template <int IMM> __device__ __forceinline__ void glds16s(const void* sbase, unsigned voff, unsigned lds_dst) { unsigned keep;
    asm volatile("s_mov_b32 %0, m0\n\ts_mov_b32 m0, %3\n\ts_nop 0\n\tglobal_load_lds_dwordx4 %1, %2 offset:%c4\n\ts_mov_b32 m0, %0" : "=&s"(keep) : "v"(voff), "s"(sbase), "s"(lds_dst), "i"(IMM) : "memory"); }
#define LDS_WAIT() asm volatile("s_waitcnt lgkmcnt(0)" ::: "memory")
#define VM_WAIT() asm volatile("s_waitcnt vmcnt(0)" ::: "memory")

namespace pg8 {
constexpr int BM = 256, BK = 64, HALF = 128, HTB = HALF * BK * 2, NXCD = 8, WGM = 8;
__host__ __device__ __forceinline__ int lds_byte(int r, int c) { const int x = (-(r >> 2)) & 3; return (r >> 3) * 1024 + (c >> 5) * 512 + (r & 7) * 64 + (((((c >> 3) & 3) ^ x)) << 4) + (c & 7) * 2; }
__host__ __device__ __forceinline__ void stage_rc(int b, int& R, int& C) { const int blk = b / 1024, i = (b % 1024) / 16; R = blk * 8 + ((i & 31) >> 2); const int x = (-(R >> 2)) & 3; C = ((i >> 5) * 4 + ((i & 3) ^ x)) * 8 + (b % 16) / 2; }
__host__ __device__ __forceinline__ int perm32(int rho) { const int n = rho >> 4, i = rho & 15; return 8 * (i >> 2) + 4 * n + (i & 3); }

struct Unit { int pm, pn, z; };
struct Gemm { const char* A; const char* B; int lda, ldb, K; size_t zA, zB; };
__device__ __forceinline__ const char* a_base(const Gemm& g, const Unit& u) { return g.A + (size_t)u.pm * 256 * g.lda * 2 + (size_t)u.z * g.zA; }
__device__ __forceinline__ const char* b_base(const Gemm& g, const Unit& u) { return g.B + (size_t)u.pn * 256 * g.ldb * 2 + (size_t)u.z * g.zB; }

template <int NN, int NZ> struct Order {
    static constexpr int nM = M / BM, nN = NN, nwg = nM * nN, nz = NZ;
    int G, c, wave;
    __device__ void init(int G_, int c_, int wave_) { G = G_; c = c_; wave = wave_; }
    __device__ bool next(int i, Unit& u) const {
        const int t = i / NZ; u.z = i - t * NZ;
        const int L = t * G + c; if (L >= nwg) return false;
        static_assert(nwg % NXCD == 0 && nM % WGM == 0, "tile counts");
        int wgid = L; { constexpr int q = nwg / NXCD; const int xcd = wgid % NXCD, off = wgid / NXCD; wgid = xcd * q + off; }
        constexpr int nig = WGM * nN; const int gid = wgid / nig, fm = gid * WGM, w = wgid - gid * nig;
        u.pm = fm + (w % WGM); u.pn = w / WGM; return true;
    }
};

template <class Epi, bool ALIGN_EPI, class Sched>
__device__ __forceinline__ void gemm_phase(LAS unsigned char* lds, const Gemm g, const Sched& S, const Epi& E) {
    const int tid = opaque_tid(S.wave), wid = S.wave, lane = tid & 63, wr = wid >> 2, wc = wid & 3, fr = lane & 15, fq = lane >> 4;
    const int nt = g.K / BK;
    unsigned voffA[2], voffB[2];
#pragma unroll
    for (int i = 0; i < 2; ++i) { int R, C; stage_rc(tid * 16 + i * 8192, R, C); const int Rb = Epi::PERM ? ((R & ~31) + perm32(R & 31)) : R;
        voffA[i] = (unsigned)(R * g.lda + C) * 2u; voffB[i] = (unsigned)(Rb * g.ldb + C) * 2u; }
    const size_t kstep = (size_t)(BK * 2);
    const size_t hstepA = (size_t)HALF * g.lda * 2, hstepB = (size_t)HALF * g.ldb * 2;
    const unsigned ldsw = (unsigned)wid * 1024u; const unsigned ldsb = (unsigned)(size_t)lds;
    const int aoff = lds_byte(wr * 64 + fr, fq * 8), boff = lds_byte(wc * 32 + fr, fq * 8);
#define PG8_SA(b, h) (((b) * 2 + (h)) * HTB)
#define PG8_SB(b, h) ((4 + (b) * 2 + (h)) * HTB)
#define PG8_STAGE(bufoff, gbase, voff) do { _Pragma("unroll") for (int _i = 0; _i < 2; ++_i) \
        glds16s<0>(uni((const char*)(gbase)), (voff)[_i], (unsigned)__builtin_amdgcn_readfirstlane((int)(ldsb + (bufoff) + ldsw + _i * 8192))); } while (0)
#define PG8_LDA(dst, b, h) do { _Pragma("unroll") for (int m = 0; m < 4; ++m) _Pragma("unroll") for (int k = 0; k < 2; ++k) dst[m][k] = *(const LAS bf16x8*)(lds + PG8_SA(b, h) + aoff + m * 2048 + k * 512); } while (0)
#define PG8_LDB(dst, b, h) do { _Pragma("unroll") for (int n = 0; n < 2; ++n) _Pragma("unroll") for (int k = 0; k < 2; ++k) dst[n][k] = *(const LAS bf16x8*)(lds + PG8_SB(b, h) + boff + n * 2048 + k * 512); } while (0)
#define PG8_MMA(ai, bj, At, Bt) do { __builtin_amdgcn_s_setprio(1); _Pragma("unroll") for (int m = 0; m < 4; ++m) _Pragma("unroll") for (int n = 0; n < 2; ++n) _Pragma("unroll") for (int k = 0; k < 2; ++k) \
        acc[ai][bj][m][n] = __builtin_amdgcn_mfma_f32_16x16x32_bf16(Bt[n][k], At[m][k], acc[ai][bj][m][n], 0, 0, 0); __builtin_amdgcn_s_setprio(0); } while (0)
#define PG8_WAIT_V(n) asm volatile("s_waitcnt vmcnt(" #n ")" ::: "memory")
#define PG8_WAIT_VN(n) asm volatile("s_waitcnt vmcnt(%0)" :: "n"(n) : "memory")
#define PG8_WAIT_L(n) asm volatile("s_waitcnt lgkmcnt(" #n ")" ::: "memory")
#define PG8_BAR __builtin_amdgcn_s_barrier()
#define PG8_SCHED __builtin_amdgcn_sched_barrier(0)
    Unit cur, nxt; int ui = 0;
    if (!S.next(0, cur)) return;
    f32x4 acc[2][2][4][2];
    if constexpr (Epi::CINIT) E.cinit(acc, cur, wr, wc, fr, fq);
    else {
#pragma unroll
    for (int a = 0; a < 2; ++a)
#pragma unroll
        for (int b = 0; b < 2; ++b)
#pragma unroll
            for (int m = 0; m < 4; ++m)
#pragma unroll
                for (int n = 0; n < 2; ++n) acc[a][b][m][n] = (f32x4){0.f, 0.f, 0.f, 0.f};
    }
    bf16x8 At[4][2], B0[2][2], B1[2][2];
    LAS float* rsl = (LAS float*)(lds + 132096) + (wid * 16 + fr) * 8;
    int cpm = -1;
    const char* cA = a_base(g, cur); const char* cB = b_base(g, cur);
    PG8_STAGE(PG8_SB(0, 0), cB, voffB); PG8_STAGE(PG8_SB(0, 1), cB + hstepB, voffB); PG8_STAGE(PG8_SA(0, 0), cA, voffA); PG8_STAGE(PG8_SA(0, 1), cA + hstepA, voffA);
    if (wr == 1) PG8_BAR;
    PG8_WAIT_V(2); PG8_BAR;
    PG8_STAGE(PG8_SB(1, 0), cB + kstep, voffB); PG8_STAGE(PG8_SA(1, 0), cA + kstep, voffA); PG8_STAGE(PG8_SB(1, 1), cB + hstepB + kstep, voffB);
    if constexpr (Epi::NST > 0) PG8_STAGE(PG8_SA(1, 1), cA + kstep + hstepA, voffA);
    PG8_WAIT_V(0); PG8_BAR;
    for (;;) {
        const bool has_next = S.next(ui + 1, nxt);
        const char* nA = has_next ? a_base(g, nxt) : cA; const char* nB = has_next ? b_base(g, nxt) : cB;
#define PG8_ITER(t, W123, S1) do { \
            const bool last = ((t) == nt - 2); \
            const char* a1 = cA + (size_t)((t) + 1) * kstep; \
            const char* a2 = last ? nA : cA + (size_t)((t) + 2) * kstep; const char* b2 = last ? nB : cB + (size_t)((t) + 2) * kstep; \
            const char* a3 = a2 + kstep; const char* b3 = b2 + kstep; \
            PG8_LDB(B0, 0, 0); PG8_LDB(B1, 0, 1); PG8_SCHED; PG8_LDA(At, 0, 0); if (S1) PG8_STAGE(PG8_SA(1, 1), a1 + hstepA, voffA); \
            PG8_WAIT_VN(W123); PG8_WAIT_L(0); PG8_BAR; PG8_MMA(0, 0, At, B0); PG8_MMA(0, 1, At, B1); PG8_BAR; PG8_SCHED; \
            PG8_LDA(At, 0, 1); PG8_STAGE(PG8_SB(0, 0), b2, voffB); PG8_STAGE(PG8_SB(0, 1), b2 + hstepB, voffB); PG8_STAGE(PG8_SA(0, 0), a2, voffA); \
            PG8_WAIT_VN(W123); PG8_WAIT_L(0); PG8_BAR; PG8_MMA(1, 0, At, B0); PG8_MMA(1, 1, At, B1); PG8_BAR; PG8_SCHED; \
            PG8_LDB(B0, 1, 0); PG8_LDB(B1, 1, 1); PG8_SCHED; PG8_LDA(At, 1, 0); PG8_STAGE(PG8_SA(0, 1), a2 + hstepA, voffA); \
            PG8_WAIT_VN(W123); PG8_WAIT_L(0); PG8_BAR; PG8_MMA(0, 0, At, B0); PG8_MMA(0, 1, At, B1); PG8_BAR; PG8_SCHED; \
            PG8_LDA(At, 1, 1); PG8_STAGE(PG8_SB(1, 0), b3, voffB); PG8_STAGE(PG8_SB(1, 1), b3 + hstepB, voffB); PG8_STAGE(PG8_SA(1, 0), a3, voffA); \
            PG8_WAIT_V(8); PG8_WAIT_L(0); PG8_BAR; PG8_MMA(1, 0, At, B0); PG8_MMA(1, 1, At, B1); PG8_BAR; PG8_SCHED; \
        } while (0)
        if constexpr (Epi::NST > 0) { PG8_ITER(0, 8 + Epi::NST, false); for (int t = 2; t < nt; t += 2) PG8_ITER(t, 8, true); PG8_STAGE(PG8_SA(1, 1), nA + kstep + hstepA, voffA); }
        else { for (int t = 0; t < nt; t += 2) PG8_ITER(t, 8, true); }
#undef PG8_ITER
        if constexpr (ALIGN_EPI) { if (wr == 0) PG8_BAR; }
        if constexpr (Epi::RSTD) {
            if (cur.pm != cpm) { cpm = cur.pm; E.rs_fill(cur, wr, fr, fq, rsl); }
            float rs[2][4]; { const f32x4 a0 = *(const LAS f32x4*)rsl, a1 = *(const LAS f32x4*)(rsl + 4); rs[0][0] = a0[0]; rs[0][1] = a0[1]; rs[0][2] = a0[2]; rs[0][3] = a0[3]; rs[1][0] = a1[0]; rs[1][1] = a1[1]; rs[1][2] = a1[2]; rs[1][3] = a1[3]; }
            E(acc, cur, wr, wc, fr, fq, rs);
        } else { float rs[2][4]; E(acc, cur, wr, wc, fr, fq, rs); }
        if (!has_next) break;
        if constexpr (Epi::CINIT) E.cinit(acc, nxt, wr, wc, fr, fq);
        else {
#pragma unroll
        for (int a = 0; a < 2; ++a)
#pragma unroll
            for (int b = 0; b < 2; ++b)
#pragma unroll
                for (int m = 0; m < 4; ++m)
#pragma unroll
                    for (int n = 0; n < 2; ++n) acc[a][b][m][n] = (f32x4){0.f, 0.f, 0.f, 0.f};
        }
        cur = nxt; cA = nA; cB = nB; ++ui;
        if constexpr (ALIGN_EPI) { if (wr == 1) PG8_BAR; }
    }
    PG8_WAIT_V(0);
    if constexpr (!ALIGN_EPI) { if (wr == 0) PG8_BAR; }
    PG8_BAR;
#undef PG8_SA
#undef PG8_SB
#undef PG8_STAGE
#undef PG8_LDA
#undef PG8_LDB
#undef PG8_MMA
#undef PG8_WAIT_V
#undef PG8_WAIT_VN
#undef PG8_WAIT_L
#undef PG8_BAR
#undef PG8_SCHED
}

typedef f32x4 Acc[2][2][4][2];
__device__ __forceinline__ float row_rstd(const float* part, int row, int fq) {
    const f32x4 p = *(const f32x4*)(part + (size_t)row * 16 + 4 * fq);
    float s = (p[0] + p[1]) + (p[2] + p[3]);
    s = xadd<16>(s); s = xadd<32>(s);
    return __builtin_amdgcn_rsqf(s * (1.0f / DMODEL) + EPS);
}
__device__ __forceinline__ v4u pack8(const f32x4 a, const f32x4 b) { v4u w; w.x = pk2(a[0], a[1]); w.y = pk2(a[2], a[3]); w.z = pk2(b[0], b[1]); w.w = pk2(b[2], b[3]); return w; }

__device__ __forceinline__ void rstd_fill(const float* part, int row0, int fq, LAS float* rsl) {
#pragma unroll
    for (int i = 0; i < 8; i += 2) {
        const float r0 = row_rstd(part, row0 + (i >> 2) * HALF + (i & 3) * 16, fq), r1 = row_rstd(part, row0 + ((i + 1) >> 2) * HALF + ((i + 1) & 3) * 16, fq);
        if (fq == 0) { rsl[i] = r0; rsl[i + 1] = r1; }
        asm volatile("" ::: "memory");
    }
    asm volatile("s_waitcnt lgkmcnt(0)" ::: "memory");
}
__device__ __forceinline__ void rows_rstd(const float* part, int row0, int fq, float (&rs)[2][4]) {
#pragma unroll
    for (int ai = 0; ai < 2; ++ai)
#pragma unroll
        for (int m = 0; m < 4; ++m) rs[ai][m] = row_rstd(part, row0 + ai * HALF + m * 16, fq);
}
struct EpiSwiGLU {
    static constexpr bool PERM = true; static constexpr bool CINIT = false; static constexpr int NST = 8;
    bf16* H; const float* ssq;
    static constexpr bool RSTD = true;
    __device__ __forceinline__ void rs_fill(const Unit& u, int wr, int fr, int fq, LAS float* rsl) const { rstd_fill(ssq, u.pm * BM + wr * 64 + fr, fq, rsl); }
    __device__ __forceinline__ void operator()(const Acc& acc, const Unit& u, int wr, int wc, int fr, int fq, const float (&rsv)[2][4]) const {
        const int row0 = u.pm * BM + wr * 64 + fr, col0 = u.pn * 128 + wc * 32 + 8 * fq;
#pragma unroll
        for (int ai = 0; ai < 2; ++ai)
#pragma unroll
            for (int m = 0; m < 4; ++m) {
                const float rs = rsv[ai][m];
                f32x4 v0, v1;
#pragma unroll
                for (int j = 0; j < 4; ++j) { v0[j] = siluf_(acc[ai][0][m][0][j] * rs) * (acc[ai][1][m][0][j] * rs); v1[j] = siluf_(acc[ai][0][m][1][j] * rs) * (acc[ai][1][m][1][j] * rs); }
                *(v4u*)(H + (size_t)(row0 + ai * HALF + m * 16) * DFFP + col0) = pack8(v0, v1);
            }
    }
};
struct EpiResid {
    static constexpr bool PERM = true, RSTD = false, CINIT = true; static constexpr int NST = 0;
    bf16* xb; float scale, iscale; bool dry; float* ssq;
    __device__ __forceinline__ void cinit(Acc& acc, const Unit& u, int wr, int wc, int fr, int fq) const {
        const int row0 = u.pm * BM + wr * 64 + fr, col0 = u.pn * BM + wc * 32 + 8 * fq;
#pragma unroll
        for (int ai = 0; ai < 2; ++ai)
#pragma unroll
            for (int m = 0; m < 4; ++m) { const size_t off = (size_t)(row0 + ai * HALF + m * 16) * DMODEL + col0;
#pragma unroll
                for (int bj = 0; bj < 2; ++bj) { const v4u w = *(const v4u*)(xb + off + bj * HALF);
                    acc[ai][bj][m][0] = (f32x4){bflo(w.x), bfhi(w.x), bflo(w.y), bfhi(w.y)} * iscale; acc[ai][bj][m][1] = (f32x4){bflo(w.z), bfhi(w.z), bflo(w.w), bfhi(w.w)} * iscale; } }
    }
    __device__ __forceinline__ void operator()(const Acc& acc, const Unit& u, int wr, int wc, int fr, int fq, const float (&)[2][4]) const {
        const int row0 = u.pm * BM + wr * 64 + fr, col0 = u.pn * BM + wc * 32 + 8 * fq;
#pragma unroll
        for (int ai = 0; ai < 2; ++ai)
#pragma unroll
            for (int m = 0; m < 4; ++m) { const int row = row0 + ai * HALF + m * 16; const size_t off = (size_t)row * DMODEL + col0; float ss = 0.f;
#pragma unroll
                for (int bj = 0; bj < 2; ++bj) {
                    const f32x4 v0 = acc[ai][bj][m][0] * scale, v1 = acc[ai][bj][m][1] * scale;
                    ss += (v0[0] * v0[0] + v0[1] * v0[1]) + (v0[2] * v0[2] + v0[3] * v0[3]) + (v1[0] * v1[0] + v1[1] * v1[1]) + (v1[2] * v1[2] + v1[3] * v1[3]);
                    if (!dry) *(v4u*)(xb + off + bj * HALF) = pack8(v0, v1); }
                ss = xadd<16>(ss); ss = xadd<32>(ss);
                if (fq == 0 && !dry) ssq[(size_t)row * 16 + u.pn * 4 + wc] = ss; }
    }
};
struct EpiInProj {
    static constexpr bool PERM = true; static constexpr bool CINIT = false; static constexpr int NST = 16;
    bf16* P; const float* rope; const float* la_bias; const float* ssq;
    static constexpr bool RSTD = true;
    __device__ __forceinline__ void rs_fill(const Unit& u, int wr, int fr, int fq, LAS float* rsl) const { rstd_fill(ssq, u.pm * BM + wr * 64 + fr, fq, rsl); }
    __device__ __forceinline__ void operator()(const Acc& acc, const Unit& u, int wr, int wc, int fr, int fq, const float (&rsv)[2][4]) const {
        const int row0 = u.pm * BM + wr * 64 + fr; const int pn = u.pn;
        if (pn == 10 || pn == 11) {
            const float sc = (pn == 11) ? 0.125f : 1.0f;
#pragma unroll
            for (int ai = 0; ai < 2; ++ai)
#pragma unroll
                for (int m = 0; m < 4; ++m) { const int row = row0 + ai * HALF + m * 16; const int pos = row & (SEQ - 1); const float rs = rsv[ai][m] * sc;
                    const f32x4* cs = (const f32x4*)(rope + ((size_t)pos * 32 + 8 * fq) * 2);
                    f32x4 o1[2], o2[2];
#pragma unroll
                    for (int n = 0; n < 2; ++n) { const f32x4 c01 = cs[2 * n], c23 = cs[2 * n + 1];
                        const float co[4] = {c01[0], c01[2], c23[0], c23[2]}, si[4] = {c01[1], c01[3], c23[1], c23[3]};
#pragma unroll
                        for (int j = 0; j < 4; ++j) { const float t1 = acc[ai][0][m][n][j], t2 = acc[ai][1][m][n][j]; o1[n][j] = (t1 * co[j] - t2 * si[j]) * rs; o2[n][j] = (t1 * si[j] + t2 * co[j]) * rs; } }
                    bf16* rowp = P + (size_t)row * PJ + pn * BM + wc * 64 + 8 * fq;
                    *(v4u*)(rowp) = pack8(o1[0], o1[1]); *(v4u*)(rowp + 32) = pack8(o2[0], o2[1]); }
            return;
        }
        const int col0 = pn * BM + wc * 32 + 8 * fq;
        if (pn == 18) {
            f32x4 bv[2][2];
            int bo = wc * 32 + 8 * fq; asm volatile("" : "+v"(bo));
#pragma unroll
            for (int bj = 0; bj < 2; ++bj)
#pragma unroll
                for (int n = 0; n < 2; ++n) bv[bj][n] = *(const f32x4*)(la_bias + bo + bj * HALF + 4 * n);
#pragma unroll
            for (int ai = 0; ai < 2; ++ai)
#pragma unroll
                for (int m = 0; m < 4; ++m) { bf16* rowp = P + (size_t)(row0 + ai * HALF + m * 16) * PJ + col0; const float rs = rsv[ai][m];
#pragma unroll
                    for (int bj = 0; bj < 2; ++bj) { f32x4 v[2];
#pragma unroll
                        for (int n = 0; n < 2; ++n)
#pragma unroll
                            for (int j = 0; j < 4; ++j) { const float x = acc[ai][bj][m][n][j] * rs + bv[bj][n][j]; v[n][j] = (fminf(x, 0.f) - 0.6931471805599453f * __builtin_amdgcn_logf(1.0f + fast_exp2(-1.4426950408889634f * fabsf(x)))) * (1.0f / 16.0f); }
                        *(v4u*)(rowp + bj * HALF) = pack8(v[0], v[1]); } }
            return;
        }
        const bool silu = (pn >= 2 && pn <= 5);
        const float sc = (pn <= 1) ? C2 : (pn == 14 ? 0.125f : 1.0f);
#pragma unroll
        for (int ai = 0; ai < 2; ++ai)
#pragma unroll
            for (int m = 0; m < 4; ++m) { bf16* rowp = P + (size_t)(row0 + ai * HALF + m * 16) * PJ + col0; const float rs = rsv[ai][m] * sc;
#pragma unroll
                for (int bj = 0; bj < 2; ++bj) { f32x4 v0 = acc[ai][bj][m][0] * rs, v1 = acc[ai][bj][m][1] * rs;
                    if (silu) {
#pragma unroll
                        for (int j = 0; j < 4; ++j) { v0[j] = siluf_(v0[j]); v1[j] = siluf_(v1[j]); } }
                    *(v4u*)(rowp + bj * HALF) = pack8(v0, v1); } }
    }
};
struct EpiGates {
    static constexpr bool PERM = true; static constexpr bool CINIT = false; static constexpr int NST = 16;
    bf16* P; const float* ssq;
    static constexpr bool RSTD = true;
    __device__ __forceinline__ void rs_fill(const Unit& u, int wr, int fr, int fq, LAS float* rsl) const { rstd_fill(ssq, u.pm * BM + wr * 64 + fr, fq, rsl); }
    __device__ __forceinline__ void operator()(const Acc& acc, const Unit& u, int wr, int wc, int fr, int fq, const float (&rsv)[2][4]) const {
        const int row0 = u.pm * BM + wr * 64 + fr, col0 = C_GATE + u.pn * BM + wc * 32 + 8 * fq;
#pragma unroll
        for (int ai = 0; ai < 2; ++ai)
#pragma unroll
            for (int m = 0; m < 4; ++m) { bf16* rowp = P + (size_t)(row0 + ai * HALF + m * 16) * PJ + col0; const float rs = rsv[ai][m];
#pragma unroll
                for (int bj = 0; bj < 2; ++bj) { f32x4 v0, v1;
#pragma unroll
                    for (int j = 0; j < 4; ++j) { v0[j] = sigmoidf_(acc[ai][bj][m][0][j] * rs); v1[j] = sigmoidf_(acc[ai][bj][m][1][j] * rs); }
                    *(v4u*)(rowp + bj * HALF) = pack8(v0, v1); } }
    }
};
struct EpiMerge {
    static constexpr bool PERM = true; static constexpr bool CINIT = false; static constexpr int NST = 16;
    const bf16* P; bf16* O;
    static constexpr bool RSTD = false;
    __device__ __forceinline__ void operator()(const Acc& acc, const Unit& u, int wr, int wc, int fr, int fq, const float (&)[2][4]) const {
        const int row0 = u.pm * BM + wr * 64 + fr, col0 = u.pn * BM + wc * 32 + 8 * fq, gcol0 = C_GATE + u.z * DMODEL + col0;
        const bool add = u.z > 0;
#pragma unroll
        for (int ai = 0; ai < 2; ++ai) {
            v4u gw[4][2], pw[4][2];
#pragma unroll
            for (int m = 0; m < 4; ++m)
#pragma unroll
                for (int bj = 0; bj < 2; ++bj) { const size_t row = (size_t)(row0 + ai * HALF + m * 16);
                    gw[m][bj] = *(const v4u*)(P + row * PJ + gcol0 + bj * HALF);
                    pw[m][bj] = add ? *(const v4u*)(O + row * DMODEL + col0 + bj * HALF) : (v4u){0u, 0u, 0u, 0u}; }
#pragma unroll
            for (int m = 0; m < 4; ++m)
#pragma unroll
                for (int bj = 0; bj < 2; ++bj) { const size_t row = (size_t)(row0 + ai * HALF + m * 16);
                    const v4u g = gw[m][bj], p = pw[m][bj];
                    f32x4 v0 = acc[ai][bj][m][0], v1 = acc[ai][bj][m][1];
                    v0[0] = v0[0] * bflo(g.x) + bflo(p.x); v0[1] = v0[1] * bfhi(g.x) + bfhi(p.x); v0[2] = v0[2] * bflo(g.y) + bflo(p.y); v0[3] = v0[3] * bfhi(g.y) + bfhi(p.y);
                    v1[0] = v1[0] * bflo(g.z) + bflo(p.z); v1[1] = v1[1] * bfhi(g.z) + bfhi(p.z); v1[2] = v1[2] * bflo(g.w) + bflo(p.w); v1[3] = v1[3] * bfhi(g.w) + bfhi(p.w);
                    *(v4u*)(O + row * DMODEL + col0 + bj * HALF) = pack8(v0, v1); }
        }
    }
};
}

#define XB_TMO      128
#define XB_XCNT(j)  (256  + 64 * (j))
#define XB_XSUB(j)  (1280 + 64 * (j))
#define XB_XGEN(j)  (2304 + 64 * (j))
#define XB_TOP      3328
#define XB_TOPGEN   3392
#define XCD_BAR_WORDS 3456
#define XB_SPIN_CAP (1u << 23)
__device__ __forceinline__ unsigned xb_ld(unsigned* p)              { return __hip_atomic_load(p, __ATOMIC_RELAXED, __HIP_MEMORY_SCOPE_AGENT); }
__device__ __forceinline__ unsigned xb_add(unsigned* p, unsigned v) { return __hip_atomic_fetch_add(p, v, __ATOMIC_RELAXED, __HIP_MEMORY_SCOPE_AGENT); }
__device__ __forceinline__ unsigned xb_xcc_id() { return (unsigned)__builtin_amdgcn_s_getreg((3 << 11) | 20) & 0xFu; }
#define XB_SPIN(cond, bar) do { unsigned _sp = 0; while (cond) { __builtin_amdgcn_s_sleep(1); \
    if ((++_sp & 255u) == 0u) { if (xb_ld(&(bar)[XB_TMO])) break; if (_sp > XB_SPIN_CAP) { atomicAdd(&(bar)[XB_TMO], 1u); break; } } } } while (0)
struct XcdBarrier { unsigned* bar; unsigned x; volatile LAS unsigned* st; };
__device__ __forceinline__ XcdBarrier xcd_barrier_post(unsigned* bar, volatile LAS unsigned* st) {
    XcdBarrier b; b.bar = bar; b.x = xb_xcc_id(); b.st = st;
    if (threadIdx.x == 0) (void)xb_add(&bar[XB_XCNT(b.x)], 1u);
    return b;
}
__device__ __forceinline__ void xcd_barrier_complete(unsigned* bar, unsigned x, unsigned& nloc, unsigned& nx) {
    const unsigned G = gridDim.x * gridDim.y * gridDim.z;
    unsigned sum, cnt, mine, sp = 0u;
    for (;;) {
        sum = 0u; cnt = 0u; mine = 0u;
#pragma unroll
        for (unsigned j = 0; j < 16; ++j) { const unsigned c = xb_ld(&bar[XB_XCNT(j)]); sum += c; cnt += (c > 0u) ? 1u : 0u; mine = (j == x) ? c : mine; }
        if (sum == G) break;
        __builtin_amdgcn_s_sleep(1);
        if ((++sp & 255u) == 0u) { if (xb_ld(&bar[XB_TMO])) break; if (sp > XB_SPIN_CAP) { atomicAdd(&bar[XB_TMO], 1u); break; } }
    }
    nloc = mine > 0u ? mine : 1u; nx = cnt > 0u ? cnt : 1u;
}
__device__ __forceinline__ void xcd_barrier(const XcdBarrier& b) {
    asm volatile("s_waitcnt vmcnt(0)" ::: "memory");
    __syncthreads();
    if (threadIdx.x == 0) {
        unsigned* bar = b.bar;
        __builtin_amdgcn_s_waitcnt(0);
        unsigned nloc = b.st[0], nx = b.st[1];
        if (nloc == 0u) { xcd_barrier_complete(bar, b.x, nloc, nx); b.st[0] = nloc; b.st[1] = nx; }
        const unsigned old = xb_add(&bar[XB_XSUB(b.x)], 1u);
        const unsigned gen = old / nloc;
        if (old + 1u == (gen + 1u) * nloc) {
            __builtin_amdgcn_fence(__ATOMIC_RELEASE, "agent");
            asm volatile("s_waitcnt vmcnt(0)" ::: "memory");
            const unsigned og = xb_add(&bar[XB_TOP], 1u);
            const unsigned tg = og / nx;
            if (og + 1u == (tg + 1u) * nx) xb_add(&bar[XB_TOPGEN], 1u);
            else XB_SPIN(xb_ld(&bar[XB_TOPGEN]) == tg, bar);
            __builtin_amdgcn_fence(__ATOMIC_ACQUIRE, "agent");
            xb_add(&bar[XB_XGEN(b.x)], 1u);
            asm volatile("s_waitcnt vmcnt(0)" ::: "memory");
        } else {
            XB_SPIN(xb_ld(&bar[XB_XGEN(b.x)]) == gen, bar);
            __builtin_amdgcn_fence(__ATOMIC_ACQUIRE, "agent");
            asm volatile("s_waitcnt vmcnt(0)" ::: "memory");
        }
    }
    __syncthreads();
}

struct Args {
    const float* x; const float* ffn1_norm; const float* ffn1_w1; const float* ffn1_w3; const float* ffn1_w2; const float* mix_norm; const float* w_in; const float* lam_qk;
    const float* da_norm; const float* ret_norm; const float* gla_a2; const float* gla_ab; const float* gla_norm; const float* wb_a; const float* wb_b; const float* wb_c; const float* w_out;
    const float* ffn2_norm; const float* ffn2_w1; const float* ffn2_w3; const float* ffn2_w2; const float* final_norm;
    float* out; unsigned char* ws; int ph_lo, ph_hi;
};
struct Frame { LAS unsigned char* lds; unsigned char* ws; int vcu, G, wave; };

__device__ __constant__ float LAM_INIT[4] = {0.2f, 0.35550906759f, 0.47071301834f, 0.55605820416f};

__device__ __forceinline__ void conv_tr(const float* src, int ldsrc, bf16* dst, int lddst, LAS float* scr, int lane, bool zero, const float* gain = nullptr) {
    if (zero) {
        const int c = lane & 7;
#pragma unroll
        for (int j = 0; j < 4; ++j) { const int n = (lane >> 3) + 8 * j; *(v4u*)(dst + (size_t)n * lddst + 8 * c) = (v4u){0u, 0u, 0u, 0u}; }
        return;
    }
    const int n4 = lane & 7, kg = lane >> 3;
    f32x4 tv[8];
#pragma unroll
    for (int j = 0; j < 8; ++j) tv[j] = *(const f32x4*)(src + (size_t)(8 * kg + j) * ldsrc + 4 * n4);
    if (gain) { const f32x4 g0 = *(const f32x4*)(gain + 8 * kg), g1 = *(const f32x4*)(gain + 8 * kg + 4);
#pragma unroll
        for (int j = 0; j < 4; ++j) { tv[j] = tv[j] * g0[j]; tv[4 + j] = tv[4 + j] * g1[j]; } }
#pragma unroll
    for (int i = 0; i < 4; ++i) { v4u o; o.x = pk2(tv[0][i], tv[1][i]); o.y = pk2(tv[2][i], tv[3][i]); o.z = pk2(tv[4][i], tv[5][i]); o.w = pk2(tv[6][i], tv[7][i]);
        *(v4u*)(dst + (size_t)(4 * n4 + i) * lddst + 8 * kg) = o; }
    (void)scr;
}
__device__ __forceinline__ int inproj_src_col(int g) {
    const int c = 32 * g;
    if (c < 512) return O_AQ + c;
    if (c < 1024) return O_RG + (c - 512);
    if (c < 1536) return O_CG + (c - 1024);
    if (c < 2048) return O_AK + (c - 1536);
    if (c < 2560) return O_AV + (c - 2048);
    if (c < 3072) { const int base = (c < 2816) ? O_RQ : O_RK; const int cc = (c < 2816) ? c - 2560 : c - 2816; const int half = cc >> 7, head = (cc & 127) >> 5; return base + head * 64 + 32 * half; }
    if (c < 3584) return O_RV + (c - 3072);
    if (c < 3840) return O_CQ + (c - 3584);
    if (c < 4096) return O_CK + (c - 3840);
    return O_CV + (c - 4096);
}
constexpr int I_W13 = 16 * 176, I_W2 = 44 * 32, I_WIN = 16 * 144, I_WG = 16 * 96, I_WB = 8 * 32, I_WO = 16 * 32, I_LA = 16 * 8;
constexpr int I_TOTAL = 2 * (I_W13 + I_W2) + I_WIN + I_WG + 3 * I_WB + I_WO + I_LA;

__device__ __forceinline__ void conv_w13(const float* w1, const float* w3, bf16* dst, int r, LAS float* scr, int lane, const float* gain) {
    const int kb = r / 176, g = r % 176, pn = g >> 3, half = (g >> 2) & 1, jj = g & 3, hc0 = pn * 128 + jj * 32;
    const float* src = (half ? w3 : w1) + (size_t)(64 * kb) * DFF + hc0;
    conv_tr(src, DFF, dst + (size_t)(32 * g) * DMODEL + 64 * kb, DMODEL, scr, lane, hc0 >= DFF, gain + 64 * kb);
}
__device__ __forceinline__ void conv_w2(const float* w2, bf16* dst, int r, LAS float* scr, int lane) {
    const int kb = r / 32, nb = r % 32;
    conv_tr(w2 + (size_t)(64 * kb) * DMODEL + 32 * nb, DMODEL, dst + (size_t)(32 * nb) * DFFP + 64 * kb, DFFP, scr, lane, kb >= 43);
}

struct ConvJob { const float* src; const float* gain; bf16* dst; int ldsrc, lddst, kind; };
__device__ __forceinline__ ConvJob conv_job(const Args& a, unsigned char* wd, int l, int it) {
    ConvJob j; j.src = nullptr; j.gain = nullptr; j.dst = nullptr; j.ldsrc = 0; j.lddst = 0; j.kind = 0;
    if (it < 0 || it >= I_TOTAL - I_LA) return j;
    const float* win = uni(a.w_in) + (size_t)l * DMODEL * INC;
    const float* gm = uni(a.mix_norm) + l * DMODEL;
    int r = it;
    if (r < I_W13 || (r >= I_W13 + I_W2 && r < 2 * I_W13 + I_W2)) { const bool second = r >= I_W13; if (second) r -= I_W13 + I_W2;
        const int kb = r / 176, g = r % 176, pn = g >> 3, half = (g >> 2) & 1, jj = g & 3, hc0 = pn * 128 + jj * 32;
        const float* w1 = uni(second ? a.ffn2_w1 : a.ffn1_w1) + (size_t)l * DMODEL * DFF; const float* w3 = uni(second ? a.ffn2_w3 : a.ffn1_w3) + (size_t)l * DMODEL * DFF;
        j.src = (half ? w3 : w1) + (size_t)(64 * kb) * DFF + hc0; j.ldsrc = DFF; j.dst = (bf16*)(wd + (second ? W_13B : W_13A)) + (size_t)(32 * g) * DMODEL + 64 * kb; j.lddst = DMODEL;
        j.gain = uni(second ? a.ffn2_norm : a.ffn1_norm) + l * DMODEL + 64 * kb; j.kind = (hc0 >= DFF) ? 2 : 1; return j; }
    r -= I_W13;
    if (r < I_W2 || (r >= I_W2 + I_W13 && r < 2 * I_W2 + I_W13)) { const bool second = r >= I_W2; if (second) r -= I_W2 + I_W13;
        const int kb = r / 32, nb = r % 32; const float* w2 = uni(second ? a.ffn2_w2 : a.ffn1_w2) + (size_t)l * DFF * DMODEL;
        j.src = w2 + (size_t)(64 * kb) * DMODEL + 32 * nb; j.ldsrc = DMODEL; j.dst = (bf16*)(wd + (second ? W_2B : W_2A)) + (size_t)(32 * nb) * DFFP + 64 * kb; j.lddst = DFFP; j.kind = (kb >= 43) ? 2 : 1; return j; }
    r -= I_W2 + I_W13 + I_W2;
    if (r < I_WIN) { const int kb = r / 144, g = r % 144;
        j.src = win + (size_t)(64 * kb) * INC + inproj_src_col(g); j.ldsrc = INC; j.dst = (bf16*)(wd + W_IN) + (size_t)(32 * g) * DMODEL + 64 * kb; j.lddst = DMODEL; j.gain = gm + 64 * kb; j.kind = 1; return j; }
    r -= I_WIN;
    if (r < I_WG) { const int kb = r / 96, g = r % 96;
        j.src = win + (size_t)(64 * kb) * INC + O_GATE + 32 * g; j.ldsrc = INC; j.dst = (bf16*)(wd + W_G) + (size_t)(32 * g) * DMODEL + 64 * kb; j.lddst = DMODEL; j.gain = gm + 64 * kb; j.kind = 1; return j; }
    r -= I_WG;
    if (r < 3 * I_WB) { const int z = r / I_WB, rr = r % I_WB, kb = rr / 32, nb = rr % 32;
        const float* wb = uni(z == 0 ? a.wb_a : (z == 1 ? a.wb_b : a.wb_c)) + (size_t)l * 512 * DMODEL;
        j.src = wb + (size_t)(64 * kb) * DMODEL + 32 * nb; j.ldsrc = DMODEL; j.dst = (bf16*)(wd + W_B) + (size_t)z * DMODEL * 512 + (size_t)(32 * nb) * 512 + 64 * kb; j.lddst = 512; j.kind = 1; return j; }
    r -= 3 * I_WB;
    { const int kb = r / 32, nb = r % 32;
      j.src = uni(a.w_out) + (size_t)l * DMODEL * DMODEL + (size_t)(64 * kb) * DMODEL + 32 * nb; j.ldsrc = DMODEL; j.dst = (bf16*)(wd + W_O) + (size_t)(32 * nb) * DMODEL + 64 * kb; j.lddst = DMODEL; j.kind = 1; }
    return j;
}
__device__ __forceinline__ void conv_load(const ConvJob& j, int lane, f32x4 (&tv)[8]) {
    if (j.kind == 1) { const int n4 = lane & 7, kg = lane >> 3;
#pragma unroll
        for (int q = 0; q < 8; ++q) tv[q] = *(const f32x4*)(j.src + (size_t)(8 * kg + q) * j.ldsrc + 4 * n4); }
}
__device__ __forceinline__ void conv_store(const ConvJob& j, int lane, f32x4 (&tv)[8]) {
    if (j.kind == 0) return;
    const int n4 = lane & 7, kg = lane >> 3;
    if (j.kind == 2) {
#pragma unroll
        for (int i = 0; i < 4; ++i) *(v4u*)(j.dst + (size_t)(4 * n4 + i) * j.lddst + 8 * kg) = (v4u){0u, 0u, 0u, 0u};
        return; }
    if (j.gain) { const f32x4 g0 = *(const f32x4*)(j.gain + 8 * kg), g1 = *(const f32x4*)(j.gain + 8 * kg + 4);
#pragma unroll
        for (int q = 0; q < 4; ++q) { tv[q] = tv[q] * g0[q]; tv[4 + q] = tv[4 + q] * g1[q]; } }
#pragma unroll
    for (int i = 0; i < 4; ++i) { v4u o; o.x = pk2(tv[0][i], tv[1][i]); o.y = pk2(tv[2][i], tv[3][i]); o.z = pk2(tv[4][i], tv[5][i]); o.w = pk2(tv[6][i], tv[7][i]);
        *(v4u*)(j.dst + (size_t)(4 * n4 + i) * j.lddst + 8 * kg) = o; }
}
__device__ __forceinline__ void conv_item(const Args& a, unsigned char* wd, int l, int it, int lane) {
    const ConvJob j = conv_job(a, wd, l, it); f32x4 tv[8]; conv_load(j, lane, tv); conv_store(j, lane, tv);
}
__device__ __forceinline__ void conv_la_item(const Args& a, unsigned char* wd, int l, int r, int lane) {
    const float* win = uni(a.w_in) + (size_t)l * DMODEL * INC;
    const float* gm = uni(a.mix_norm) + l * DMODEL;
    const int kb = r / 8, cb = r % 8, c8 = lane & 7; const float* a2 = uni(a.gla_a2) + (size_t)l * 16 * 256;
    const float* wrow = win + (size_t)(64 * kb + 8 * c8) * INC + O_CA;
#pragma unroll 1
    for (int j = 0; j < 4; ++j) { const int c = 32 * cb + (lane >> 3) + 8 * j;
        float av[16];
#pragma unroll
        for (int t = 0; t < 16; ++t) av[t] = a2[t * 256 + c];
        float o[8];
#pragma unroll
        for (int q = 0; q < 8; ++q) {
            float acc = 0.f;
#pragma unroll
            for (int t4 = 0; t4 < 4; ++t4) { const f32x4 w4 = *(const f32x4*)(wrow + (size_t)q * INC + 4 * t4);
                acc += (w4[0] * av[4 * t4] + w4[1] * av[4 * t4 + 1]) + (w4[2] * av[4 * t4 + 2] + w4[3] * av[4 * t4 + 3]); }
            o[q] = acc * gm[64 * kb + 8 * c8 + q]; }
        v4u w; w.x = pk2(o[0], o[1]); w.y = pk2(o[2], o[3]); w.z = pk2(o[4], o[5]); w.w = pk2(o[6], o[7]);
        *(v4u*)((bf16*)(wd + W_IN) + (size_t)(C_LA + c) * DMODEL + 64 * kb + 8 * c8) = w; }
}
__device__ __forceinline__ void conv_lam(const Args& a, unsigned char* ws, int l, int lane) {
    const float* lq = uni(a.lam_qk) + (size_t)l * 256;
    const float s1 = wave_sum(lq[lane] * lq[64 + lane]), s2 = wave_sum(lq[128 + lane] * lq[192 + lane]);
    if (lane == 0) ((float*)(ws + WS_LAM))[l] = __expf(s1) - __expf(s2) + LAM_INIT[l];
}
__device__ __forceinline__ void phase_conv(const Args& a, const Frame& F, int l, unsigned char* wd) {
    const int tid = opaque_tid(F.wave), lane = tid & 63, wave = F.wave;
    const int gw = F.vcu * 8 + wave, NGW = F.G * 8;
    for (int it = gw; it < I_TOTAL - I_LA; it += NGW) conv_item(a, wd, l, it, lane);
    for (int r = gw; r < I_LA; r += NGW) conv_la_item(a, wd, l, r, lane);
    if (gw == 0) conv_lam(a, F.ws, l, lane);
}

__device__ __forceinline__ void phase_rope(const Frame& F) {
    const int tid = opaque_tid(F.wave);
    float* rt = (float*)(F.ws + WS_ROPE);
    for (int idx = F.vcu * 512 + tid; idx < SEQ * 32; idx += F.G * 512) {
        const int pos = idx >> 5, i = idx & 31;
        const float inv = exp2f(-(float)i * (13.287712379549449f / 32.0f));
        const float ang = (float)pos * inv;
        double rev = (double)ang * 0.15915494309189535; rev -= floor(rev);
        const float rf = (float)rev;
        rt[2 * idx] = __builtin_amdgcn_cosf(rf); rt[2 * idx + 1] = __builtin_amdgcn_sinf(rf);
    }
}
__device__ __forceinline__ void phase_prep(const Frame& F, const float* x, bf16* xb, float* ssq) {
    const int tid = opaque_tid(F.wave), lane = tid & 63, wave = F.wave;
    const int gw = F.vcu * 8 + wave, NGW = F.G * 8;
    for (int m = gw; m < M; m += NGW) {
        const f32x4* xr = (const f32x4*)(x + (size_t)m * DMODEL) + lane;
        f32x4 v[4]; float s = 0.f;
#pragma unroll
        for (int j = 0; j < 4; ++j) { v[j] = xr[64 * j]; s += (v[j][0] * v[j][0] + v[j][1] * v[j][1]) + (v[j][2] * v[j][2] + v[j][3] * v[j][3]); }
        s = wave_sum(s);
        v2u* o8 = (v2u*)(xb + (size_t)m * DMODEL) + lane;
#pragma unroll
        for (int j = 0; j < 4; ++j) { v2u w; w.x = pk2(v[j][0], v[j][1]); w.y = pk2(v[j][2], v[j][3]); o8[64 * j] = w; }
        if (lane < 16) ssq[(size_t)m * 16 + lane] = (lane == 0) ? s : 0.f;
    }
}
__device__ __forceinline__ void phase_final_norm(const Frame& F, const bf16* xb, float* out, const float* gain, const float* ssq) {
    const int tid = opaque_tid(F.wave), lane = tid & 63, wave = F.wave;
    const int gw = F.vcu * 8 + wave, NGW = F.G * 8;
    f32x4 g[4];
#pragma unroll
    for (int j = 0; j < 4; ++j) g[j] = *((const f32x4*)gain + lane + 64 * j);
    for (int m = gw; m < M; m += NGW) {
        const v2u* xr = (const v2u*)(xb + (size_t)m * DMODEL) + lane; f32x4* orow = (f32x4*)(out + (size_t)m * DMODEL) + lane;
        float sq = ssq[(size_t)m * 16 + (lane & 15)];
        sq = xadd<1>(sq); sq = xadd<2>(sq); sq = xadd<4>(sq); sq = xadd<8>(sq);
        const float rstd = __builtin_amdgcn_rsqf(sq * (1.0f / DMODEL) + EPS);
#pragma unroll
        for (int j = 0; j < 4; ++j) { const v2u w = xr[64 * j]; orow[64 * j] = (f32x4){bflo(w.x), bfhi(w.x), bflo(w.y), bfhi(w.y)} * rstd * g[j]; }
    }
}

__device__ __forceinline__ float ret_logg(int h) { return h == 0 ? -0.031748698314580301f : (h == 1 ? -0.015748356968139168f : (h == 2 ? -0.0078431774610258928f : -0.0039138993211363287f)); }

__device__ __forceinline__ void chunk_cum(LAS float* cum, LAS float* tot, const bf16* prow, int mix, int h, int tid) {
    const int d = tid & 63, seg = tid >> 6;
    if (mix == 0) {
        const float lg = ret_logg(h);
#pragma unroll
        for (int x = 0; x < 8; ++x) { const int t = seg * 8 + x; cum[t * 64 + d] = (float)(t + 1) * lg; }
        __syncthreads(); __syncthreads();
        return;
    }
    float run = 0.f;
#pragma unroll
    for (int x = 0; x < 8; ++x) { const int t = seg * 8 + x; run += bf2f(prow[(size_t)t * PJ + C_LA + h * 64 + d]); cum[t * 64 + d] = run; }
    tot[seg * 64 + d] = run;
    __syncthreads();
    float off = 0.f;
    for (int s = 0; s < seg; ++s) off += tot[s * 64 + d];
#pragma unroll
    for (int x = 0; x < 8; ++x) { const int t = seg * 8 + x; cum[t * 64 + d] += off; }
    __syncthreads();
}

__device__ __forceinline__ void phase_r2(const Args& a, const Frame& F) {
    unsigned char* ws = F.ws; unsigned* ST = (unsigned*)(ws + WS_ST); const float* DEC = (const float*)(ws + WS_DEC);
    const int tid = opaque_tid(F.wave);
    for (int gt = F.vcu * 512 + tid; gt < 32 * 4096; gt += F.G * 512) {
        const int w = gt & 4095, seq = gt >> 12, mix = seq >> 4, bh = seq & 15, h = bh & 3, d0 = (2 * w) & 63;
        unsigned* p = ST + (size_t)seq * 128 * 4096 + w;
        const float* dp = DEC + (size_t)bh * 128 * 64 + d0;
        float s0 = 0.f, s1 = 0.f;
        const float cret = __expf(64.0f * ret_logg(h));
        unsigned ua[8], ub[8]; f32x2 da[8], db[8];
#define R2_LOAD(uu, dd, n0_) do { _Pragma("unroll") for (int i = 0; i < 8; ++i) { uu[i] = p[(size_t)((n0_) + i) * 4096]; dd[i] = mix ? *(const f32x2*)(dp + (size_t)((n0_) + i) * 64) : (f32x2){cret, cret}; } } while (0)
#define R2_SCAN(uu, dd, n0_) do { _Pragma("unroll") for (int i = 0; i < 8; ++i) { p[(size_t)((n0_) + i) * 4096] = pk2(s0, s1); s0 = s0 * dd[i][0] + bflo(uu[i]); s1 = s1 * dd[i][1] + bfhi(uu[i]); } } while (0)
        R2_LOAD(ua, da, 0);
        for (int n0 = 0; n0 < 128; n0 += 16) {
            R2_LOAD(ub, db, n0 + 8);
            R2_SCAN(ua, da, n0);
            if (n0 + 16 < 128) R2_LOAD(ua, da, n0 + 16);
            R2_SCAN(ub, db, n0 + 8);
        }
#undef R2_LOAD
#undef R2_SCAN
    }
}

namespace lin {
typedef float f32x16 __attribute__((ext_vector_type(16)));
typedef short v4i16_t __attribute__((ext_vector_type(4)));
constexpr int L_V = 0, L_S = 16384, L_QE = 32768, L_KE = 40960, L_KD = 40960, L_CUM = 49152, L_TOT = 65536, L_OB = 67584, OB_LD = 132, L_SIN = 101376, L_QE2 = 117760;
__device__ __forceinline__ int crow(int r, int hi) { return (r & 3) + 8 * (r >> 2) + 4 * hi; }
__device__ __forceinline__ bf16x8 trfrag(const LAS unsigned char* p) {
    const v4i16_t lo = __builtin_amdgcn_ds_read_tr16_b64_v4i16((LAS v4i16_t*)(p)), hh = __builtin_amdgcn_ds_read_tr16_b64_v4i16((LAS v4i16_t*)(p + 512));
    return (bf16x8){lo[0], lo[1], lo[2], lo[3], hh[0], hh[1], hh[2], hh[3]};
}
__device__ __forceinline__ void unpack8(const v4u w, float (&f)[8]) { f[0] = bflo(w.x); f[1] = bfhi(w.x); f[2] = bflo(w.y); f[3] = bfhi(w.y); f[4] = bflo(w.z); f[5] = bfhi(w.z); f[6] = bflo(w.w); f[7] = bfhi(w.w); }
__device__ __forceinline__ v4u pack8f(const float (&f)[8]) { v4u w; w.x = pk2(f[0], f[1]); w.y = pk2(f[2], f[3]); w.z = pk2(f[4], f[5]); w.w = pk2(f[6], f[7]); return w; }
__device__ __forceinline__ void dma_v(LAS unsigned char* lds, const bf16* vbase, int wid, int lane) {
    const bf16* vsrc = vbase + (size_t)(16 * (wid & 3) + (lane >> 2)) * PJ + (wid >> 2) * 32 + (lane & 3) * 8;
    __builtin_amdgcn_global_load_lds((const unsigned*)(vsrc), (LAS unsigned*)(lds + L_V + wid * 1024), 16, 0, 0);
    __builtin_amdgcn_global_load_lds((const unsigned*)(vsrc + 64), (LAS unsigned*)(lds + L_V + wid * 1024 + 8192), 16, 0, 0);
}
}

struct RFetch { v4u qw, kw, g0, g1; f32x4 pn0, pn1; unsigned short la[8]; };
__device__ __forceinline__ void chunk_cum_regs(LAS float* cum, LAS float* tot, const unsigned short (&la)[8], int mix, int h, int tid) {
    const int d = tid & 63, seg = tid >> 6;
    if (mix == 0) {
        const float lg = ret_logg(h);
#pragma unroll
        for (int x = 0; x < 8; ++x) { const int t = seg * 8 + x; cum[t * 64 + d] = (float)(t + 1) * lg; }
        __syncthreads(); __syncthreads();
        return;
    }
    float run = 0.f;
#pragma unroll
    for (int x = 0; x < 8; ++x) { const int t = seg * 8 + x; run += bf2f(la[x]); cum[t * 64 + d] = run; }
    tot[seg * 64 + d] = run;
    __syncthreads();
    float off = 0.f;
    for (int s = 0; s < seg; ++s) off += tot[s * 64 + d];
#pragma unroll
    for (int x = 0; x < 8; ++x) { const int t = seg * 8 + x; cum[t * 64 + d] += off; }
    __syncthreads();
}

__device__ __forceinline__ void phase_r1_mfma(const Args& a, const Frame& F) {
    using namespace lin;
    unsigned char* ws = F.ws; const bf16* proj = (const bf16*)(ws + WS_BIG); bf16* ST = (bf16*)(ws + WS_ST); float* DEC = (float*)(ws + WS_DEC);
    bf16* TOT = (bf16*)(ws + WS_TOT); float* DR = (float*)(ws + WS_DR);
    const int tid = opaque_tid(F.wave), lane = tid & 63, wid = F.wave, r32 = lane & 31, hi = lane >> 5;
    LAS unsigned char* lds = F.lds; LAS float* cum = (LAS float*)(lds + L_CUM); LAS float* tot = (LAS float*)(lds + L_TOT);
    const int t = tid >> 3, c = tid & 7;
    const int eb = wid >> 1, db = wid & 1, dcol = 32 * db + r32;
#define R1_FETCH(u_, f_) do { const int mix_ = (u_) >> 11, bh_ = ((u_) >> 7) & 15, n_ = (u_) & 127, h_ = bh_ & 3; \
        const bf16* prow_ = proj + (size_t)((bh_ >> 2) * SEQ + n_ * 64) * PJ; \
        f_.kw = *(const v4u*)(prow_ + (size_t)t * PJ + (mix_ ? C_CK : C_RK) + h_ * 64 + 8 * c); \
        if (mix_) { _Pragma("unroll") for (int x = 0; x < 8; ++x) f_.la[x] = prow_[(size_t)((tid >> 6) * 8 + x) * PJ + C_LA + h_ * 64 + (tid & 63)]; } \
        dma_v(lds, prow_ + (mix_ ? C_CV : C_RV) + h_ * 128, wid, lane); } while (0)
    RFetch cur; cur.qw = cur.g0 = cur.g1 = (v4u){0u, 0u, 0u, 0u};
    int v = F.vcu;
    if (v < 256) R1_FETCH(v * 16, cur);
    for (; v < 256; v += F.G) {
        const int sq = v >> 3, run = v & 7, mix = sq >> 4, bh = sq & 15, h = bh & 3;
        const float cret = __expf(64.0f * ret_logg(h));
        f32x16 state; float pst = 1.0f;
#pragma unroll
        for (int r = 0; r < 16; ++r) state[r] = 0.f;
#pragma unroll 1
        for (int i = 0; i < 16; ++i) {
            const int u = v * 16 + i, n = run * 16 + i;
            chunk_cum_regs(cum, tot, cur.la, mix, h, tid);
            float kf[8]; unpack8(cur.kw, kf);
            { const f32x4 c0 = *(const LAS f32x4*)(cum + t * 64 + 8 * c), c1 = *(const LAS f32x4*)(cum + t * 64 + 8 * c + 4);
              const f32x4 l0 = *(const LAS f32x4*)(cum + 63 * 64 + 8 * c), l1 = *(const LAS f32x4*)(cum + 63 * 64 + 8 * c + 4);
#pragma unroll
              for (int j = 0; j < 4; ++j) { kf[j] *= __expf(l0[j] - c0[j]); kf[4 + j] *= __expf(l1[j] - c1[j]); } }
            *(LAS v4u*)(lds + L_KD + (c >> 2) * 4096 + t * 64 + (c & 3) * 16) = pack8f(kf);
            asm volatile("s_waitcnt vmcnt(0) lgkmcnt(0)" ::: "memory"); __builtin_amdgcn_s_barrier(); asm volatile("" ::: "memory");
            const LAS unsigned char* tp = lds + ((lane >> 4) & 1) * 32 + (lane & 3) * 8 + (4 * hi + ((lane & 15) >> 2)) * 64;
            f32x16 acc;
#pragma unroll
            for (int r = 0; r < 16; ++r) acc[r] = 0.f;
#pragma unroll
            for (int ks = 0; ks < 4; ++ks) acc = __builtin_amdgcn_mfma_f32_32x32x16_bf16(trfrag(tp + L_V + eb * 4096 + ks * 1024), trfrag(tp + L_KD + db * 4096 + ks * 1024), acc, 0, 0, 0);
            const float decv = mix ? __expf(cum[63 * 64 + dcol]) : cret;
            LDS_WAIT(); __builtin_amdgcn_s_barrier(); asm volatile("" ::: "memory");
            { const int un = (i < 15) ? u + 1 : (v + F.G) * 16; if (i < 15 || v + F.G < 256) R1_FETCH(un, cur); }
            {
                LAS unsigned char* sg = lds + L_OB + wid * 2048;
#pragma unroll
                for (int r = 0; r < 16; ++r) *(LAS unsigned short*)(sg + crow(r, hi) * 64 + r32 * 2) = (unsigned short)f2bf(state[r]);
                LDS_WAIT();
                bf16* st = ST + ((size_t)(sq * 128 + n)) * 8192 + (size_t)(32 * eb) * 64 + 32 * db;
#pragma unroll
                for (int j = 0; j < 2; ++j) { const int p = lane + 64 * j, row = p >> 2, c16 = p & 3;
                    *(v4u*)(st + row * 64 + 8 * c16) = *(const LAS v4u*)(sg + row * 64 + c16 * 16); }
            }
            if (mix == 1 && eb == 0 && hi == 0) DEC[(size_t)(bh * 128 + n) * 64 + dcol] = pst;
#pragma unroll
            for (int r = 0; r < 16; ++r) state[r] = state[r] * decv + acc[r];
            pst *= decv;
        }
        bf16* tt = TOT + ((size_t)(sq * 8 + run)) * 8192 + dcol;
#pragma unroll
        for (int r = 0; r < 16; ++r) tt[(32 * eb + crow(r, hi)) * 64] = (bf16)f2bf(state[r]);
        if (eb == 0 && hi == 0) DR[(size_t)(sq * 8 + run) * 64 + dcol] = pst;
    }
#undef R1_FETCH
}

__device__ __forceinline__ void phase_r3_mfma(const Args& a, const Frame& F, int l, bool dry) {
    using namespace lin;
    unsigned char* ws = F.ws; bf16* proj = (bf16*)(ws + WS_BIG); const bf16* ST = (const bf16*)(ws + WS_ST); const float* DEC = (const float*)(ws + WS_DEC);
    const bf16* TOT = (const bf16*)(ws + WS_TOT); const float* DR = (const float*)(ws + WS_DR);
    const int tid = opaque_tid(F.wave), lane = tid & 63, wid = F.wave, r32 = lane & 31, hi = lane >> 5;
    LAS unsigned char* lds = F.lds; LAS float* cum = (LAS float*)(lds + L_CUM); LAS float* tot = (LAS float*)(lds + L_TOT); LAS float* ob = (LAS float*)(lds + L_OB);
    const int t = tid >> 3, c = tid & 7;
#define R3_FETCH(u_, f_) do { const int mix_ = (u_) >> 11, bh_ = ((u_) >> 7) & 15, n_ = (u_) & 127, h_ = bh_ & 3; \
        const bf16* prow_ = proj + (size_t)((bh_ >> 2) * SEQ + n_ * 64) * PJ; \
        f_.qw = *(const v4u*)(prow_ + (size_t)t * PJ + (mix_ ? C_CQ : C_RQ) + h_ * 64 + 8 * c); f_.kw = *(const v4u*)(prow_ + (size_t)t * PJ + (mix_ ? C_CK : C_RK) + h_ * 64 + 8 * c); \
        if (mix_) { _Pragma("unroll") for (int x = 0; x < 8; ++x) f_.la[x] = prow_[(size_t)((tid >> 6) * 8 + x) * PJ + C_LA + h_ * 64 + (tid & 63)]; \
                    const f32x4* pp_ = (const f32x4*)(DEC + (size_t)(bh_ * 128 + n_) * 64 + 8 * c); f_.pn0 = pp_[0]; f_.pn1 = pp_[1]; } \
        { const v4u* gp_ = (const v4u*)(prow_ + (size_t)t * PJ + (mix_ ? C_CG : C_RG) + h_ * 128 + 16 * c); f_.g0 = gp_[0]; f_.g1 = gp_[1]; } \
        dma_v(lds, prow_ + (mix_ ? C_CV : C_RV) + h_ * 128, wid, lane); \
        { const bf16* st_ = ST + ((size_t)((mix_ * 16 + bh_) * 128 + n_)) * 8192; \
          _Pragma("unroll") for (int i_ = 0; i_ < 2; ++i_) { const int p = wid + 8 * i_, cc = p >> 1, e0 = 64 * (p & 1); \
            __builtin_amdgcn_global_load_lds((const unsigned*)(st_ + (size_t)(e0 + lane) * 64 + cc * 8), (LAS unsigned*)(lds + L_S + cc * 2048 + e0 * 16), 16, 0, 0); } } } while (0)
    RFetch cur;
    int v = F.vcu;
    for (; v < 256; v += F.G) {
        const int sq = v >> 3, run = v & 7, mix = sq >> 4, bh = sq & 15, b = bh >> 2, h = bh & 3;
        const float lg64 = 64.0f * ret_logg(h);
        {
            const int e = tid >> 2, d0 = (tid & 3) * 16; float sv[16];
#pragma unroll
            for (int k = 0; k < 16; ++k) sv[k] = 0.f;
#pragma unroll 1
            for (int q = 0; q < run; ++q) {
                const v4u* tp_ = (const v4u*)(TOT + ((size_t)(sq * 8 + q)) * 8192 + e * 64 + d0); const f32x4* dp_ = (const f32x4*)(DR + (size_t)(sq * 8 + q) * 64 + d0);
                float tv[16]; { float t0[8], t1[8]; unpack8(tp_[0], t0); unpack8(tp_[1], t1);
#pragma unroll
                  for (int k = 0; k < 8; ++k) { tv[k] = t0[k]; tv[8 + k] = t1[k]; } }
#pragma unroll
                for (int k4 = 0; k4 < 4; ++k4) { const f32x4 d4 = dp_[k4];
#pragma unroll
                    for (int k = 0; k < 4; ++k) sv[4 * k4 + k] = sv[4 * k4 + k] * d4[k] + tv[4 * k4 + k]; }
            }
            float s0[8], s1[8];
#pragma unroll
            for (int k = 0; k < 8; ++k) { s0[k] = sv[k]; s1[k] = sv[8 + k]; }
            *(LAS v4u*)(lds + L_SIN + ((tid & 3) * 2) * 2048 + e * 16) = pack8f(s0); *(LAS v4u*)(lds + L_SIN + ((tid & 3) * 2 + 1) * 2048 + e * 16) = pack8f(s1);
        }
        R3_FETCH(v * 16, cur);
#pragma unroll 1
        for (int i = 0; i < 16; ++i) {
            const int u = v * 16 + i, n = run * 16 + i;
            bf16* prow = proj + (size_t)(b * SEQ + n * 64) * PJ;
            const int cg = (mix ? C_CG : C_RG) + h * 128;
            const float* gn = uni(mix ? a.gla_norm : a.ret_norm) + l * 128;
            chunk_cum_regs(cum, tot, cur.la, mix, h, tid);
            { float qf[8], kf[8], q2[8]; unpack8(cur.qw, qf); unpack8(cur.kw, kf);
              const f32x4 c0 = *(const LAS f32x4*)(cum + t * 64 + 8 * c), c1 = *(const LAS f32x4*)(cum + t * 64 + 8 * c + 4);
              const float pret = __expf(lg64 * (float)i);
#pragma unroll
              for (int j = 0; j < 4; ++j) { const float e0 = __expf(c0[j]), e1 = __expf(c1[j]); qf[j] *= e0; qf[4 + j] *= e1; kf[j] *= __builtin_amdgcn_rcpf(e0); kf[4 + j] *= __builtin_amdgcn_rcpf(e1);
                  q2[j] = qf[j] * (mix ? cur.pn0[j] : pret); q2[4 + j] = qf[4 + j] * (mix ? cur.pn1[j] : pret); }
              *(LAS v4u*)(lds + L_QE + c * 1024 + t * 16) = pack8f(qf); *(LAS v4u*)(lds + L_KE + c * 1024 + t * 16) = pack8f(kf); *(LAS v4u*)(lds + L_QE2 + c * 1024 + t * 16) = pack8f(q2); }
            const v4u gw0 = cur.g0, gw1 = cur.g1;
            asm volatile("s_waitcnt vmcnt(0) lgkmcnt(0)" ::: "memory"); __builtin_amdgcn_s_barrier(); asm volatile("" ::: "memory");
            {
                const int ib = wid & 1, eb = wid >> 1;
                bf16x8 qe[4];
#pragma unroll
                for (int d0 = 0; d0 < 4; ++d0) qe[d0] = *(const LAS bf16x8*)(lds + L_QE + (2 * d0 + hi) * 1024 + (32 * ib + r32) * 16);
                f32x16 p0, p1;
#pragma unroll
                for (int r = 0; r < 16; ++r) { p0[r] = 0.f; p1[r] = 0.f; }
                const LAS unsigned char* kb = lds + L_KE + hi * 1024 + r32 * 16;
#pragma unroll
                for (int d0 = 0; d0 < 4; ++d0) p0 = __builtin_amdgcn_mfma_f32_32x32x16_bf16(*(const LAS bf16x8*)(kb + d0 * 2048), qe[d0], p0, 0, 0, 0);
                if (ib == 1) {
#pragma unroll
                    for (int d0 = 0; d0 < 4; ++d0) p1 = __builtin_amdgcn_mfma_f32_32x32x16_bf16(*(const LAS bf16x8*)(kb + d0 * 2048 + 512), qe[d0], p1, 0, 0, 0);
#pragma unroll
                    for (int r = 0; r < 16; ++r) if (crow(r, hi) > r32) p1[r] = 0.f;
                } else {
#pragma unroll
                    for (int r = 0; r < 16; ++r) if (crow(r, hi) > r32) p0[r] = 0.f;
                }
                bf16x8 pa[4];
                { v4u w0 = {cvtpk2(p0[0], p0[1]), cvtpk2(p0[2], p0[3]), cvtpk2(p0[4], p0[5]), cvtpk2(p0[6], p0[7])};
                  v4u w1 = {cvtpk2(p0[8], p0[9]), cvtpk2(p0[10], p0[11]), cvtpk2(p0[12], p0[13]), cvtpk2(p0[14], p0[15])};
                  v4u w2 = {cvtpk2(p1[0], p1[1]), cvtpk2(p1[2], p1[3]), cvtpk2(p1[4], p1[5]), cvtpk2(p1[6], p1[7])};
                  v4u w3 = {cvtpk2(p1[8], p1[9]), cvtpk2(p1[10], p1[11]), cvtpk2(p1[12], p1[13]), cvtpk2(p1[14], p1[15])};
                  pa[0] = __builtin_bit_cast(bf16x8, w0); pa[1] = __builtin_bit_cast(bf16x8, w1); pa[2] = __builtin_bit_cast(bf16x8, w2); pa[3] = __builtin_bit_cast(bf16x8, w3); }
                f32x16 o;
#pragma unroll
                for (int r = 0; r < 16; ++r) o[r] = 0.f;
                const LAS unsigned char* vp = lds + L_V + eb * 4096 + ((lane >> 4) & 1) * 32 + (lane & 3) * 8 + (4 * hi + ((lane & 15) >> 2)) * 64;
#pragma unroll
                for (int ks = 0; ks < 4; ++ks) o = __builtin_amdgcn_mfma_f32_32x32x16_bf16(pa[ks], trfrag(vp + ks * 1024), o, 0, 0, 0);
#pragma unroll
                for (int d0 = 0; d0 < 4; ++d0) o = __builtin_amdgcn_mfma_f32_32x32x16_bf16(qe[d0], *(const LAS bf16x8*)(lds + L_S + (2 * d0 + hi) * 2048 + (32 * eb + r32) * 16), o, 0, 0, 0);
#pragma unroll
                for (int d0 = 0; d0 < 4; ++d0) o = __builtin_amdgcn_mfma_f32_32x32x16_bf16(*(const LAS bf16x8*)(lds + L_QE2 + (2 * d0 + hi) * 1024 + (32 * ib + r32) * 16),
                                                                                         *(const LAS bf16x8*)(lds + L_SIN + (2 * d0 + hi) * 2048 + (32 * eb + r32) * 16), o, 0, 0, 0);
#pragma unroll
                for (int r = 0; r < 16; ++r) ob[(32 * ib + crow(r, hi)) * OB_LD + 32 * eb + r32] = o[r];
            }
            LDS_WAIT(); __builtin_amdgcn_s_barrier(); asm volatile("" ::: "memory");
            if (i < 15) R3_FETCH(u + 1, cur);
            {
                const int ii = tid >> 3, sg = tid & 7;
                f32x4 vv[4]; float ss = 0.f;
#pragma unroll
                for (int k = 0; k < 4; ++k) { vv[k] = *(const LAS f32x4*)(ob + ii * OB_LD + 16 * sg + 4 * k); ss += (vv[k][0] * vv[k][0] + vv[k][1] * vv[k][1]) + (vv[k][2] * vv[k][2] + vv[k][3] * vv[k][3]); }
                ss = xadd<1>(ss); ss = xadd<2>(ss); ss = xadd<4>(ss);
                const float rstd = __builtin_amdgcn_rsqf(ss * (1.0f / 128.0f) + EPS);
                v4u* gp = (v4u*)(prow + (size_t)ii * PJ + cg + 16 * sg);
#pragma unroll
                for (int k2 = 0; k2 < 2; ++k2) { const v4u gw = k2 ? gw1 : gw0; float gf[8]; unpack8(gw, gf);
                    const f32x4 g0 = *(const f32x4*)(gn + 16 * sg + 8 * k2), g1 = *(const f32x4*)(gn + 16 * sg + 8 * k2 + 4);
                    float y[8];
#pragma unroll
                    for (int j = 0; j < 4; ++j) { y[j] = vv[2 * k2][j] * rstd * g0[j] * gf[j]; y[4 + j] = vv[2 * k2 + 1][j] * rstd * g1[j] * gf[4 + j]; }
                    if (!dry) gp[k2] = pack8f(y); }
            }
        }
        LDS_WAIT(); __builtin_amdgcn_s_barrier(); asm volatile("" ::: "memory");
    }
#undef R3_FETCH
}

namespace att {
typedef float f32x16 __attribute__((ext_vector_type(16)));
typedef short v4i16_t __attribute__((ext_vector_type(4)));
constexpr int SLOT = 16384, L_K = 0, L_V = 3 * SLOT, L_WS = 6 * SLOT, L_XCH = 0, L_STG = 65536;
constexpr float THR = 8.0f;
__device__ __forceinline__ int crow(int r, int hi) { return (r & 3) + 8 * (r >> 2) + 4 * hi; }
__device__ __forceinline__ float swapmax(float m) { auto rr = __builtin_amdgcn_permlane32_swap(__float_as_uint(m), __float_as_uint(m), false, false); return fmaxf(__uint_as_float(rr[0]), __uint_as_float(rr[1])); }
__device__ __forceinline__ float max3f(float a, float b, float c) { return __builtin_fmaxf(__builtin_fmaxf(a, b), c); }
__device__ __forceinline__ float swapadd(float m) { auto rr = __builtin_amdgcn_permlane32_swap(__float_as_uint(m), __float_as_uint(m), false, false); return __uint_as_float(rr[0]) + __uint_as_float(rr[1]); }
__device__ __forceinline__ unsigned cvtpk(float lo, float hi) { typedef float f2 __attribute__((ext_vector_type(2))); typedef __bf16 b2 __attribute__((ext_vector_type(2))); f2 v = {lo, hi}; b2 b = __builtin_convertvector(v, b2); return __builtin_bit_cast(unsigned, b); }

__device__ __forceinline__ void attn_unit(LAS unsigned char* lds, bf16* proj, int tid, int wid, int b, int h, int qb, float lam, float post, const float* gn, bool dry,
                                          const Args& a, unsigned char* wnext, int lnext, int it0, int it1) {
    const int lane = tid & 63, r32 = lane & 31, hi = lane >> 5, mp = wid & 1, rw = wid >> 1;
    const size_t rowbase = (size_t)b * SEQ; const int q0 = qb * 128;
    const int NT = 2 * qb + 2, NTw = 2 * qb + 1 + (rw >> 1);
    const bf16* Kh = proj + rowbase * PJ + C_AK + h * 128; const bf16* Vh = proj + rowbase * PJ + C_AV + h * 128;
    const unsigned kvoff = (unsigned)(lane * PJ + wid * 8) * 2u;
    const unsigned vvoff = (unsigned)((16 * (wid & 3) + (lane >> 2)) * PJ + (wid >> 2) * 32 + (lane & 3) * 8) * 2u;
    const unsigned kdst = L_K + wid * 1024, vdst = L_V + wid * 1024;
    const unsigned ldsb = (unsigned)(size_t)lds;
#define ATT_DMA(t, slot) do { const char* kt_ = (const char*)uni(Kh + (size_t)(t) * 64 * PJ); const char* vt_ = (const char*)uni(Vh + (size_t)(t) * 64 * PJ); \
        const unsigned kd_ = (unsigned)__builtin_amdgcn_readfirstlane((int)(ldsb + kdst + (slot) * SLOT)), vd_ = (unsigned)__builtin_amdgcn_readfirstlane((int)(ldsb + vdst + (slot) * SLOT)); \
        glds16s<0>(kt_, kvoff, kd_); glds16s<0>(kt_ + 128, kvoff, kd_ + 8192); glds16s<0>(vt_, vvoff, vd_); glds16s<0>(vt_ + 128, vvoff, vd_ + 8192); } while (0)
#define ATT_DMA1(t, slot, P_) do { const char* bt_ = (const char*)uni(((P_) < 2 ? Kh : Vh) + (size_t)(t) * 64 * PJ) + ((P_) & 1) * 128; \
        const unsigned dd_ = (unsigned)__builtin_amdgcn_readfirstlane((int)(ldsb + ((P_) < 2 ? kdst : vdst) + (slot) * SLOT + ((P_) & 1) * 8192)); \
        glds16s<0>(bt_, (P_) < 2 ? kvoff : vvoff, dd_); } while (0)
    bf16x8 qr[4];
    { const bf16* qp = proj + (rowbase + q0 + 32 * rw + r32) * PJ + C_AQ + h * 128 + mp * 64 + hi * 8;
#pragma unroll
      for (int d0 = 0; d0 < 4; ++d0) qr[d0] = *(const bf16x8*)(qp + d0 * 16); }
    ATT_DMA(0, 0); ATT_DMA(1, 1);
    f32x16 o[4];
#pragma unroll
    for (int d = 0; d < 4; ++d)
#pragma unroll
        for (int r = 0; r < 16; ++r) o[d][r] = 0.f;
    float mref = 0.f, lsum = 0.f;
    float one_ = 1.0f; asm volatile("" : "+v"(one_));
    f32x16 negm;
#pragma unroll
    for (int r = 0; r < 16; ++r) negm[r] = 0.f;
    volatile LAS float* wsf = (volatile LAS float*)(lds + L_WS) + wid * 64;
    const LAS unsigned char* kb0 = lds + L_K + mp * 8192 + hi * 1024 + r32 * 16;
    const LAS unsigned char* vp0 = lds + L_V + ((lane >> 4) & 1) * 32 + (lane & 3) * 8 + (4 * hi + ((lane & 15) >> 2)) * 64;
#define ATT_KLOAD(slot) do { _Pragma("unroll") for (int d0 = 0; d0 < 4; ++d0) { kf[2 * d0] = *(const LAS bf16x8*)(kb0 + (slot) * SLOT + d0 * 2048); kf[2 * d0 + 1] = *(const LAS bf16x8*)(kb0 + (slot) * SLOT + d0 * 2048 + 512); } } while (0)
#define ATT_VLOAD(dst, slot, d0_) do { _Pragma("unroll") for (int ks_ = 0; ks_ < 4; ++ks_) { \
        const v4i16_t lo_ = __builtin_amdgcn_ds_read_tr16_b64_v4i16((LAS v4i16_t*)(vp0 + (slot) * SLOT + (d0_) * 4096 + ks_ * 1024)); \
        const v4i16_t hh_ = __builtin_amdgcn_ds_read_tr16_b64_v4i16((LAS v4i16_t*)(vp0 + (slot) * SLOT + (d0_) * 4096 + ks_ * 1024 + 512)); \
        dst[ks_] = (bf16x8){lo_[0], lo_[1], lo_[2], lo_[3], hh_[0], hh_[1], hh_[2], hh_[3]}; } } while (0)
#define ATT_PV(d0_, vf_) do { _Pragma("unroll") for (int ks_ = 0; ks_ < 4; ++ks_) o[d0_] = __builtin_amdgcn_mfma_f32_32x32x16_bf16(pa[ks_], vf_[ks_], o[d0_], 0, 0, 0); } while (0)
    asm volatile("s_waitcnt vmcnt(4)" ::: "memory"); LDS_WAIT(); __builtin_amdgcn_s_barrier(); asm volatile("" ::: "memory");
    bf16x8 kf[8];
    ATT_KLOAD(0);
#define ATT_PARTA(FIRST_, p0, p1) \
            float ra = max3f(p0[0], p0[1], p1[0]), rb = max3f(p0[2], p0[3], p1[1]); ra = max3f(ra, p1[2], p1[3]); \
            _Pragma("unroll") for (int r = 4; r < 16; r += 4) { ra = max3f(ra, p0[r], p0[r + 1]); rb = max3f(rb, p0[r + 2], p0[r + 3]); ra = max3f(ra, p1[r], p1[r + 1]); rb = max3f(rb, p1[r + 2], p1[r + 3]); } \
            float rm = swapmax(fmaxf(ra, rb)); \
            if ((FIRST_) || __any(rm > THR)) { \
                const float dl = (FIRST_) ? rm : fmaxf(rm, 0.f); \
                mref += dl; \
                _Pragma("unroll") for (int r = 0; r < 16; ++r) { p0[r] -= dl; p1[r] -= dl; negm[r] = -mref; } \
                fres_ = fast_exp2(-dl); lsum *= fres_; need_ = !(FIRST_); }
#define ATT_PARTB(p0, p1, pk) \
            { float sacc = 0.f, sbcc = 0.f; \
            _Pragma("unroll") for (int r = 0; r < 16; ++r) { p0[r] = fast_exp2(p0[r]); p1[r] = fast_exp2(p1[r]); sacc += p0[r]; sbcc = __builtin_fmaf(p1[r], one_, sbcc); } \
            lsum += sacc + sbcc; \
            { v4u w0 = {cvtpk(p0[0], p0[1]), cvtpk(p0[2], p0[3]), cvtpk(p0[4], p0[5]), cvtpk(p0[6], p0[7])}; \
              v4u w1 = {cvtpk(p0[8], p0[9]), cvtpk(p0[10], p0[11]), cvtpk(p0[12], p0[13]), cvtpk(p0[14], p0[15])}; \
              v4u w2 = {cvtpk(p1[0], p1[1]), cvtpk(p1[2], p1[3]), cvtpk(p1[4], p1[5]), cvtpk(p1[6], p1[7])}; \
              v4u w3 = {cvtpk(p1[8], p1[9]), cvtpk(p1[10], p1[11]), cvtpk(p1[12], p1[13]), cvtpk(p1[14], p1[15])}; \
              pk[0] = __builtin_bit_cast(bf16x8, w0); pk[1] = __builtin_bit_cast(bf16x8, w1); pk[2] = __builtin_bit_cast(bf16x8, w2); pk[3] = __builtin_bit_cast(bf16x8, w3); } }
#define ATT_POST() \
            if (need_) { if (hi == 0) wsf[r32] = fres_; \
                _Pragma("unroll") for (int r = 0; r < 16; ++r) { const float fr = wsf[crow(r, hi)]; \
                    _Pragma("unroll") for (int d = 0; d < 4; ++d) o[d][r] *= fr; } }
#define ATT_SB() __builtin_amdgcn_sched_barrier(0)
#define ATT_QK(p0, p1) do { p0 = __builtin_amdgcn_mfma_f32_32x32x16_bf16(kf[0], qr[0], negm, 0, 0, 0); p1 = __builtin_amdgcn_mfma_f32_32x32x16_bf16(kf[1], qr[0], negm, 0, 0, 0); \
        _Pragma("unroll") for (int d0 = 1; d0 < 4; ++d0) { p0 = __builtin_amdgcn_mfma_f32_32x32x16_bf16(kf[2 * d0], qr[d0], p0, 0, 0, 0); p1 = __builtin_amdgcn_mfma_f32_32x32x16_bf16(kf[2 * d0 + 1], qr[d0], p1, 0, 0, 0); } } while (0)
#define ATT_STEP(T_, SL_, SL1_, SL2_, G_DMA, ACT_, ACTN_) do { \
        if (ACTN_) ATT_KLOAD(SL1_); \
        if (G_DMA) ATT_DMA1((T_) + 2, SL2_, 0); \
        if (ACT_) { ATT_PV(0, va); ATT_VLOAD(va, SL_, 2); } \
        ATT_SB(); \
        if (G_DMA) ATT_DMA1((T_) + 2, SL2_, 1); \
        bool need_ = false; float fres_ = 1.0f; \
        if (ACTN_) { ATT_QK(ps0, ps1); ATT_SB(); if (G_DMA) ATT_DMA1((T_) + 2, SL2_, 2); ATT_PARTA(false, ps0, ps1) } \
        else if (G_DMA) ATT_DMA1((T_) + 2, SL2_, 2); \
        ATT_SB(); \
        if (G_DMA) ATT_DMA1((T_) + 2, SL2_, 3); \
        if (ACT_) { ATT_PV(1, vb); ATT_VLOAD(vb, SL_, 3); ATT_PV(2, va); ATT_PV(3, vb); } \
        if (ACTN_) { ATT_PARTB(ps0, ps1, pn) asm volatile("" :: "v"(pn[0]), "v"(pn[1]), "v"(pn[2]), "v"(pn[3]), "v"(lsum)); }        \
        _Pragma("unroll") for (int g_ = 0; g_ < 12; ++g_) { __builtin_amdgcn_sched_group_barrier(0x008, 1, 0); __builtin_amdgcn_sched_group_barrier(0x100, 1, 0); __builtin_amdgcn_sched_group_barrier(0x002, 7, 0); } \
        ATT_SB(); \
        if (ACTN_) { ATT_POST() _Pragma("unroll") for (int i_ = 0; i_ < 4; ++i_) pa[i_] = pn[i_]; \
            ATT_VLOAD(va, SL1_, 0); ATT_VLOAD(vb, SL1_, 1); } \
        ATT_SB(); \
    } while (0)
#define ATT_BARRIER() do { asm volatile("s_waitcnt vmcnt(0)" ::: "memory"); __builtin_amdgcn_s_barrier(); asm volatile("" ::: "memory"); } while (0)
    f32x16 ps0, ps1; bf16x8 pa[4], pn[4];
#pragma unroll
    for (int i = 0; i < 4; ++i) { pa[i] = (bf16x8){0, 0, 0, 0, 0, 0, 0, 0}; pn[i] = pa[i]; }
    bf16x8 va[4], vb[4];
    ATT_QK(ps0, ps1);
    ATT_VLOAD(va, 0, 0); ATT_VLOAD(vb, 0, 1);
    { bool need_ = false; float fres_ = 1.0f; ATT_PARTA(true, ps0, ps1) ATT_PARTB(ps0, ps1, pa) (void)need_; (void)fres_; }
    int t = 0;
    for (; t + 5 <= NT; t += 3) {
        ATT_BARRIER(); ATT_STEP(t, 0, 1, 2, true, true, true);
        ATT_BARRIER(); ATT_STEP(t + 1, 1, 2, 0, true, true, true);
        ATT_BARRIER(); ATT_STEP(t + 2, 2, 0, 1, true, true, true);
    }
    {
        int sl = 0, sl1 = 1, sl2 = 2;
        for (; t < NT; ++t) {
            if (t + 1 < NT) ATT_BARRIER();
            ATT_STEP(t, sl, sl1, sl2, (t + 2 < NT), (t < NTw), (t + 1 < NTw));
            const int s0 = sl; sl = sl1; sl1 = sl2; sl2 = s0;
        }
    }
#undef ATT_STEP
#undef ATT_PARTA
#undef ATT_PARTB
#undef ATT_POST
#undef ATT_BARRIER
#undef ATT_QK
#undef ATT_FAST
#undef ATT_SB
#undef ATT_KLOAD
#undef ATT_VLOAD
#undef ATT_PV
    int lane_e = lane; asm volatile("" : "+v"(lane_e)); const int r32e = lane_e & 31, hie = lane_e >> 5;
    const ConvJob cj0 = conv_job(a, wnext, lnext, it0), cj1 = conv_job(a, wnext, lnext, it1); f32x4 ct0[8], ct1[8];
    conv_load(cj0, lane_e, ct0); conv_load(cj1, lane_e, ct1);
    lsum = swapadd(lsum);
    if (hie == 0) wsf[r32e] = 1.0f / lsum;
#pragma unroll
    for (int r = 0; r < 16; ++r) { const float fr = wsf[crow(r, hie)];
#pragma unroll
        for (int d = 0; d < 4; ++d) o[d][r] *= fr; }
    LDS_WAIT(); __builtin_amdgcn_s_barrier(); asm volatile("" ::: "memory");
    LAS float* xch = (LAS float*)(lds + L_XCH) + rw * 4096 + lane_e;
    if (mp == 1) {
#pragma unroll
        for (int d = 0; d < 4; ++d)
#pragma unroll
            for (int r = 0; r < 16; ++r) xch[(d * 16 + r) * 64] = o[d][r];
    }
    LDS_WAIT(); __builtin_amdgcn_s_barrier(); asm volatile("" ::: "memory");
    if (mp == 0) {
        float ss[16];
#pragma unroll
        for (int r = 0; r < 16; ++r) ss[r] = 0.f;
#pragma unroll
        for (int d = 0; d < 4; ++d)
#pragma unroll
            for (int r = 0; r < 16; ++r) { const float y = o[d][r] - lam * xch[(d * 16 + r) * 64]; o[d][r] = y; ss[r] += y * y; }
#pragma unroll
        for (int r = 0; r < 16; ++r) {
            ss[r] = xadd<1>(ss[r]); ss[r] = xadd<2>(ss[r]); ss[r] = xadd<4>(ss[r]); ss[r] = xadd<8>(ss[r]); ss[r] = xadd<16>(ss[r]);
            ss[r] = post * __builtin_amdgcn_rsqf(ss[r] * (1.0f / 128.0f) + EPS);
        }
        LAS bf16* stg = (LAS bf16*)(lds + L_STG + rw * 8192);
#pragma unroll
        for (int d = 0; d < 4; ++d) { const float g = gn[32 * d + r32e];
#pragma unroll
            for (int r = 0; r < 16; ++r) stg[crow(r, hie) * 128 + 32 * d + r32e] = (bf16)f2bf(o[d][r] * ss[r] * g); }
        LDS_WAIT();
        bf16* orow = proj + (rowbase + q0 + 32 * rw) * PJ + C_AQ + h * 128;
#pragma unroll
        for (int i = 0; i < 8; ++i) { const int row = i * 4 + (lane_e >> 4), ch = lane_e & 15;
            const v4u v = *(const LAS v4u*)(stg + row * 128 + ch * 8); if (!dry) *(v4u*)(orow + (size_t)row * PJ + ch * 8) = v; }
    }
    conv_store(cj0, lane_e, ct0); conv_store(cj1, lane_e, ct1);
    LDS_WAIT(); __builtin_amdgcn_s_barrier(); asm volatile("" ::: "memory");
#undef ATT_DMA
#undef ATT_DMA1
}
}

__device__ __forceinline__ void phase_attn(const Args& a, const Frame& F, int l, bool dry, unsigned char* wnext) {
    unsigned char* ws = F.ws; bf16* proj = (bf16*)(ws + WS_BIG);
    const float lam = ((const float*)(ws + WS_LAM))[l];
    const float post = 1.0f - LAM_INIT[l];
    const float* gn = uni(a.da_norm) + l * 128;
    const int tid = opaque_tid(F.wave);
    for (int v = F.vcu; v < 256; v += F.G) {
        const int bh = v >> 4, s = v & 15;
#pragma unroll 1
        for (int i = 0; i < 4; ++i) {
            const int qb = (i == 0) ? 63 - s : (i == 1) ? 32 + s : (i == 2) ? 31 - s : s;
            const bool cv = (wnext != nullptr) && (v == F.vcu);
            const int gw = F.vcu * 8 + F.wave, NGW = F.G * 8;
            att::attn_unit(F.lds, proj, tid, F.wave, bh >> 2, bh & 3, qb, lam, post, gn, dry, a, wnext, l + 1, cv ? gw + (2 * i) * NGW : -1, cv ? gw + (2 * i + 1) * NGW : -1);
            if (cv && i == 3) {
                int lane = tid & 63; asm volatile("" : "+v"(lane));
                for (int it = gw + 8 * NGW; it < I_TOTAL - I_LA; it += NGW) conv_item(a, wnext, l + 1, it, lane);
                for (int r = gw; r < I_LA; r += NGW) conv_la_item(a, wnext, l + 1, r, lane);
                if (gw == 0) conv_lam(a, F.ws, l + 1, lane);
            }
        }
    }
}


constexpr int NPH = 12;
constexpr int N_PHASES = DEPTH * NPH + 1;
#ifndef REP_UP
#define REP_UP 1
#endif
#ifndef REP_DOWN
#define REP_DOWN 1
#endif
#ifndef REP_INPROJ
#define REP_INPROJ 1
#endif
#ifndef REP_R
#define REP_R 1
#endif
#ifndef REP_ATTN
#define REP_ATTN 1
#endif
#ifndef REP_G
#define REP_G 1
#endif
#ifndef REP_M
#define REP_M 1
#endif
#ifndef REP_R2
#define REP_R2 1
#endif
#ifndef REP_NORM
#define REP_NORM 1
#endif
#ifndef MK_PER_PHASE
#define MK_PER_PHASE 0
#endif

__global__ void __launch_bounds__(512, 2) mk_fwd(Args a) {
    extern __shared__ __attribute__((aligned(16))) unsigned char lds_raw[];
    Frame F;
    F.lds = (LAS unsigned char*)lds_raw; F.ws = uni(a.ws); F.wave = __builtin_amdgcn_readfirstlane((int)threadIdx.x >> 6);
    F.G = gridDim.x; { const int bx = blockIdx.x; F.vcu = (F.G % 8 == 0) ? (bx % 8) * (F.G / 8) + bx / 8 : bx; }
    volatile LAS unsigned* MISC = (volatile LAS unsigned*)(F.lds + MISC_OFF);
    if (threadIdx.x < 32) MISC[threadIdx.x] = 0u;
    __syncthreads();
    XcdBarrier bar; bar.bar = (unsigned*)(F.ws + WS_CTL); bar.x = 0; bar.st = nullptr;
    if (!MK_PER_PHASE) bar = xcd_barrier_post((unsigned*)(F.ws + WS_CTL), MISC + 8);
    const int lo = a.ph_lo, hi = a.ph_hi;
#define RUN(k) (lo <= (k) && (k) < hi)
#define SEAM(k) do { if (RUN(k) && RUN((k) + 1)) xcd_barrier(bar); } while (0)
    unsigned char* ws = F.ws; float* const outp = uni(a.out);
    bf16* XB = (bf16*)(ws + WS_HN); bf16* BIG = (bf16*)(ws + WS_BIG); bf16* MG = (bf16*)(ws + WS_ST); float* SSQ = (float*)(ws + WS_SSQ);
    const int cid = (int)blockIdx.x;

    if (RUN(0)) phase_rope(F);
    for (int l = 0; l < DEPTH; ++l) {
        const int pb = l * NPH;
        unsigned char* const wb1 = (unsigned char*)((unsigned long long)outp - WS_W);
        unsigned char* const wcur = (l & 1) ? wb1 : ws; unsigned char* const wnxt = (l + 1 < DEPTH) ? ((l & 1) ? ws : wb1) : nullptr;
        if (RUN(pb)) {
            for (int rep = 0; rep < REP_NORM; ++rep) {
            if (l == 0) phase_conv(a, F, 0, ws);
            if (l == 0) phase_prep(F, uni(a.x), XB, SSQ);
            }
        }
        if (l == 0) SEAM(pb);
        for (int hf = 0; hf < 2; ++hf) {
            const int p0 = pb + (hf ? 10 : 1);
            const float* ssq_in = SSQ + (size_t)(hf ? 2 : 0) * M * 16;
            float* ssq_out = SSQ + (size_t)(hf ? 0 : 1) * M * 16;
            if (RUN(p0)) {
                pg8::Gemm g{(const char*)XB, (const char*)(wcur + (hf ? W_13B : W_13A)), DMODEL, DMODEL, DMODEL, 0, 0};
                pg8::Order<(2 * DFFP) / 256, 1> S; S.init(F.G, cid, F.wave);
                pg8::EpiSwiGLU E{BIG, ssq_in};
                for (int rep = 0; rep < REP_UP; ++rep)
                pg8::gemm_phase<pg8::EpiSwiGLU, true>(F.lds, g, S, E);
            }
            SEAM(p0);
            if (RUN(p0 + 1)) {
                pg8::Gemm g{(const char*)BIG, (const char*)(wcur + (hf ? W_2B : W_2A)), DFFP, DFFP, DFFP, 0, 0};
                pg8::Order<(DMODEL) / 256, 1> S; S.init(F.G, cid, F.wave);
                for (int rep = 0; rep < REP_DOWN; ++rep) {
                pg8::EpiResid E{XB, 0.5f, 2.0f, rep < REP_DOWN - 1, ssq_out};
                pg8::gemm_phase<pg8::EpiResid, true>(F.lds, g, S, E); }
            }
            SEAM(p0 + 1);
            if (hf == 0) {
                const float* ssq_mix = ssq_out;
                if (RUN(pb + 3)) {
                    pg8::Gemm g{(const char*)XB, (const char*)(wcur + W_IN), DMODEL, DMODEL, DMODEL, 0, 0};
                    pg8::Order<(PJ) / 256, 1> S; S.init(F.G, cid, F.wave);
                    pg8::EpiInProj E{BIG, (const float*)(ws + WS_ROPE), uni(a.gla_ab) + l * 256, ssq_mix};
                    for (int rep = 0; rep < REP_INPROJ; ++rep)
                    pg8::gemm_phase<pg8::EpiInProj, true>(F.lds, g, S, E);
                }
                SEAM(pb + 3);
                if (RUN(pb + 4)) for (int rep = 0; rep < REP_R; ++rep) phase_r1_mfma(a, F);
                SEAM(pb + 4);
                if (RUN(pb + 6)) {
                    for (int rep = 0; rep < REP_R; ++rep) phase_r3_mfma(a, F, l, rep < REP_R - 1);
                    for (int rep = 0; rep < REP_ATTN; ++rep) phase_attn(a, F, l, rep < REP_ATTN - 1, rep == REP_ATTN - 1 ? wnxt : nullptr);
                }
                SEAM(pb + 6);
                if (RUN(pb + 7)) {
                    pg8::Gemm g{(const char*)XB, (const char*)(wcur + W_G), DMODEL, DMODEL, DMODEL, 0, 0};
                    pg8::Order<(3 * DMODEL) / 256, 1> S; S.init(F.G, cid, F.wave);
                    pg8::EpiGates E{BIG, ssq_mix};
                    for (int rep = 0; rep < REP_G; ++rep)
                    pg8::gemm_phase<pg8::EpiGates, true>(F.lds, g, S, E);
                }
                SEAM(pb + 7);
                if (RUN(pb + 8)) {
                    pg8::Gemm g{(const char*)BIG, (const char*)(wcur + W_B), PJ, 512, 512, 512 * 2, (size_t)DMODEL * 512 * 2};
                    pg8::Order<(DMODEL) / 256, 3> S; S.init(F.G, cid, F.wave);
                    pg8::EpiMerge E{BIG, MG};
                    for (int rep = 0; rep < REP_M; ++rep)
                    pg8::gemm_phase<pg8::EpiMerge, true>(F.lds, g, S, E);
                }
                SEAM(pb + 8);
                if (RUN(pb + 9)) {
                    pg8::Gemm g{(const char*)MG, (const char*)(wcur + W_O), DMODEL, DMODEL, DMODEL, 0, 0};
                    pg8::Order<(DMODEL) / 256, 1> S; S.init(F.G, cid, F.wave);
                    pg8::EpiResid E{XB, 1.0f, 1.0f, false, SSQ + (size_t)2 * M * 16};
                    pg8::gemm_phase<pg8::EpiResid, true>(F.lds, g, S, E);
                }
                SEAM(pb + 9);
            }
        }
    }
    if (RUN(DEPTH * NPH)) phase_final_norm(F, XB, outp, uni(a.final_norm), SSQ);
#undef RUN
#undef SEAM
}

extern "C" void kernel_launch(void* const* d_in, const int* in_sizes, int n_in, void* d_out, int out_size, void* d_ws, size_t ws_size, hipStream_t stream) {
    static int grid = 0;
    if (grid == 0) {
        if (n_in != 22 || in_sizes[0] != M * DMODEL || out_size != M * DMODEL || ws_size < WS_END) { fprintf(stderr, "kernel_launch: unexpected shapes (n_in %d, ws %zu)\n", n_in, ws_size); grid = -1; return; }
        int dev = 0, cus = 0, per_cu = 0;
        if (hipGetDevice(&dev) != hipSuccess || hipDeviceGetAttribute(&cus, hipDeviceAttributeMultiprocessorCount, dev) != hipSuccess) { grid = -1; return; }
        if (hipFuncSetAttribute((const void*)mk_fwd, hipFuncAttributeMaxDynamicSharedMemorySize, LDS_BYTES) != hipSuccess) { fprintf(stderr, "kernel_launch: hipFuncSetAttribute failed\n"); grid = -1; return; }
        if (hipOccupancyMaxActiveBlocksPerMultiprocessor(&per_cu, (const void*)mk_fwd, 512, LDS_BYTES) != hipSuccess || per_cu < 1) fprintf(stderr, "kernel_launch: occupancy query says %d\n", per_cu);
        (void)hipGetLastError();
        grid = cus;
    }
    if (grid < 0) return;
    if (hipMemsetAsync((char*)d_ws + WS_CTL, 0, CTL_ZERO_BYTES, stream) != hipSuccess) return;
    Args a{};
    a.x = (const float*)d_in[0]; a.ffn1_norm = (const float*)d_in[1]; a.ffn1_w1 = (const float*)d_in[2]; a.ffn1_w3 = (const float*)d_in[3]; a.ffn1_w2 = (const float*)d_in[4];
    a.mix_norm = (const float*)d_in[5]; a.w_in = (const float*)d_in[6]; a.lam_qk = (const float*)d_in[7]; a.da_norm = (const float*)d_in[8]; a.ret_norm = (const float*)d_in[9];
    a.gla_a2 = (const float*)d_in[10]; a.gla_ab = (const float*)d_in[11]; a.gla_norm = (const float*)d_in[12]; a.wb_a = (const float*)d_in[13]; a.wb_b = (const float*)d_in[14];
    a.wb_c = (const float*)d_in[15]; a.w_out = (const float*)d_in[16]; a.ffn2_norm = (const float*)d_in[17]; a.ffn2_w1 = (const float*)d_in[18]; a.ffn2_w3 = (const float*)d_in[19];
    a.ffn2_w2 = (const float*)d_in[20]; a.final_norm = (const float*)d_in[21];
    a.out = (float*)d_out; a.ws = (unsigned char*)d_ws;
#if MK_PER_PHASE
    for (int p = 0; p < N_PHASES; ++p) { a.ph_lo = p; a.ph_hi = p + 1; hipLaunchKernelGGL(mk_fwd, dim3(grid), dim3(512), LDS_BYTES, stream, a); }
#else
    a.ph_lo = 0; a.ph_hi = N_PHASES;
    hipLaunchKernelGGL(mk_fwd, dim3(grid), dim3(512), LDS_BYTES, stream, a);
#endif
}
```

```cpp
#include <hip/hip_runtime.h>
#include <cstdio>
#include <cstdint>

#define GAS __attribute__((address_space(1)))
#define LAS __attribute__((address_space(3)))
typedef unsigned short bf16;
typedef unsigned v4u __attribute__((ext_vector_type(4)));
typedef unsigned v2u __attribute__((ext_vector_type(2)));
typedef float f32x4 __attribute__((ext_vector_type(4)));
typedef float f32x2 __attribute__((ext_vector_type(2)));
typedef short bf16x8 __attribute__((ext_vector_type(8)));

constexpr int BATCH = 4, SEQ = 8192, DMODEL = 1024, DEPTH = 4, M = BATCH * SEQ;
constexpr int NH = 4;
constexpr int DFF = 2752, DFFP = 2816;
constexpr int INC = 7696;
constexpr int PJ = 4864;
constexpr int C_AQ = 0, C_RG = 512, C_CG = 1024, C_AK = 1536, C_AV = 2048, C_RQ = 2560, C_RK = 2816, C_RV = 3072, C_CQ = 3584, C_CK = 3840, C_CV = 4096, C_LA = 4608;
constexpr int C_GATE = 1536;
constexpr int O_AQ = 0, O_AK = 512, O_AV = 1024, O_RQ = 1536, O_RK = 1792, O_RV = 2048, O_RG = 2560, O_CQ = 3072, O_CK = 3328, O_CV = 3584, O_CG = 4096, O_CA = 4608, O_GATE = 4624;
constexpr float EPS = 1e-6f;
constexpr float C2 = 0.125f * 1.4426950408889634f;

constexpr size_t MiB = 1u << 20;
constexpr size_t WS_CTL = 0, CTL_ZERO_BYTES = 64 * 1024;
constexpr size_t WS_LAM = 256 * 1024;
constexpr size_t WS_DEC = 1 * MiB;
constexpr size_t WS_ROPE = 2 * MiB;
constexpr size_t WS_SSQ = 4 * MiB;
constexpr size_t WS_W = 10 * MiB;
constexpr size_t W_13A = WS_W, W_2A = W_13A + 11 * MiB, W_13B = W_2A + 11 * MiB / 2, W_2B = W_13B + 11 * MiB, W_IN = W_2B + 11 * MiB / 2,
                 W_G = W_IN + 19 * MiB / 2, W_B = W_G + 6 * MiB, W_O = W_B + 3 * MiB, W_END = W_O + 2 * MiB;
constexpr size_t WS_HN = 64 * MiB;
constexpr size_t WS_ST = 128 * MiB;
constexpr size_t WS_BIG = 192 * MiB;
constexpr size_t WS_TOT = 496 * MiB;
constexpr size_t WS_DR = 500 * MiB;
constexpr size_t WS_END = 501 * MiB;
static_assert(W_END <= WS_HN, "weight region");

constexpr int RING_BYTES = 131072;
constexpr int MISC_OFF = RING_BYTES + 320;
constexpr int LDS_BYTES = 147456;

__device__ __forceinline__ float bf2f(unsigned h) { return __uint_as_float(h << 16); }
__device__ __forceinline__ float bflo(unsigned w) { return __uint_as_float(w << 16); }
__device__ __forceinline__ float bfhi(unsigned w) { return __uint_as_float(w & 0xffff0000u); }
__device__ __forceinline__ unsigned f2bf(float f) { unsigned u = __float_as_uint(f); return (u + 0x7fffu + ((u >> 16) & 1u)) >> 16; }
__device__ __forceinline__ unsigned pk2(float lo, float hi) { typedef float f2_ __attribute__((ext_vector_type(2))); typedef __bf16 b2_ __attribute__((ext_vector_type(2))); f2_ v = {lo, hi}; b2_ b = __builtin_convertvector(v, b2_); return __builtin_bit_cast(unsigned, b); }
template <int K> __device__ __forceinline__ float xadd(float v) {
    if constexpr (K == 32) { auto rr = __builtin_amdgcn_permlane32_swap(__float_as_uint(v), __float_as_uint(v), false, false); return __uint_as_float(rr[0]) + __uint_as_float(rr[1]); }
    else return v + __int_as_float(__builtin_amdgcn_ds_swizzle(__float_as_int(v), (K << 10) | 0x1f));
}
__device__ __forceinline__ float wave_sum(float v) { v = xadd<1>(v); v = xadd<2>(v); v = xadd<4>(v); v = xadd<8>(v); v = xadd<16>(v); v = xadd<32>(v); return v; }
__device__ __forceinline__ float fast_exp2(float x) { return __builtin_amdgcn_exp2f(x); }
__device__ __forceinline__ float sigmoidf_(float x) { return __builtin_amdgcn_rcpf(1.0f + fast_exp2(-1.4426950408889634f * x)); }
__device__ __forceinline__ float siluf_(float x) { return x * sigmoidf_(x); }
template <class T> __device__ __forceinline__ T* uni(T* p) {
    const unsigned long long v = (unsigned long long)p;
    const unsigned lo = __builtin_amdgcn_readfirstlane((unsigned)v), hi = __builtin_amdgcn_readfirstlane((unsigned)(v >> 32));
    return (T*)(GAS T*)(((unsigned long long)hi << 32) | lo);
}
__device__ __forceinline__ int opaque_tid(int wave) { int z = 0; asm volatile("" : "+v"(z)); const int lane = __builtin_amdgcn_mbcnt_hi(-1, __builtin_amdgcn_mbcnt_lo(-1, z)); return wave * 64 + lane; }
__device__ __forceinline__ unsigned cvtpk2(float lo, float hi) { typedef float f2 __attribute__((ext_vector_type(2))); typedef __bf16 b2 __attribute__((ext_vector_type(2))); f2 v = {lo, hi}; b2 b = __builtin_convertvector(v, b2); return __builtin_bit_cast(unsigned, b); }
__device__ __forceinline__ void glds16(const void* gsrc, unsigned lds_dst) { unsigned keep;
    asm volatile("s_mov_b32 %0, m0\n\ts_mov_b32 m0, %2\n\ts_nop 0\n\tglobal_load_lds_dwordx4 %1, off\n\ts_mov_b32 m0, %0" : "=&s"(keep) : "v"(gsrc), "s"(lds_dst) : "memory"); }
template <int IMM> __device__ __forceinline__ void glds16s(const void* sbase, unsigned voff, unsigned lds_dst) { unsigned keep;
    asm volatile("s_mov_b32 %0, m0\n\ts_mov_b32 m0, %3\n\ts_nop 0\n\tglobal_load_lds_dwordx4 %1, %2 offset:%c4\n\ts_mov_b32 m0, %0" : "=&s"(keep) : "v"(voff), "s"(sbase), "s"(lds_dst), "i"(IMM) : "memory"); }
#define LDS_WAIT() asm volatile("s_waitcnt lgkmcnt(0)" ::: "memory")
#define VM_WAIT() asm volatile("s_waitcnt vmcnt(0)" ::: "memory")

namespace pg8 {
constexpr int BM = 256, BK = 64, HALF = 128, HTB = HALF * BK * 2, NXCD = 8, WGM = 8;
__host__ __device__ __forceinline__ int lds_byte(int r, int c) { const int x = (-(r >> 2)) & 3; return (r >> 3) * 1024 + (c >> 5) * 512 + (r & 7) * 64 + (((((c >> 3) & 3) ^ x)) << 4) + (c & 7) * 2; }
__host__ __device__ __forceinline__ void stage_rc(int b, int& R, int& C) { const int blk = b / 1024, i = (b % 1024) / 16; R = blk * 8 + ((i & 31) >> 2); const int x = (-(R >> 2)) & 3; C = ((i >> 5) * 4 + ((i & 3) ^ x)) * 8 + (b % 16) / 2; }
__host__ __device__ __forceinline__ int perm32(int rho) { const int n = rho >> 4, i = rho & 15; return 8 * (i >> 2) + 4 * n + (i & 3); }

struct Unit { int pm, pn, z; };
struct Gemm { const char* A; const char* B; int lda, ldb, K; size_t zA, zB; };
__device__ __forceinline__ const char* a_base(const Gemm& g, const Unit& u) { return g.A + (size_t)u.pm * 256 * g.lda * 2 + (size_t)u.z * g.zA; }
__device__ __forceinline__ const char* b_base(const Gemm& g, const Unit& u) { return g.B + (size_t)u.pn * 256 * g.ldb * 2 + (size_t)u.z * g.zB; }

template <int NN, int NZ> struct Order {
    static constexpr int nM = M / BM, nN = NN, nwg = nM * nN, nz = NZ;
    int G, c, wave;
    __device__ void init(int G_, int c_, int wave_) { G = G_; c = c_; wave = wave_; }
    __device__ bool next(int i, Unit& u) const {
        const int t = i / NZ; u.z = i - t * NZ;
        const int L = t * G + c; if (L >= nwg) return false;
        static_assert(nwg % NXCD == 0 && nM % WGM == 0, "tile counts");
        int wgid = L; { constexpr int q = nwg / NXCD; const int xcd = wgid % NXCD, off = wgid / NXCD; wgid = xcd * q + off; }
        constexpr int nig = WGM * nN; const int gid = wgid / nig, fm = gid * WGM, w = wgid - gid * nig;
        u.pm = fm + (w % WGM); u.pn = w / WGM; return true;
    }
};

template <class Epi, bool ALIGN_EPI, class Sched>
__device__ __forceinline__ void gemm_phase(LAS unsigned char* lds, const Gemm g, const Sched& S, const Epi& E) {
    const int tid = opaque_tid(S.wave), wid = S.wave, lane = tid & 63, wr = wid >> 2, wc = wid & 3, fr = lane & 15, fq = lane >> 4;
    const int nt = g.K / BK;
    unsigned voffA[2], voffB[2];
#pragma unroll
    for (int i = 0; i < 2; ++i) { int R, C; stage_rc(tid * 16 + i * 8192, R, C); const int Rb = Epi::PERM ? ((R & ~31) + perm32(R & 31)) : R;
        voffA[i] = (unsigned)(R * g.lda + C) * 2u; voffB[i] = (unsigned)(Rb * g.ldb + C) * 2u; }
    const size_t kstep = (size_t)(BK * 2);
    const size_t hstepA = (size_t)HALF * g.lda * 2, hstepB = (size_t)HALF * g.ldb * 2;
    const unsigned ldsw = (unsigned)wid * 1024u; const unsigned ldsb = (unsigned)(size_t)lds;
    const int aoff = lds_byte(wr * 64 + fr, fq * 8), boff = lds_byte(wc * 32 + fr, fq * 8);
#define PG8_SA(b, h) (((b) * 2 + (h)) * HTB)
#define PG8_SB(b, h) ((4 + (b) * 2 + (h)) * HTB)
#define PG8_STAGE(bufoff, gbase, voff) do { _Pragma("unroll") for (int _i = 0; _i < 2; ++_i) \
        glds16s<0>(uni((const char*)(gbase)), (voff)[_i], (unsigned)__builtin_amdgcn_readfirstlane((int)(ldsb + (bufoff) + ldsw + _i * 8192))); } while (0)
#define PG8_LDA(dst, b, h) do { _Pragma("unroll") for (int m = 0; m < 4; ++m) _Pragma("unroll") for (int k = 0; k < 2; ++k) dst[m][k] = *(const LAS bf16x8*)(lds + PG8_SA(b, h) + aoff + m * 2048 + k * 512); } while (0)
#define PG8_LDB(dst, b, h) do { _Pragma("unroll") for (int n = 0; n < 2; ++n) _Pragma("unroll") for (int k = 0; k < 2; ++k) dst[n][k] = *(const LAS bf16x8*)(lds + PG8_SB(b, h) + boff + n * 2048 + k * 512); } while (0)
#define PG8_MMA(ai, bj, At, Bt) do { __builtin_amdgcn_s_setprio(1); _Pragma("unroll") for (int m = 0; m < 4; ++m) _Pragma("unroll") for (int n = 0; n < 2; ++n) _Pragma("unroll") for (int k = 0; k < 2; ++k) \
        acc[ai][bj][m][n] = __builtin_amdgcn_mfma_f32_16x16x32_bf16(Bt[n][k], At[m][k], acc[ai][bj][m][n], 0, 0, 0); __builtin_amdgcn_s_setprio(0); } while (0)
#define PG8_WAIT_V(n) asm volatile("s_waitcnt vmcnt(" #n ")" ::: "memory")
#define PG8_WAIT_VN(n) asm volatile("s_waitcnt vmcnt(%0)" :: "n"(n) : "memory")
#define PG8_WAIT_L(n) asm volatile("s_waitcnt lgkmcnt(" #n ")" ::: "memory")
#define PG8_BAR __builtin_amdgcn_s_barrier()
#define PG8_SCHED __builtin_amdgcn_sched_barrier(0)
    Unit cur, nxt; int ui = 0;
    if (!S.next(0, cur)) return;
    f32x4 acc[2][2][4][2];
    if constexpr (Epi::CINIT) E.cinit(acc, cur, wr, wc, fr, fq);
    else {
#pragma unroll
    for (int a = 0; a < 2; ++a)
#pragma unroll
        for (int b = 0; b < 2; ++b)
#pragma unroll
            for (int m = 0; m < 4; ++m)
#pragma unroll
                for (int n = 0; n < 2; ++n) acc[a][b][m][n] = (f32x4){0.f, 0.f, 0.f, 0.f};
    }
    bf16x8 At[4][2], B0[2][2], B1[2][2];
    LAS float* rsl = (LAS float*)(lds + 132096) + (wid * 16 + fr) * 8;
    int cpm = -1;
    const char* cA = a_base(g, cur); const char* cB = b_base(g, cur);
    PG8_STAGE(PG8_SB(0, 0), cB, voffB); PG8_STAGE(PG8_SB(0, 1), cB + hstepB, voffB); PG8_STAGE(PG8_SA(0, 0), cA, voffA); PG8_STAGE(PG8_SA(0, 1), cA + hstepA, voffA);
    if (wr == 1) PG8_BAR;
    PG8_WAIT_V(2); PG8_BAR;
    PG8_STAGE(PG8_SB(1, 0), cB + kstep, voffB); PG8_STAGE(PG8_SA(1, 0), cA + kstep, voffA); PG8_STAGE(PG8_SB(1, 1), cB + hstepB + kstep, voffB);
    if constexpr (Epi::NST > 0) PG8_STAGE(PG8_SA(1, 1), cA + kstep + hstepA, voffA);
    PG8_WAIT_V(0); PG8_BAR;
    for (;;) {
        const bool has_next = S.next(ui + 1, nxt);
        const char* nA = has_next ? a_base(g, nxt) : cA; const char* nB = has_next ? b_base(g, nxt) : cB;
#define PG8_ITER(t, W123, S1) do { \
            const bool last = ((t) == nt - 2); \
            const char* a1 = cA + (size_t)((t) + 1) * kstep; \
            const char* a2 = last ? nA : cA + (size_t)((t) + 2) * kstep; const char* b2 = last ? nB : cB + (size_t)((t) + 2) * kstep; \
            const char* a3 = a2 + kstep; const char* b3 = b2 + kstep; \
            PG8_LDB(B0, 0, 0); PG8_LDB(B1, 0, 1); PG8_SCHED; PG8_LDA(At, 0, 0); if (S1) PG8_STAGE(PG8_SA(1, 1), a1 + hstepA, voffA); \
            PG8_WAIT_VN(W123); PG8_WAIT_L(0); PG8_BAR; PG8_MMA(0, 0, At, B0); PG8_MMA(0, 1, At, B1); PG8_BAR; PG8_SCHED; \
            PG8_LDA(At, 0, 1); PG8_STAGE(PG8_SB(0, 0), b2, voffB); PG8_STAGE(PG8_SB(0, 1), b2 + hstepB, voffB); PG8_STAGE(PG8_SA(0, 0), a2, voffA); \
            PG8_WAIT_VN(W123); PG8_WAIT_L(0); PG8_BAR; PG8_MMA(1, 0, At, B0); PG8_MMA(1, 1, At, B1); PG8_BAR; PG8_SCHED; \
            PG8_LDB(B0, 1, 0); PG8_LDB(B1, 1, 1); PG8_SCHED; PG8_LDA(At, 1, 0); PG8_STAGE(PG8_SA(0, 1), a2 + hstepA, voffA); \
            PG8_WAIT_VN(W123); PG8_WAIT_L(0); PG8_BAR; PG8_MMA(0, 0, At, B0); PG8_MMA(0, 1, At, B1); PG8_BAR; PG8_SCHED; \
            PG8_LDA(At, 1, 1); PG8_STAGE(PG8_SB(1, 0), b3, voffB); PG8_STAGE(PG8_SB(1, 1), b3 + hstepB, voffB); PG8_STAGE(PG8_SA(1, 0), a3, voffA); \
            PG8_WAIT_V(8); PG8_WAIT_L(0); PG8_BAR; PG8_MMA(1, 0, At, B0); PG8_MMA(1, 1, At, B1); PG8_BAR; PG8_SCHED; \
        } while (0)
        if constexpr (Epi::NST > 0) { PG8_ITER(0, 8 + Epi::NST, false); for (int t = 2; t < nt; t += 2) PG8_ITER(t, 8, true); PG8_STAGE(PG8_SA(1, 1), nA + kstep + hstepA, voffA); }
        else { for (int t = 0; t < nt; t += 2) PG8_ITER(t, 8, true); }
#undef PG8_ITER
        if constexpr (ALIGN_EPI) { if (wr == 0) PG8_BAR; }
        if constexpr (Epi::RSTD) {
            if (cur.pm != cpm) { cpm = cur.pm; E.rs_fill(cur, wr, fr, fq, rsl); }
            float rs[2][4]; { const f32x4 a0 = *(const LAS f32x4*)rsl, a1 = *(const LAS f32x4*)(rsl + 4); rs[0][0] = a0[0]; rs[0][1] = a0[1]; rs[0][2] = a0[2]; rs[0][3] = a0[3]; rs[1][0] = a1[0]; rs[1][1] = a1[1]; rs[1][2] = a1[2]; rs[1][3] = a1[3]; }
            E(acc, cur, wr, wc, fr, fq, rs);
        } else { const int te_ = opaque_tid(S.wave), fre_ = te_ & 15, fqe_ = (te_ >> 4) & 3; float rs[2][4]; E(acc, cur, wr, wc, fre_, fqe_, rs); }
        if (!has_next) break;
        if constexpr (Epi::CINIT) { const int te_ = opaque_tid(S.wave), fre_ = te_ & 15, fqe_ = (te_ >> 4) & 3; E.cinit(acc, nxt, wr, wc, fre_, fqe_); }
        else {
#pragma unroll
        for (int a = 0; a < 2; ++a)
#pragma unroll
            for (int b = 0; b < 2; ++b)
#pragma unroll
                for (int m = 0; m < 4; ++m)
#pragma unroll
                    for (int n = 0; n < 2; ++n) acc[a][b][m][n] = (f32x4){0.f, 0.f, 0.f, 0.f};
        }
        cur = nxt; cA = nA; cB = nB; ++ui;
        if constexpr (ALIGN_EPI) { if (wr == 1) PG8_BAR; }
    }
    PG8_WAIT_V(0);
    if constexpr (!ALIGN_EPI) { if (wr == 0) PG8_BAR; }
    PG8_BAR;
#undef PG8_SA
#undef PG8_SB
#undef PG8_STAGE
#undef PG8_LDA
#undef PG8_LDB
#undef PG8_MMA
#undef PG8_WAIT_V
#undef PG8_WAIT_VN
#undef PG8_WAIT_L
#undef PG8_BAR
#undef PG8_SCHED
}

typedef f32x4 Acc[2][2][4][2];
__device__ __forceinline__ float row_rstd(const float* part, int row, int fq) {
    const f32x4 p = *(const f32x4*)(part + (size_t)row * 16 + 4 * fq);
    float s = (p[0] + p[1]) + (p[2] + p[3]);
    s = xadd<16>(s); s = xadd<32>(s);
    return __builtin_amdgcn_rsqf(s * (1.0f / DMODEL) + EPS);
}
__device__ __forceinline__ v4u pack8(const f32x4 a, const f32x4 b) { v4u w; w.x = pk2(a[0], a[1]); w.y = pk2(a[2], a[3]); w.z = pk2(b[0], b[1]); w.w = pk2(b[2], b[3]); return w; }

__device__ __forceinline__ void rstd_fill(const float* part, int row0, int fq, LAS float* rsl) {
#pragma unroll
    for (int i = 0; i < 8; i += 2) {
        const float r0 = row_rstd(part, row0 + (i >> 2) * HALF + (i & 3) * 16, fq), r1 = row_rstd(part, row0 + ((i + 1) >> 2) * HALF + ((i + 1) & 3) * 16, fq);
        if (fq == 0) { rsl[i] = r0; rsl[i + 1] = r1; }
        asm volatile("" ::: "memory");
    }
    asm volatile("s_waitcnt lgkmcnt(0)" ::: "memory");
}
__device__ __forceinline__ void rows_rstd(const float* part, int row0, int fq, float (&rs)[2][4]) {
#pragma unroll
    for (int ai = 0; ai < 2; ++ai)
#pragma unroll
        for (int m = 0; m < 4; ++m) rs[ai][m] = row_rstd(part, row0 + ai * HALF + m * 16, fq);
}
struct EpiSwiGLU {
    static constexpr bool PERM = true; static constexpr bool CINIT = false; static constexpr int NST = 8;
    bf16* H; const float* ssq;
    static constexpr bool RSTD = true;
    __device__ __forceinline__ void rs_fill(const Unit& u, int wr, int fr, int fq, LAS float* rsl) const { rstd_fill(ssq, u.pm * BM + wr * 64 + fr, fq, rsl); }
    __device__ __forceinline__ void operator()(const Acc& acc, const Unit& u, int wr, int wc, int fr, int fq, const float (&rsv)[2][4]) const {
        const int row0 = u.pm * BM + wr * 64 + fr, col0 = u.pn * 128 + wc * 32 + 8 * fq;
#pragma unroll
        for (int ai = 0; ai < 2; ++ai)
#pragma unroll
            for (int m = 0; m < 4; ++m) {
                const float rs = rsv[ai][m];
                f32x4 v0, v1;
#pragma unroll
                for (int j = 0; j < 4; ++j) { v0[j] = siluf_(acc[ai][0][m][0][j] * rs) * (acc[ai][1][m][0][j] * rs); v1[j] = siluf_(acc[ai][0][m][1][j] * rs) * (acc[ai][1][m][1][j] * rs); }
                *(v4u*)(H + (size_t)(row0 + ai * HALF + m * 16) * DFFP + col0) = pack8(v0, v1);
            }
    }
};
struct EpiResid {
    static constexpr bool PERM = true, RSTD = false, CINIT = true; static constexpr int NST = 0;
    bf16* xb; float scale, iscale; bool dry; float* ssq;
    __device__ __forceinline__ void cinit(Acc& acc, const Unit& u, int wr, int wc, int fr, int fq) const {
        const int row0 = u.pm * BM + wr * 64 + fr, col0 = u.pn * BM + wc * 32 + 8 * fq;
#pragma unroll
        for (int ai = 0; ai < 2; ++ai)
#pragma unroll
            for (int m = 0; m < 4; ++m) { const size_t off = (size_t)(row0 + ai * HALF + m * 16) * DMODEL + col0;
#pragma unroll
                for (int bj = 0; bj < 2; ++bj) { const v4u w = *(const v4u*)(xb + off + bj * HALF);
                    acc[ai][bj][m][0] = (f32x4){bflo(w.x), bfhi(w.x), bflo(w.y), bfhi(w.y)} * iscale; acc[ai][bj][m][1] = (f32x4){bflo(w.z), bfhi(w.z), bflo(w.w), bfhi(w.w)} * iscale; } }
    }
    __device__ __forceinline__ void operator()(const Acc& acc, const Unit& u, int wr, int wc, int fr, int fq, const float (&)[2][4]) const {
        const int row0 = u.pm * BM + wr * 64 + fr, col0 = u.pn * BM + wc * 32 + 8 * fq;
#pragma unroll
        for (int ai = 0; ai < 2; ++ai)
#pragma unroll
            for (int m = 0; m < 4; ++m) { const int row = row0 + ai * HALF + m * 16; const size_t off = (size_t)row * DMODEL + col0; float ss = 0.f;
#pragma unroll
                for (int bj = 0; bj < 2; ++bj) {
                    const f32x4 v0 = acc[ai][bj][m][0] * scale, v1 = acc[ai][bj][m][1] * scale;
                    ss += (v0[0] * v0[0] + v0[1] * v0[1]) + (v0[2] * v0[2] + v0[3] * v0[3]) + (v1[0] * v1[0] + v1[1] * v1[1]) + (v1[2] * v1[2] + v1[3] * v1[3]);
                    if (!dry) *(v4u*)(xb + off + bj * HALF) = pack8(v0, v1); }
                ss = xadd<16>(ss); ss = xadd<32>(ss);
                if (fq == 0 && !dry) ssq[(size_t)row * 16 + u.pn * 4 + wc] = ss; }
    }
};
struct EpiInProj {
    static constexpr bool PERM = true; static constexpr bool CINIT = false; static constexpr int NST = 16;
    bf16* P; const float* rope; const float* la_bias; const float* ssq;
    static constexpr bool RSTD = true;
    __device__ __forceinline__ void rs_fill(const Unit& u, int wr, int fr, int fq, LAS float* rsl) const { rstd_fill(ssq, u.pm * BM + wr * 64 + fr, fq, rsl); }
    __device__ __forceinline__ void operator()(const Acc& acc, const Unit& u, int wr, int wc, int fr, int fq, const float (&rsv)[2][4]) const {
        const int row0 = u.pm * BM + wr * 64 + fr; const int pn = u.pn;
        if (pn == 10 || pn == 11) {
            const float sc = (pn == 11) ? 0.125f : 1.0f;
#pragma unroll
            for (int ai = 0; ai < 2; ++ai)
#pragma unroll
                for (int m = 0; m < 4; ++m) { const int row = row0 + ai * HALF + m * 16; const int pos = row & (SEQ - 1); const float rs = rsv[ai][m] * sc;
                    const f32x4* cs = (const f32x4*)(rope + ((size_t)pos * 32 + 8 * fq) * 2);
                    f32x4 o1[2], o2[2];
#pragma unroll
                    for (int n = 0; n < 2; ++n) { const f32x4 c01 = cs[2 * n], c23 = cs[2 * n + 1];
                        const float co[4] = {c01[0], c01[2], c23[0], c23[2]}, si[4] = {c01[1], c01[3], c23[1], c23[3]};
#pragma unroll
                        for (int j = 0; j < 4; ++j) { const float t1 = acc[ai][0][m][n][j], t2 = acc[ai][1][m][n][j]; o1[n][j] = (t1 * co[j] - t2 * si[j]) * rs; o2[n][j] = (t1 * si[j] + t2 * co[j]) * rs; } }
                    bf16* rowp = P + (size_t)row * PJ + pn * BM + wc * 64 + 8 * fq;
                    *(v4u*)(rowp) = pack8(o1[0], o1[1]); *(v4u*)(rowp + 32) = pack8(o2[0], o2[1]); }
            return;
        }
        const int col0 = pn * BM + wc * 32 + 8 * fq;
        if (pn == 18) {
            f32x4 bv[2][2];
            int bo = wc * 32 + 8 * fq; asm volatile("" : "+v"(bo));
#pragma unroll
            for (int bj = 0; bj < 2; ++bj)
#pragma unroll
                for (int n = 0; n < 2; ++n) bv[bj][n] = *(const f32x4*)(la_bias + bo + bj * HALF + 4 * n);
#pragma unroll
            for (int ai = 0; ai < 2; ++ai)
#pragma unroll
                for (int m = 0; m < 4; ++m) { bf16* rowp = P + (size_t)(row0 + ai * HALF + m * 16) * PJ + col0; const float rs = rsv[ai][m];
#pragma unroll
                    for (int bj = 0; bj < 2; ++bj) { f32x4 v[2];
#pragma unroll
                        for (int n = 0; n < 2; ++n)
#pragma unroll
                            for (int j = 0; j < 4; ++j) { const float x = acc[ai][bj][m][n][j] * rs + bv[bj][n][j]; v[n][j] = (fminf(x, 0.f) - 0.6931471805599453f * __builtin_amdgcn_logf(1.0f + fast_exp2(-1.4426950408889634f * fabsf(x)))) * (1.0f / 16.0f); }
                        *(v4u*)(rowp + bj * HALF) = pack8(v[0], v[1]); } }
            return;
        }
        const bool silu = (pn >= 2 && pn <= 5);
        const float sc = (pn <= 1) ? C2 : (pn == 14 ? 0.125f : 1.0f);
#pragma unroll
        for (int ai = 0; ai < 2; ++ai)
#pragma unroll
            for (int m = 0; m < 4; ++m) { bf16* rowp = P + (size_t)(row0 + ai * HALF + m * 16) * PJ + col0; const float rs = rsv[ai][m] * sc;
#pragma unroll
                for (int bj = 0; bj < 2; ++bj) { f32x4 v0 = acc[ai][bj][m][0] * rs, v1 = acc[ai][bj][m][1] * rs;
                    if (silu) {
#pragma unroll
                        for (int j = 0; j < 4; ++j) { v0[j] = siluf_(v0[j]); v1[j] = siluf_(v1[j]); } }
                    *(v4u*)(rowp + bj * HALF) = pack8(v0, v1); } }
    }
};
struct EpiGates {
    static constexpr bool PERM = true; static constexpr bool CINIT = false; static constexpr int NST = 16;
    bf16* P; const float* ssq;
    static constexpr bool RSTD = true;
    __device__ __forceinline__ void rs_fill(const Unit& u, int wr, int fr, int fq, LAS float* rsl) const { rstd_fill(ssq, u.pm * BM + wr * 64 + fr, fq, rsl); }
    __device__ __forceinline__ void operator()(const Acc& acc, const Unit& u, int wr, int wc, int fr, int fq, const float (&rsv)[2][4]) const {
        const int row0 = u.pm * BM + wr * 64 + fr, col0 = C_GATE + u.pn * BM + wc * 32 + 8 * fq;
#pragma unroll
        for (int ai = 0; ai < 2; ++ai)
#pragma unroll
            for (int m = 0; m < 4; ++m) { bf16* rowp = P + (size_t)(row0 + ai * HALF + m * 16) * PJ + col0; const float rs = rsv[ai][m];
#pragma unroll
                for (int bj = 0; bj < 2; ++bj) { f32x4 v0, v1;
#pragma unroll
                    for (int j = 0; j < 4; ++j) { v0[j] = sigmoidf_(acc[ai][bj][m][0][j] * rs); v1[j] = sigmoidf_(acc[ai][bj][m][1][j] * rs); }
                    *(v4u*)(rowp + bj * HALF) = pack8(v0, v1); } }
    }
};
struct EpiMerge {
    static constexpr bool PERM = true; static constexpr bool CINIT = true; static constexpr int NST = 0;
    const bf16* P; bf16* O;
    static constexpr bool RSTD = false;
    template <bool INV> __device__ __forceinline__ void scale(Acc& acc, const Unit& u, int wr, int wc, int fr, int fq) const {
        const int row0 = u.pm * BM + wr * 64 + fr, gcol0 = C_GATE + u.z * DMODEL + u.pn * BM + wc * 32 + 8 * fq;
#pragma unroll
        for (int ai = 0; ai < 2; ++ai) {
            v4u gw[4][2];
#pragma unroll
            for (int m = 0; m < 4; ++m)
#pragma unroll
                for (int bj = 0; bj < 2; ++bj) gw[m][bj] = *(const v4u*)(P + (size_t)(row0 + ai * HALF + m * 16) * PJ + gcol0 + bj * HALF);
#pragma unroll
            for (int m = 0; m < 4; ++m)
#pragma unroll
                for (int bj = 0; bj < 2; ++bj) { const v4u g = gw[m][bj];
                    float gf[8] = {bflo(g.x), bfhi(g.x), bflo(g.y), bfhi(g.y), bflo(g.z), bfhi(g.z), bflo(g.w), bfhi(g.w)};
                    if constexpr (INV) {
#pragma unroll
                        for (int j = 0; j < 8; ++j) gf[j] = __builtin_amdgcn_rcpf(fmaxf(gf[j], 1e-30f)); }
#pragma unroll
                    for (int j = 0; j < 4; ++j) { acc[ai][bj][m][0][j] *= gf[j]; acc[ai][bj][m][1][j] *= gf[4 + j]; } }
            __builtin_amdgcn_sched_barrier(0);
        }
    }
    __device__ __forceinline__ void cinit(Acc& acc, const Unit& u, int wr, int wc, int fr, int fq) const {
        if (u.z == 0) {
#pragma unroll
            for (int a = 0; a < 2; ++a)
#pragma unroll
                for (int b = 0; b < 2; ++b)
#pragma unroll
                    for (int m = 0; m < 4; ++m)
#pragma unroll
                        for (int n = 0; n < 2; ++n) acc[a][b][m][n] = (f32x4){0.f, 0.f, 0.f, 0.f};
        } else scale<true>(acc, u, wr, wc, fr, fq);
    }
    __device__ __forceinline__ void operator()(Acc& acc, const Unit& u, int wr, int wc, int fr, int fq, const float (&)[2][4]) const {
        scale<false>(acc, u, wr, wc, fr, fq);
        if (u.z < 2) return;
        const int row0 = u.pm * BM + wr * 64 + fr, col0 = u.pn * BM + wc * 32 + 8 * fq;
#pragma unroll
        for (int ai = 0; ai < 2; ++ai)
#pragma unroll
            for (int m = 0; m < 4; ++m)
#pragma unroll
                for (int bj = 0; bj < 2; ++bj) *(v4u*)(O + (size_t)(row0 + ai * HALF + m * 16) * DMODEL + col0 + bj * HALF) = pack8(acc[ai][bj][m][0], acc[ai][bj][m][1]);
    }
};
}

#define XB_TMO      128
#define XB_XCNT(j)  (256  + 64 * (j))
#define XB_XSUB(j)  (1280 + 64 * (j))
#define XB_XGEN(j)  (2304 + 64 * (j))
#define XB_TOP      3328
#define XB_TOPGEN   3392
#define XCD_BAR_WORDS 3456
#define XB_SPIN_CAP (1u << 23)
__device__ __forceinline__ unsigned xb_ld(unsigned* p)              { return __hip_atomic_load(p, __ATOMIC_RELAXED, __HIP_MEMORY_SCOPE_AGENT); }
__device__ __forceinline__ unsigned xb_add(unsigned* p, unsigned v) { return __hip_atomic_fetch_add(p, v, __ATOMIC_RELAXED, __HIP_MEMORY_SCOPE_AGENT); }
__device__ __forceinline__ unsigned xb_xcc_id() { return (unsigned)__builtin_amdgcn_s_getreg((3 << 11) | 20) & 0xFu; }
#define XB_SPIN(cond, bar) do { unsigned _sp = 0; while (cond) { __builtin_amdgcn_s_sleep(1); \
    if ((++_sp & 255u) == 0u) { if (xb_ld(&(bar)[XB_TMO])) break; if (_sp > XB_SPIN_CAP) { atomicAdd(&(bar)[XB_TMO], 1u); break; } } } } while (0)
struct XcdBarrier { unsigned* bar; unsigned x; volatile LAS unsigned* st; };
__device__ __forceinline__ XcdBarrier xcd_barrier_post(unsigned* bar, volatile LAS unsigned* st) {
    XcdBarrier b; b.bar = bar; b.x = xb_xcc_id(); b.st = st;
    if (threadIdx.x == 0) (void)xb_add(&bar[XB_XCNT(b.x)], 1u);
    return b;
}
__device__ __forceinline__ void xcd_barrier_complete(unsigned* bar, unsigned x, unsigned& nloc, unsigned& nx) {
    const unsigned G = gridDim.x * gridDim.y * gridDim.z;
    unsigned sum, cnt, mine, sp = 0u;
    for (;;) {
        sum = 0u; cnt = 0u; mine = 0u;
#pragma unroll
        for (unsigned j = 0; j < 16; ++j) { const unsigned c = xb_ld(&bar[XB_XCNT(j)]); sum += c; cnt += (c > 0u) ? 1u : 0u; mine = (j == x) ? c : mine; }
        if (sum == G) break;
        __builtin_amdgcn_s_sleep(1);
        if ((++sp & 255u) == 0u) { if (xb_ld(&bar[XB_TMO])) break; if (sp > XB_SPIN_CAP) { atomicAdd(&bar[XB_TMO], 1u); break; } }
    }
    nloc = mine > 0u ? mine : 1u; nx = cnt > 0u ? cnt : 1u;
}
__device__ __forceinline__ void xcd_barrier(const XcdBarrier& b) {
    asm volatile("s_waitcnt vmcnt(0)" ::: "memory");
    __syncthreads();
    if (threadIdx.x == 0) {
        unsigned* bar = b.bar;
        __builtin_amdgcn_s_waitcnt(0);
        unsigned nloc = b.st[0], nx = b.st[1];
        if (nloc == 0u) { xcd_barrier_complete(bar, b.x, nloc, nx); b.st[0] = nloc; b.st[1] = nx; }
        const unsigned old = xb_add(&bar[XB_XSUB(b.x)], 1u);
        const unsigned gen = old / nloc;
        if (old + 1u == (gen + 1u) * nloc) {
            __builtin_amdgcn_fence(__ATOMIC_RELEASE, "agent");
            asm volatile("s_waitcnt vmcnt(0)" ::: "memory");
            const unsigned og = xb_add(&bar[XB_TOP], 1u);
            const unsigned tg = og / nx;
            if (og + 1u == (tg + 1u) * nx) xb_add(&bar[XB_TOPGEN], 1u);
            else XB_SPIN(xb_ld(&bar[XB_TOPGEN]) == tg, bar);
            __builtin_amdgcn_fence(__ATOMIC_ACQUIRE, "agent");
            xb_add(&bar[XB_XGEN(b.x)], 1u);
            asm volatile("s_waitcnt vmcnt(0)" ::: "memory");
        } else {
            XB_SPIN(xb_ld(&bar[XB_XGEN(b.x)]) == gen, bar);
            __builtin_amdgcn_fence(__ATOMIC_ACQUIRE, "agent");
            asm volatile("s_waitcnt vmcnt(0)" ::: "memory");
        }
    }
    __syncthreads();
}

struct Args {
    const float* x; const float* ffn1_norm; const float* ffn1_w1; const float* ffn1_w3; const float* ffn1_w2; const float* mix_norm; const float* w_in; const float* lam_qk;
    const float* da_norm; const float* ret_norm; const float* gla_a2; const float* gla_ab; const float* gla_norm; const float* wb_a; const float* wb_b; const float* wb_c; const float* w_out;
    const float* ffn2_norm; const float* ffn2_w1; const float* ffn2_w3; const float* ffn2_w2; const float* final_norm;
    float* out; unsigned char* ws; int ph_lo, ph_hi;
};
struct Frame { LAS unsigned char* lds; unsigned char* ws; int vcu, G, wave; };

__device__ __constant__ float LAM_INIT[4] = {0.2f, 0.35550906759f, 0.47071301834f, 0.55605820416f};

__device__ __forceinline__ void conv_tr(const float* src, int ldsrc, bf16* dst, int lddst, LAS float* scr, int lane, bool zero, const float* gain = nullptr) {
    if (zero) {
        const int c = lane & 7;
#pragma unroll
        for (int j = 0; j < 4; ++j) { const int n = (lane >> 3) + 8 * j; *(v4u*)(dst + (size_t)n * lddst + 8 * c) = (v4u){0u, 0u, 0u, 0u}; }
        return;
    }
    const int n4 = lane & 7, kg = lane >> 3;
    f32x4 tv[8];
#pragma unroll
    for (int j = 0; j < 8; ++j) tv[j] = *(const f32x4*)(src + (size_t)(8 * kg + j) * ldsrc + 4 * n4);
    if (gain) { const f32x4 g0 = *(const f32x4*)(gain + 8 * kg), g1 = *(const f32x4*)(gain + 8 * kg + 4);
#pragma unroll
        for (int j = 0; j < 4; ++j) { tv[j] = tv[j] * g0[j]; tv[4 + j] = tv[4 + j] * g1[j]; } }
#pragma unroll
    for (int i = 0; i < 4; ++i) { v4u o; o.x = pk2(tv[0][i], tv[1][i]); o.y = pk2(tv[2][i], tv[3][i]); o.z = pk2(tv[4][i], tv[5][i]); o.w = pk2(tv[6][i], tv[7][i]);
        *(v4u*)(dst + (size_t)(4 * n4 + i) * lddst + 8 * kg) = o; }
    (void)scr;
}
__device__ __forceinline__ int inproj_src_col(int g) {
    const int c = 32 * g;
    if (c < 512) return O_AQ + c;
    if (c < 1024) return O_RG + (c - 512);
    if (c < 1536) return O_CG + (c - 1024);
    if (c < 2048) return O_AK + (c - 1536);
    if (c < 2560) return O_AV + (c - 2048);
    if (c < 3072) { const int base = (c < 2816) ? O_RQ : O_RK; const int cc = (c < 2816) ? c - 2560 : c - 2816; const int half = cc >> 7, head = (cc & 127) >> 5; return base + head * 64 + 32 * half; }
    if (c < 3584) return O_RV + (c - 3072);
    if (c < 3840) return O_CQ + (c - 3584);
    if (c < 4096) return O_CK + (c - 3840);
    return O_CV + (c - 4096);
}
constexpr int I_W13 = 16 * 176, I_W2 = 44 * 32, I_WIN = 16 * 144, I_WG = 16 * 96, I_WB = 8 * 32, I_WO = 16 * 32, I_LA = 16 * 8;
constexpr int I_TOTAL = 2 * (I_W13 + I_W2) + I_WIN + I_WG + 3 * I_WB + I_WO + I_LA;

__device__ __forceinline__ void conv_w13(const float* w1, const float* w3, bf16* dst, int r, LAS float* scr, int lane, const float* gain) {
    const int kb = r / 176, g = r % 176, pn = g >> 3, half = (g >> 2) & 1, jj = g & 3, hc0 = pn * 128 + jj * 32;
    const float* src = (half ? w3 : w1) + (size_t)(64 * kb) * DFF + hc0;
    conv_tr(src, DFF, dst + (size_t)(32 * g) * DMODEL + 64 * kb, DMODEL, scr, lane, hc0 >= DFF, gain + 64 * kb);
}
__device__ __forceinline__ void conv_w2(const float* w2, bf16* dst, int r, LAS float* scr, int lane) {
    const int kb = r / 32, nb = r % 32;
    conv_tr(w2 + (size_t)(64 * kb) * DMODEL + 32 * nb, DMODEL, dst + (size_t)(32 * nb) * DFFP + 64 * kb, DFFP, scr, lane, kb >= 43);
}

struct ConvJob { const float* src; const float* gain; bf16* dst; int ldsrc, lddst, kind; };
__device__ __forceinline__ ConvJob conv_job(const Args& a, unsigned char* wd, int l, int it) {
    ConvJob j; j.src = nullptr; j.gain = nullptr; j.dst = nullptr; j.ldsrc = 0; j.lddst = 0; j.kind = 0;
    if (it < 0 || it >= I_TOTAL - I_LA) return j;
    const float* win = uni(a.w_in) + (size_t)l * DMODEL * INC;
    const float* gm = uni(a.mix_norm) + l * DMODEL;
    int r = it;
    if (r < I_W13 || (r >= I_W13 + I_W2 && r < 2 * I_W13 + I_W2)) { const bool second = r >= I_W13; if (second) r -= I_W13 + I_W2;
        const int kb = r / 176, g = r % 176, pn = g >> 3, half = (g >> 2) & 1, jj = g & 3, hc0 = pn * 128 + jj * 32;
        const float* w1 = uni(second ? a.ffn2_w1 : a.ffn1_w1) + (size_t)l * DMODEL * DFF; const float* w3 = uni(second ? a.ffn2_w3 : a.ffn1_w3) + (size_t)l * DMODEL * DFF;
        j.src = (half ? w3 : w1) + (size_t)(64 * kb) * DFF + hc0; j.ldsrc = DFF; j.dst = (bf16*)(wd + (second ? W_13B : W_13A)) + (size_t)(32 * g) * DMODEL + 64 * kb; j.lddst = DMODEL;
        j.gain = uni(second ? a.ffn2_norm : a.ffn1_norm) + l * DMODEL + 64 * kb; j.kind = (hc0 >= DFF) ? 2 : 1; return j; }
    r -= I_W13;
    if (r < I_W2 || (r >= I_W2 + I_W13 && r < 2 * I_W2 + I_W13)) { const bool second = r >= I_W2; if (second) r -= I_W2 + I_W13;
        const int kb = r / 32, nb = r % 32; const float* w2 = uni(second ? a.ffn2_w2 : a.ffn1_w2) + (size_t)l * DFF * DMODEL;
        j.src = w2 + (size_t)(64 * kb) * DMODEL + 32 * nb; j.ldsrc = DMODEL; j.dst = (bf16*)(wd + (second ? W_2B : W_2A)) + (size_t)(32 * nb) * DFFP + 64 * kb; j.lddst = DFFP; j.kind = (kb >= 43) ? 2 : 1; return j; }
    r -= I_W2 + I_W13 + I_W2;
    if (r < I_WIN) { const int kb = r / 144, g = r % 144;
        j.src = win + (size_t)(64 * kb) * INC + inproj_src_col(g); j.ldsrc = INC; j.dst = (bf16*)(wd + W_IN) + (size_t)(32 * g) * DMODEL + 64 * kb; j.lddst = DMODEL; j.gain = gm + 64 * kb; j.kind = 1; return j; }
    r -= I_WIN;
    if (r < I_WG) { const int kb = r / 96, g = r % 96;
        j.src = win + (size_t)(64 * kb) * INC + O_GATE + 32 * g; j.ldsrc = INC; j.dst = (bf16*)(wd + W_G) + (size_t)(32 * g) * DMODEL + 64 * kb; j.lddst = DMODEL; j.gain = gm + 64 * kb; j.kind = 1; return j; }
    r -= I_WG;
    if (r < 3 * I_WB) { const int z = r / I_WB, rr = r % I_WB, kb = rr / 32, nb = rr % 32;
        const float* wb = uni(z == 0 ? a.wb_a : (z == 1 ? a.wb_b : a.wb_c)) + (size_t)l * 512 * DMODEL;
        j.src = wb + (size_t)(64 * kb) * DMODEL + 32 * nb; j.ldsrc = DMODEL; j.dst = (bf16*)(wd + W_B) + (size_t)z * DMODEL * 512 + (size_t)(32 * nb) * 512 + 64 * kb; j.lddst = 512; j.kind = 1; return j; }
    r -= 3 * I_WB;
    { const int kb = r / 32, nb = r % 32;
      j.src = uni(a.w_out) + (size_t)l * DMODEL * DMODEL + (size_t)(64 * kb) * DMODEL + 32 * nb; j.ldsrc = DMODEL; j.dst = (bf16*)(wd + W_O) + (size_t)(32 * nb) * DMODEL + 64 * kb; j.lddst = DMODEL; j.kind = 1; }
    return j;
}
__device__ __forceinline__ void conv_load(const ConvJob& j, int lane, f32x4 (&tv)[8]) {
    if (j.kind == 1) { const int n4 = lane & 7, kg = lane >> 3;
#pragma unroll
        for (int q = 0; q < 8; ++q) tv[q] = *(const f32x4*)(j.src + (size_t)(8 * kg + q) * j.ldsrc + 4 * n4); }
}
__device__ __forceinline__ void conv_store(const ConvJob& j, int lane, f32x4 (&tv)[8]) {
    if (j.kind == 0) return;
    const int n4 = lane & 7, kg = lane >> 3;
    if (j.kind == 2) {
#pragma unroll
        for (int i = 0; i < 4; ++i) *(v4u*)(j.dst + (size_t)(4 * n4 + i) * j.lddst + 8 * kg) = (v4u){0u, 0u, 0u, 0u};
        return; }
    if (j.gain) { const f32x4 g0 = *(const f32x4*)(j.gain + 8 * kg), g1 = *(const f32x4*)(j.gain + 8 * kg + 4);
#pragma unroll
        for (int q = 0; q < 4; ++q) { tv[q] = tv[q] * g0[q]; tv[4 + q] = tv[4 + q] * g1[q]; } }
#pragma unroll
    for (int i = 0; i < 4; ++i) { v4u o; o.x = pk2(tv[0][i], tv[1][i]); o.y = pk2(tv[2][i], tv[3][i]); o.z = pk2(tv[4][i], tv[5][i]); o.w = pk2(tv[6][i], tv[7][i]);
        *(v4u*)(j.dst + (size_t)(4 * n4 + i) * j.lddst + 8 * kg) = o; }
}
__device__ __forceinline__ void conv_item(const Args& a, unsigned char* wd, int l, int it, int lane) {
    const ConvJob j = conv_job(a, wd, l, it); f32x4 tv[8]; conv_load(j, lane, tv); conv_store(j, lane, tv);
}
__device__ __forceinline__ void conv_la_item(const Args& a, unsigned char* wd, int l, int r, int lane) {
    const float* win = uni(a.w_in) + (size_t)l * DMODEL * INC;
    const float* gm = uni(a.mix_norm) + l * DMODEL;
    const int kb = r / 8, cb = r % 8, c8 = lane & 7; const float* a2 = uni(a.gla_a2) + (size_t)l * 16 * 256;
    const float* wrow = win + (size_t)(64 * kb + 8 * c8) * INC + O_CA;
#pragma unroll 1
    for (int j = 0; j < 4; ++j) { const int c = 32 * cb + (lane >> 3) + 8 * j;
        float av[16];
#pragma unroll
        for (int t = 0; t < 16; ++t) av[t] = a2[t * 256 + c];
        float o[8];
#pragma unroll
        for (int q = 0; q < 8; ++q) {
            float acc = 0.f;
#pragma unroll
            for (int t4 = 0; t4 < 4; ++t4) { const f32x4 w4 = *(const f32x4*)(wrow + (size_t)q * INC + 4 * t4);
                acc += (w4[0] * av[4 * t4] + w4[1] * av[4 * t4 + 1]) + (w4[2] * av[4 * t4 + 2] + w4[3] * av[4 * t4 + 3]); }
            o[q] = acc * gm[64 * kb + 8 * c8 + q]; }
        v4u w; w.x = pk2(o[0], o[1]); w.y = pk2(o[2], o[3]); w.z = pk2(o[4], o[5]); w.w = pk2(o[6], o[7]);
        *(v4u*)((bf16*)(wd + W_IN) + (size_t)(C_LA + c) * DMODEL + 64 * kb + 8 * c8) = w; }
}
__device__ __forceinline__ void conv_lam(const Args& a, unsigned char* ws, int l, int lane) {
    const float* lq = uni(a.lam_qk) + (size_t)l * 256;
    const float s1 = wave_sum(lq[lane] * lq[64 + lane]), s2 = wave_sum(lq[128 + lane] * lq[192 + lane]);
    if (lane == 0) ((float*)(ws + WS_LAM))[l] = __expf(s1) - __expf(s2) + LAM_INIT[l];
}
__device__ __forceinline__ void phase_conv(const Args& a, const Frame& F, int l, unsigned char* wd) {
    const int tid = opaque_tid(F.wave), lane = tid & 63, wave = F.wave;
    const int gw = F.vcu * 8 + wave, NGW = F.G * 8;
    for (int it = gw; it < I_TOTAL - I_LA; it += NGW) conv_item(a, wd, l, it, lane);
    for (int r = gw; r < I_LA; r += NGW) conv_la_item(a, wd, l, r, lane);
    if (gw == 0) conv_lam(a, F.ws, l, lane);
}

__device__ __forceinline__ void phase_rope(const Frame& F) {
    const int tid = opaque_tid(F.wave);
    float* rt = (float*)(F.ws + WS_ROPE);
    for (int idx = F.vcu * 512 + tid; idx < SEQ * 32; idx += F.G * 512) {
        const int pos = idx >> 5, i = idx & 31;
        const float inv = exp2f(-(float)i * (13.287712379549449f / 32.0f));
        const float ang = (float)pos * inv;
        double rev = (double)ang * 0.15915494309189535; rev -= floor(rev);
        const float rf = (float)rev;
        rt[2 * idx] = __builtin_amdgcn_cosf(rf); rt[2 * idx + 1] = __builtin_amdgcn_sinf(rf);
    }
}
__device__ __forceinline__ void phase_prep(const Frame& F, const float* x, bf16* xb, float* ssq) {
    const int tid = opaque_tid(F.wave), lane = tid & 63, wave = F.wave;
    const int gw = F.vcu * 8 + wave, NGW = F.G * 8;
    for (int m = gw; m < M; m += NGW) {
        const f32x4* xr = (const f32x4*)(x + (size_t)m * DMODEL) + lane;
        f32x4 v[4]; float s = 0.f;
#pragma unroll
        for (int j = 0; j < 4; ++j) { v[j] = xr[64 * j]; s += (v[j][0] * v[j][0] + v[j][1] * v[j][1]) + (v[j][2] * v[j][2] + v[j][3] * v[j][3]); }
        s = wave_sum(s);
        v2u* o8 = (v2u*)(xb + (size_t)m * DMODEL) + lane;
#pragma unroll
        for (int j = 0; j < 4; ++j) { v2u w; w.x = pk2(v[j][0], v[j][1]); w.y = pk2(v[j][2], v[j][3]); o8[64 * j] = w; }
        if (lane < 16) ssq[(size_t)m * 16 + lane] = (lane == 0) ? s : 0.f;
    }
}
__device__ __forceinline__ void phase_final_norm(const Frame& F, const bf16* xb, float* out, const float* gain, const float* ssq) {
    const int tid = opaque_tid(F.wave), lane = tid & 63, wave = F.wave;
    const int gw = F.vcu * 8 + wave, NGW = F.G * 8;
    f32x4 g[4];
#pragma unroll
    for (int j = 0; j < 4; ++j) g[j] = *((const f32x4*)gain + lane + 64 * j);
    for (int m = gw; m < M; m += NGW) {
        const v2u* xr = (const v2u*)(xb + (size_t)m * DMODEL) + lane; f32x4* orow = (f32x4*)(out + (size_t)m * DMODEL) + lane;
        float sq = ssq[(size_t)m * 16 + (lane & 15)];
        sq = xadd<1>(sq); sq = xadd<2>(sq); sq = xadd<4>(sq); sq = xadd<8>(sq);
        const float rstd = __builtin_amdgcn_rsqf(sq * (1.0f / DMODEL) + EPS);
#pragma unroll
        for (int j = 0; j < 4; ++j) { const v2u w = xr[64 * j]; orow[64 * j] = (f32x4){bflo(w.x), bfhi(w.x), bflo(w.y), bfhi(w.y)} * rstd * g[j]; }
    }
}

__device__ __forceinline__ float ret_logg(int h) { return h == 0 ? -0.031748698314580301f : (h == 1 ? -0.015748356968139168f : (h == 2 ? -0.0078431774610258928f : -0.0039138993211363287f)); }

__device__ __forceinline__ void chunk_cum(LAS float* cum, LAS float* tot, const bf16* prow, int mix, int h, int tid) {
    const int d = tid & 63, seg = tid >> 6;
    if (mix == 0) {
        const float lg = ret_logg(h);
#pragma unroll
        for (int x = 0; x < 8; ++x) { const int t = seg * 8 + x; cum[t * 64 + d] = (float)(t + 1) * lg; }
        __syncthreads(); __syncthreads();
        return;
    }
    float run = 0.f;
#pragma unroll
    for (int x = 0; x < 8; ++x) { const int t = seg * 8 + x; run += bf2f(prow[(size_t)t * PJ + C_LA + h * 64 + d]); cum[t * 64 + d] = run; }
    tot[seg * 64 + d] = run;
    __syncthreads();
    float off = 0.f;
    for (int s = 0; s < seg; ++s) off += tot[s * 64 + d];
#pragma unroll
    for (int x = 0; x < 8; ++x) { const int t = seg * 8 + x; cum[t * 64 + d] += off; }
    __syncthreads();
}

__device__ __forceinline__ void phase_r2(const Args& a, const Frame& F) {
    unsigned char* ws = F.ws; unsigned* ST = (unsigned*)(ws + WS_ST); const float* DEC = (const float*)(ws + WS_DEC);
    const int tid = opaque_tid(F.wave);
    for (int gt = F.vcu * 512 + tid; gt < 32 * 4096; gt += F.G * 512) {
        const int w = gt & 4095, seq = gt >> 12, mix = seq >> 4, bh = seq & 15, h = bh & 3, d0 = (2 * w) & 63;
        unsigned* p = ST + (size_t)seq * 128 * 4096 + w;
        const float* dp = DEC + (size_t)bh * 128 * 64 + d0;
        float s0 = 0.f, s1 = 0.f;
        const float cret = __expf(64.0f * ret_logg(h));
        unsigned ua[8], ub[8]; f32x2 da[8], db[8];
#define R2_LOAD(uu, dd, n0_) do { _Pragma("unroll") for (int i = 0; i < 8; ++i) { uu[i] = p[(size_t)((n0_) + i) * 4096]; dd[i] = mix ? *(const f32x2*)(dp + (size_t)((n0_) + i) * 64) : (f32x2){cret, cret}; } } while (0)
#define R2_SCAN(uu, dd, n0_) do { _Pragma("unroll") for (int i = 0; i < 8; ++i) { p[(size_t)((n0_) + i) * 4096] = pk2(s0, s1); s0 = s0 * dd[i][0] + bflo(uu[i]); s1 = s1 * dd[i][1] + bfhi(uu[i]); } } while (0)
        R2_LOAD(ua, da, 0);
        for (int n0 = 0; n0 < 128; n0 += 16) {
            R2_LOAD(ub, db, n0 + 8);
            R2_SCAN(ua, da, n0);
            if (n0 + 16 < 128) R2_LOAD(ua, da, n0 + 16);
            R2_SCAN(ub, db, n0 + 8);
        }
#undef R2_LOAD
#undef R2_SCAN
    }
}

namespace lin {
typedef float f32x16 __attribute__((ext_vector_type(16)));
typedef short v4i16_t __attribute__((ext_vector_type(4)));
constexpr int L_V = 0, L_S = 16384, L_QE = 32768, L_KE = 40960, L_KD = 40960, L_CUM = 49152, L_TOT = 65536, L_OB = 67584, OB_LD = 132, L_SIN = 101376, L_QE2 = 117760;
__device__ __forceinline__ int crow(int r, int hi) { return (r & 3) + 8 * (r >> 2) + 4 * hi; }
__device__ __forceinline__ bf16x8 trfrag(const LAS unsigned char* p) {
    const v4i16_t lo = __builtin_amdgcn_ds_read_tr16_b64_v4i16((LAS v4i16_t*)(p)), hh = __builtin_amdgcn_ds_read_tr16_b64_v4i16((LAS v4i16_t*)(p + 512));
    return (bf16x8){lo[0], lo[1], lo[2], lo[3], hh[0], hh[1], hh[2], hh[3]};
}
__device__ __forceinline__ void unpack8(const v4u w, float (&f)[8]) { f[0] = bflo(w.x); f[1] = bfhi(w.x); f[2] = bflo(w.y); f[3] = bfhi(w.y); f[4] = bflo(w.z); f[5] = bfhi(w.z); f[6] = bflo(w.w); f[7] = bfhi(w.w); }
__device__ __forceinline__ v4u pack8f(const float (&f)[8]) { v4u w; w.x = pk2(f[0], f[1]); w.y = pk2(f[2], f[3]); w.z = pk2(f[4], f[5]); w.w = pk2(f[6], f[7]); return w; }
__device__ __forceinline__ void dma_v(LAS unsigned char* lds, const bf16* vbase, int wid, int lane) {
    const bf16* vsrc = vbase + (size_t)(16 * (wid & 3) + (lane >> 2)) * PJ + (wid >> 2) * 32 + (lane & 3) * 8;
    __builtin_amdgcn_global_load_lds((const unsigned*)(vsrc), (LAS unsigned*)(lds + L_V + wid * 1024), 16, 0, 0);
    __builtin_amdgcn_global_load_lds((const unsigned*)(vsrc + 64), (LAS unsigned*)(lds + L_V + wid * 1024 + 8192), 16, 0, 0);
}
}

struct RFetch { v4u qw, kw, g0, g1; f32x4 pn0, pn1; unsigned short la[8]; };
__device__ __forceinline__ void chunk_cum_regs(LAS float* cum, LAS float* tot, const unsigned short (&la)[8], int mix, int h, int tid) {
    const int d = tid & 63, seg = tid >> 6;
    if (mix == 0) {
        const float lg = ret_logg(h);
#pragma unroll
        for (int x = 0; x < 8; ++x) { const int t = seg * 8 + x; cum[t * 64 + d] = (float)(t + 1) * lg; }
        __syncthreads(); __syncthreads();
        return;
    }
    float run = 0.f;
#pragma unroll
    for (int x = 0; x < 8; ++x) { const int t = seg * 8 + x; run += bf2f(la[x]); cum[t * 64 + d] = run; }
    tot[seg * 64 + d] = run;
    __syncthreads();
    float off = 0.f;
    for (int s = 0; s < seg; ++s) off += tot[s * 64 + d];
#pragma unroll
    for (int x = 0; x < 8; ++x) { const int t = seg * 8 + x; cum[t * 64 + d] += off; }
    __syncthreads();
}

__device__ __forceinline__ void phase_r1_mfma(const Args& a, const Frame& F) {
    using namespace lin;
    unsigned char* ws = F.ws; const bf16* proj = (const bf16*)(ws + WS_BIG); bf16* ST = (bf16*)(ws + WS_ST); float* DEC = (float*)(ws + WS_DEC);
    bf16* TOT = (bf16*)(ws + WS_TOT); float* DR = (float*)(ws + WS_DR);
    const int tid = opaque_tid(F.wave), lane = tid & 63, wid = F.wave, r32 = lane & 31, hi = lane >> 5;
    LAS unsigned char* lds = F.lds; LAS float* cum = (LAS float*)(lds + L_CUM); LAS float* tot = (LAS float*)(lds + L_TOT);
    const int t = tid >> 3, c = tid & 7;
    const int eb = wid >> 1, db = wid & 1, dcol = 32 * db + r32;
#define R1_FETCH(u_, f_) do { const int mix_ = (u_) >> 11, bh_ = ((u_) >> 7) & 15, n_ = (u_) & 127, h_ = bh_ & 3; \
        const bf16* prow_ = proj + (size_t)((bh_ >> 2) * SEQ + n_ * 64) * PJ; \
        f_.kw = *(const v4u*)(prow_ + (size_t)t * PJ + (mix_ ? C_CK : C_RK) + h_ * 64 + 8 * c); \
        if (mix_) { _Pragma("unroll") for (int x = 0; x < 8; ++x) f_.la[x] = prow_[(size_t)((tid >> 6) * 8 + x) * PJ + C_LA + h_ * 64 + (tid & 63)]; } \
        dma_v(lds, prow_ + (mix_ ? C_CV : C_RV) + h_ * 128, wid, lane); } while (0)
    RFetch cur; cur.qw = cur.g0 = cur.g1 = (v4u){0u, 0u, 0u, 0u};
    int v = F.vcu;
    if (v < 256) R1_FETCH(v * 16, cur);
    for (; v < 256; v += F.G) {
        const int sq = v >> 3, run = v & 7, mix = sq >> 4, bh = sq & 15, h = bh & 3;
        const float cret = __expf(64.0f * ret_logg(h));
        f32x16 state; float pst = 1.0f;
#pragma unroll
        for (int r = 0; r < 16; ++r) state[r] = 0.f;
#pragma unroll 1
        for (int i = 0; i < 16; ++i) {
            const int u = v * 16 + i, n = run * 16 + i;
            chunk_cum_regs(cum, tot, cur.la, mix, h, tid);
            float kf[8]; unpack8(cur.kw, kf);
            { const f32x4 c0 = *(const LAS f32x4*)(cum + t * 64 + 8 * c), c1 = *(const LAS f32x4*)(cum + t * 64 + 8 * c + 4);
              const f32x4 l0 = *(const LAS f32x4*)(cum + 63 * 64 + 8 * c), l1 = *(const LAS f32x4*)(cum + 63 * 64 + 8 * c + 4);
#pragma unroll
              for (int j = 0; j < 4; ++j) { kf[j] *= __expf(l0[j] - c0[j]); kf[4 + j] *= __expf(l1[j] - c1[j]); } }
            *(LAS v4u*)(lds + L_KD + (c >> 2) * 4096 + t * 64 + (c & 3) * 16) = pack8f(kf);
            asm volatile("s_waitcnt vmcnt(0) lgkmcnt(0)" ::: "memory"); __builtin_amdgcn_s_barrier(); asm volatile("" ::: "memory");
            const LAS unsigned char* tp = lds + ((lane >> 4) & 1) * 32 + (lane & 3) * 8 + (4 * hi + ((lane & 15) >> 2)) * 64;
            f32x16 acc;
#pragma unroll
            for (int r = 0; r < 16; ++r) acc[r] = 0.f;
#pragma unroll
            for (int ks = 0; ks < 4; ++ks) acc = __builtin_amdgcn_mfma_f32_32x32x16_bf16(trfrag(tp + L_V + eb * 4096 + ks * 1024), trfrag(tp + L_KD + db * 4096 + ks * 1024), acc, 0, 0, 0);
            const float decv = mix ? __expf(cum[63 * 64 + dcol]) : cret;
            LDS_WAIT(); __builtin_amdgcn_s_barrier(); asm volatile("" ::: "memory");
            { const int un = (i < 15) ? u + 1 : (v + F.G) * 16; if (i < 15 || v + F.G < 256) R1_FETCH(un, cur); }
            {
                LAS unsigned char* sg = lds + L_OB + wid * 2048;
#pragma unroll
                for (int r = 0; r < 16; ++r) *(LAS unsigned short*)(sg + crow(r, hi) * 64 + r32 * 2) = (unsigned short)f2bf(state[r]);
                LDS_WAIT();
                bf16* st = ST + ((size_t)(sq * 128 + n)) * 8192 + (size_t)(32 * eb) * 64 + 32 * db;
#pragma unroll
                for (int j = 0; j < 2; ++j) { const int p = lane + 64 * j, row = p >> 2, c16 = p & 3;
                    *(v4u*)(st + row * 64 + 8 * c16) = *(const LAS v4u*)(sg + row * 64 + c16 * 16); }
            }
            if (mix == 1 && eb == 0 && hi == 0) DEC[(size_t)(bh * 128 + n) * 64 + dcol] = pst;
#pragma unroll
            for (int r = 0; r < 16; ++r) state[r] = state[r] * decv + acc[r];
            pst *= decv;
        }
        bf16* tt = TOT + ((size_t)(sq * 8 + run)) * 8192 + dcol;
#pragma unroll
        for (int r = 0; r < 16; ++r) tt[(32 * eb + crow(r, hi)) * 64] = (bf16)f2bf(state[r]);
        if (eb == 0 && hi == 0) DR[(size_t)(sq * 8 + run) * 64 + dcol] = pst;
    }
#undef R1_FETCH
}

__device__ __forceinline__ void phase_r3_mfma(const Args& a, const Frame& F, int l, bool dry) {
    using namespace lin;
    unsigned char* ws = F.ws; bf16* proj = (bf16*)(ws + WS_BIG); const bf16* ST = (const bf16*)(ws + WS_ST); const float* DEC = (const float*)(ws + WS_DEC);
    const bf16* TOT = (const bf16*)(ws + WS_TOT); const float* DR = (const float*)(ws + WS_DR);
    const int tid = opaque_tid(F.wave), lane = tid & 63, wid = F.wave, r32 = lane & 31, hi = lane >> 5;
    LAS unsigned char* lds = F.lds; LAS float* cum = (LAS float*)(lds + L_CUM); LAS float* tot = (LAS float*)(lds + L_TOT); LAS float* ob = (LAS float*)(lds + L_OB);
    const int t = tid >> 3, c = tid & 7;
#define R3_FETCH(u_, f_) do { const int mix_ = (u_) >> 11, bh_ = ((u_) >> 7) & 15, n_ = (u_) & 127, h_ = bh_ & 3; \
        const bf16* prow_ = proj + (size_t)((bh_ >> 2) * SEQ + n_ * 64) * PJ; \
        f_.qw = *(const v4u*)(prow_ + (size_t)t * PJ + (mix_ ? C_CQ : C_RQ) + h_ * 64 + 8 * c); f_.kw = *(const v4u*)(prow_ + (size_t)t * PJ + (mix_ ? C_CK : C_RK) + h_ * 64 + 8 * c); \
        if (mix_) { _Pragma("unroll") for (int x = 0; x < 8; ++x) f_.la[x] = prow_[(size_t)((tid >> 6) * 8 + x) * PJ + C_LA + h_ * 64 + (tid & 63)]; \
                    const f32x4* pp_ = (const f32x4*)(DEC + (size_t)(bh_ * 128 + n_) * 64 + 8 * c); f_.pn0 = pp_[0]; f_.pn1 = pp_[1]; } \
        { const v4u* gp_ = (const v4u*)(prow_ + (size_t)t * PJ + (mix_ ? C_CG : C_RG) + h_ * 128 + 16 * c); f_.g0 = gp_[0]; f_.g1 = gp_[1]; } \
        dma_v(lds, prow_ + (mix_ ? C_CV : C_RV) + h_ * 128, wid, lane); \
        { const bf16* st_ = ST + ((size_t)((mix_ * 16 + bh_) * 128 + n_)) * 8192; \
          _Pragma("unroll") for (int i_ = 0; i_ < 2; ++i_) { const int p = wid + 8 * i_, cc = p >> 1, e0 = 64 * (p & 1); \
            __builtin_amdgcn_global_load_lds((const unsigned*)(st_ + (size_t)(e0 + lane) * 64 + cc * 8), (LAS unsigned*)(lds + L_S + cc * 2048 + e0 * 16), 16, 0, 0); } } } while (0)
    RFetch cur;
    int v = F.vcu;
    for (; v < 256; v += F.G) {
        const int sq = v >> 3, run = v & 7, mix = sq >> 4, bh = sq & 15, b = bh >> 2, h = bh & 3;
        const float lg64 = 64.0f * ret_logg(h);
        {
            const int e = tid >> 2, d0 = (tid & 3) * 16; float sv[16];
#pragma unroll
            for (int k = 0; k < 16; ++k) sv[k] = 0.f;
#pragma unroll 1
            for (int q = 0; q < run; ++q) {
                const v4u* tp_ = (const v4u*)(TOT + ((size_t)(sq * 8 + q)) * 8192 + e * 64 + d0); const f32x4* dp_ = (const f32x4*)(DR + (size_t)(sq * 8 + q) * 64 + d0);
                float tv[16]; { float t0[8], t1[8]; unpack8(tp_[0], t0); unpack8(tp_[1], t1);
#pragma unroll
                  for (int k = 0; k < 8; ++k) { tv[k] = t0[k]; tv[8 + k] = t1[k]; } }
#pragma unroll
                for (int k4 = 0; k4 < 4; ++k4) { const f32x4 d4 = dp_[k4];
#pragma unroll
                    for (int k = 0; k < 4; ++k) sv[4 * k4 + k] = sv[4 * k4 + k] * d4[k] + tv[4 * k4 + k]; }
            }
            float s0[8], s1[8];
#pragma unroll
            for (int k = 0; k < 8; ++k) { s0[k] = sv[k]; s1[k] = sv[8 + k]; }
            *(LAS v4u*)(lds + L_SIN + ((tid & 3) * 2) * 2048 + e * 16) = pack8f(s0); *(LAS v4u*)(lds + L_SIN + ((tid & 3) * 2 + 1) * 2048 + e * 16) = pack8f(s1);
        }
        R3_FETCH(v * 16, cur);
#pragma unroll 1
        for (int i = 0; i < 16; ++i) {
            const int u = v * 16 + i, n = run * 16 + i;
            bf16* prow = proj + (size_t)(b * SEQ + n * 64) * PJ;
            const int cg = (mix ? C_CG : C_RG) + h * 128;
            const float* gn = uni(mix ? a.gla_norm : a.ret_norm) + l * 128;
            chunk_cum_regs(cum, tot, cur.la, mix, h, tid);
            { float qf[8], kf[8], q2[8]; unpack8(cur.qw, qf); unpack8(cur.kw, kf);
              const f32x4 c0 = *(const LAS f32x4*)(cum + t * 64 + 8 * c), c1 = *(const LAS f32x4*)(cum + t * 64 + 8 * c + 4);
              const float pret = __expf(lg64 * (float)i);
#pragma unroll
              for (int j = 0; j < 4; ++j) { const float e0 = __expf(c0[j]), e1 = __expf(c1[j]); qf[j] *= e0; qf[4 + j] *= e1; kf[j] *= __builtin_amdgcn_rcpf(e0); kf[4 + j] *= __builtin_amdgcn_rcpf(e1);
                  q2[j] = qf[j] * (mix ? cur.pn0[j] : pret); q2[4 + j] = qf[4 + j] * (mix ? cur.pn1[j] : pret); }
              *(LAS v4u*)(lds + L_QE + c * 1024 + t * 16) = pack8f(qf); *(LAS v4u*)(lds + L_KE + c * 1024 + t * 16) = pack8f(kf); *(LAS v4u*)(lds + L_QE2 + c * 1024 + t * 16) = pack8f(q2); }
            const v4u gw0 = cur.g0, gw1 = cur.g1;
            asm volatile("s_waitcnt vmcnt(0) lgkmcnt(0)" ::: "memory"); __builtin_amdgcn_s_barrier(); asm volatile("" ::: "memory");
            {
                const int ib = wid & 1, eb = wid >> 1;
                bf16x8 qe[4];
#pragma unroll
                for (int d0 = 0; d0 < 4; ++d0) qe[d0] = *(const LAS bf16x8*)(lds + L_QE + (2 * d0 + hi) * 1024 + (32 * ib + r32) * 16);
                f32x16 p0, p1;
#pragma unroll
                for (int r = 0; r < 16; ++r) { p0[r] = 0.f; p1[r] = 0.f; }
                const LAS unsigned char* kb = lds + L_KE + hi * 1024 + r32 * 16;
#pragma unroll
                for (int d0 = 0; d0 < 4; ++d0) p0 = __builtin_amdgcn_mfma_f32_32x32x16_bf16(*(const LAS bf16x8*)(kb + d0 * 2048), qe[d0], p0, 0, 0, 0);
                if (ib == 1) {
#pragma unroll
                    for (int d0 = 0; d0 < 4; ++d0) p1 = __builtin_amdgcn_mfma_f32_32x32x16_bf16(*(const LAS bf16x8*)(kb + d0 * 2048 + 512), qe[d0], p1, 0, 0, 0);
#pragma unroll
                    for (int r = 0; r < 16; ++r) if (crow(r, hi) > r32) p1[r] = 0.f;
                } else {
#pragma unroll
                    for (int r = 0; r < 16; ++r) if (crow(r, hi) > r32) p0[r] = 0.f;
                }
                bf16x8 pa[4];
                { v4u w0 = {cvtpk2(p0[0], p0[1]), cvtpk2(p0[2], p0[3]), cvtpk2(p0[4], p0[5]), cvtpk2(p0[6], p0[7])};
                  v4u w1 = {cvtpk2(p0[8], p0[9]), cvtpk2(p0[10], p0[11]), cvtpk2(p0[12], p0[13]), cvtpk2(p0[14], p0[15])};
                  v4u w2 = {cvtpk2(p1[0], p1[1]), cvtpk2(p1[2], p1[3]), cvtpk2(p1[4], p1[5]), cvtpk2(p1[6], p1[7])};
                  v4u w3 = {cvtpk2(p1[8], p1[9]), cvtpk2(p1[10], p1[11]), cvtpk2(p1[12], p1[13]), cvtpk2(p1[14], p1[15])};
                  pa[0] = __builtin_bit_cast(bf16x8, w0); pa[1] = __builtin_bit_cast(bf16x8, w1); pa[2] = __builtin_bit_cast(bf16x8, w2); pa[3] = __builtin_bit_cast(bf16x8, w3); }
                f32x16 o;
#pragma unroll
                for (int r = 0; r < 16; ++r) o[r] = 0.f;
                const LAS unsigned char* vp = lds + L_V + eb * 4096 + ((lane >> 4) & 1) * 32 + (lane & 3) * 8 + (4 * hi + ((lane & 15) >> 2)) * 64;
#pragma unroll
                for (int ks = 0; ks < 4; ++ks) o = __builtin_amdgcn_mfma_f32_32x32x16_bf16(pa[ks], trfrag(vp + ks * 1024), o, 0, 0, 0);
#pragma unroll
                for (int d0 = 0; d0 < 4; ++d0) o = __builtin_amdgcn_mfma_f32_32x32x16_bf16(qe[d0], *(const LAS bf16x8*)(lds + L_S + (2 * d0 + hi) * 2048 + (32 * eb + r32) * 16), o, 0, 0, 0);
#pragma unroll
                for (int d0 = 0; d0 < 4; ++d0) o = __builtin_amdgcn_mfma_f32_32x32x16_bf16(*(const LAS bf16x8*)(lds + L_QE2 + (2 * d0 + hi) * 1024 + (32 * ib + r32) * 16),
                                                                                         *(const LAS bf16x8*)(lds + L_SIN + (2 * d0 + hi) * 2048 + (32 * eb + r32) * 16), o, 0, 0, 0);
#pragma unroll
                for (int r = 0; r < 16; ++r) ob[(32 * ib + crow(r, hi)) * OB_LD + 32 * eb + r32] = o[r];
            }
            LDS_WAIT(); __builtin_amdgcn_s_barrier(); asm volatile("" ::: "memory");
            if (i < 15) R3_FETCH(u + 1, cur);
            {
                const int ii = tid >> 3, sg = tid & 7;
                f32x4 vv[4]; float ss = 0.f;
#pragma unroll
                for (int k = 0; k < 4; ++k) { vv[k] = *(const LAS f32x4*)(ob + ii * OB_LD + 16 * sg + 4 * k); ss += (vv[k][0] * vv[k][0] + vv[k][1] * vv[k][1]) + (vv[k][2] * vv[k][2] + vv[k][3] * vv[k][3]); }
                ss = xadd<1>(ss); ss = xadd<2>(ss); ss = xadd<4>(ss);
                const float rstd = __builtin_amdgcn_rsqf(ss * (1.0f / 128.0f) + EPS);
                v4u* gp = (v4u*)(prow + (size_t)ii * PJ + cg + 16 * sg);
#pragma unroll
                for (int k2 = 0; k2 < 2; ++k2) { const v4u gw = k2 ? gw1 : gw0; float gf[8]; unpack8(gw, gf);
                    const f32x4 g0 = *(const f32x4*)(gn + 16 * sg + 8 * k2), g1 = *(const f32x4*)(gn + 16 * sg + 8 * k2 + 4);
                    float y[8];
#pragma unroll
                    for (int j = 0; j < 4; ++j) { y[j] = vv[2 * k2][j] * rstd * g0[j] * gf[j]; y[4 + j] = vv[2 * k2 + 1][j] * rstd * g1[j] * gf[4 + j]; }
                    if (!dry) gp[k2] = pack8f(y); }
            }
        }
        LDS_WAIT(); __builtin_amdgcn_s_barrier(); asm volatile("" ::: "memory");
    }
#undef R3_FETCH
}

namespace att {
typedef float f32x16 __attribute__((ext_vector_type(16)));
typedef short v4i16_t __attribute__((ext_vector_type(4)));
constexpr int SLOT = 16384, L_K = 0, L_V = 3 * SLOT, L_WS = 6 * SLOT, L_XCH = 0, L_STG = 65536;
constexpr float THR = 8.0f;
__device__ __forceinline__ int crow(int r, int hi) { return (r & 3) + 8 * (r >> 2) + 4 * hi; }
__device__ __forceinline__ float swapmax(float m) { auto rr = __builtin_amdgcn_permlane32_swap(__float_as_uint(m), __float_as_uint(m), false, false); return fmaxf(__uint_as_float(rr[0]), __uint_as_float(rr[1])); }
__device__ __forceinline__ float max3f(float a, float b, float c) { return __builtin_fmaxf(__builtin_fmaxf(a, b), c); }
__device__ __forceinline__ float swapadd(float m) { auto rr = __builtin_amdgcn_permlane32_swap(__float_as_uint(m), __float_as_uint(m), false, false); return __uint_as_float(rr[0]) + __uint_as_float(rr[1]); }
__device__ __forceinline__ unsigned cvtpk(float lo, float hi) { typedef float f2 __attribute__((ext_vector_type(2))); typedef __bf16 b2 __attribute__((ext_vector_type(2))); f2 v = {lo, hi}; b2 b = __builtin_convertvector(v, b2); return __builtin_bit_cast(unsigned, b); }

__device__ __forceinline__ void attn_unit(LAS unsigned char* lds, bf16* proj, int tid, int wid, int b, int h, int qb, float lam, float post, const float* gn, bool dry,
                                          const Args& a, unsigned char* wnext, int lnext, int it0, int it1) {
    const int lane = tid & 63, r32 = lane & 31, hi = lane >> 5, mp = wid & 1, rw = wid >> 1;
    const size_t rowbase = (size_t)b * SEQ; const int q0 = qb * 128;
    const int NT = 2 * qb + 2, NTw = 2 * qb + 1 + (rw >> 1);
    const bf16* Kh = proj + rowbase * PJ + C_AK + h * 128; const bf16* Vh = proj + rowbase * PJ + C_AV + h * 128;
    const unsigned kvoff = (unsigned)(lane * PJ + wid * 8) * 2u;
    const unsigned vvoff = (unsigned)((16 * (wid & 3) + (lane >> 2)) * PJ + (wid >> 2) * 32 + (lane & 3) * 8) * 2u;
    const unsigned kdst = L_K + wid * 1024, vdst = L_V + wid * 1024;
    const unsigned ldsb = (unsigned)(size_t)lds;
#define ATT_DMA(t, slot) do { const char* kt_ = (const char*)uni(Kh + (size_t)(t) * 64 * PJ); const char* vt_ = (const char*)uni(Vh + (size_t)(t) * 64 * PJ); \
        const unsigned kd_ = (unsigned)__builtin_amdgcn_readfirstlane((int)(ldsb + kdst + (slot) * SLOT)), vd_ = (unsigned)__builtin_amdgcn_readfirstlane((int)(ldsb + vdst + (slot) * SLOT)); \
        glds16s<0>(kt_, kvoff, kd_); glds16s<0>(kt_ + 128, kvoff, kd_ + 8192); glds16s<0>(vt_, vvoff, vd_); glds16s<0>(vt_ + 128, vvoff, vd_ + 8192); } while (0)
#define ATT_DMA1(t, slot, P_) do { const char* bt_ = (const char*)uni(((P_) < 2 ? Kh : Vh) + (size_t)(t) * 64 * PJ) + ((P_) & 1) * 128; \
        const unsigned dd_ = (unsigned)__builtin_amdgcn_readfirstlane((int)(ldsb + ((P_) < 2 ? kdst : vdst) + (slot) * SLOT + ((P_) & 1) * 8192)); \
        glds16s<0>(bt_, (P_) < 2 ? kvoff : vvoff, dd_); } while (0)
    bf16x8 qr[4];
    { const bf16* qp = proj + (rowbase + q0 + 32 * rw + r32) * PJ + C_AQ + h * 128 + mp * 64 + hi * 8;
#pragma unroll
      for (int d0 = 0; d0 < 4; ++d0) qr[d0] = *(const bf16x8*)(qp + d0 * 16); }
    ATT_DMA(0, 0); ATT_DMA(1, 1);
    f32x16 o[4];
#pragma unroll
    for (int d = 0; d < 4; ++d)
#pragma unroll
        for (int r = 0; r < 16; ++r) o[d][r] = 0.f;
    float mref = 0.f, lsum = 0.f;
    float one_ = 1.0f; asm volatile("" : "+v"(one_));
    f32x16 negm;
#pragma unroll
    for (int r = 0; r < 16; ++r) negm[r] = 0.f;
    volatile LAS float* wsf = (volatile LAS float*)(lds + L_WS) + wid * 64;
    const LAS unsigned char* kb0 = lds + L_K + mp * 8192 + hi * 1024 + r32 * 16;
    const LAS unsigned char* vp0 = lds + L_V + ((lane >> 4) & 1) * 32 + (lane & 3) * 8 + (4 * hi + ((lane & 15) >> 2)) * 64;
#define ATT_KLOAD(slot) do { _Pragma("unroll") for (int d0 = 0; d0 < 4; ++d0) { kf[2 * d0] = *(const LAS bf16x8*)(kb0 + (slot) * SLOT + d0 * 2048); kf[2 * d0 + 1] = *(const LAS bf16x8*)(kb0 + (slot) * SLOT + d0 * 2048 + 512); } } while (0)
#define ATT_VLOAD(dst, slot, d0_) do { _Pragma("unroll") for (int ks_ = 0; ks_ < 4; ++ks_) { \
        const v4i16_t lo_ = __builtin_amdgcn_ds_read_tr16_b64_v4i16((LAS v4i16_t*)(vp0 + (slot) * SLOT + (d0_) * 4096 + ks_ * 1024)); \
        const v4i16_t hh_ = __builtin_amdgcn_ds_read_tr16_b64_v4i16((LAS v4i16_t*)(vp0 + (slot) * SLOT + (d0_) * 4096 + ks_ * 1024 + 512)); \
        dst[ks_] = (bf16x8){lo_[0], lo_[1], lo_[2], lo_[3], hh_[0], hh_[1], hh_[2], hh_[3]}; } } while (0)
#define ATT_PV(d0_, vf_) do { _Pragma("unroll") for (int ks_ = 0; ks_ < 4; ++ks_) o[d0_] = __builtin_amdgcn_mfma_f32_32x32x16_bf16(pa[ks_], vf_[ks_], o[d0_], 0, 0, 0); } while (0)
    asm volatile("s_waitcnt vmcnt(4)" ::: "memory"); LDS_WAIT(); __builtin_amdgcn_s_barrier(); asm volatile("" ::: "memory");
    bf16x8 kf[8];
    ATT_KLOAD(0);
#define ATT_PARTA(FIRST_, p0, p1) \
            float ra = max3f(p0[0], p0[1], p1[0]), rb = max3f(p0[2], p0[3], p1[1]); ra = max3f(ra, p1[2], p1[3]); \
            _Pragma("unroll") for (int r = 4; r < 16; r += 4) { ra = max3f(ra, p0[r], p0[r + 1]); rb = max3f(rb, p0[r + 2], p0[r + 3]); ra = max3f(ra, p1[r], p1[r + 1]); rb = max3f(rb, p1[r + 2], p1[r + 3]); } \
            float rm = swapmax(fmaxf(ra, rb)); \
            if ((FIRST_) || __any(rm > THR)) { \
                const float dl = (FIRST_) ? rm : fmaxf(rm, 0.f); \
                mref += dl; \
                _Pragma("unroll") for (int r = 0; r < 16; ++r) { p0[r] -= dl; p1[r] -= dl; negm[r] = -mref; } \
                fres_ = fast_exp2(-dl); lsum *= fres_; need_ = !(FIRST_); }
#define ATT_PARTB(p0, p1, pk) \
            { float sacc = 0.f, sbcc = 0.f; \
            _Pragma("unroll") for (int r = 0; r < 16; ++r) { p0[r] = fast_exp2(p0[r]); p1[r] = fast_exp2(p1[r]); sacc += p0[r]; sbcc = __builtin_fmaf(p1[r], one_, sbcc); } \
            lsum += sacc + sbcc; \
            { v4u w0 = {cvtpk(p0[0], p0[1]), cvtpk(p0[2], p0[3]), cvtpk(p0[4], p0[5]), cvtpk(p0[6], p0[7])}; \
              v4u w1 = {cvtpk(p0[8], p0[9]), cvtpk(p0[10], p0[11]), cvtpk(p0[12], p0[13]), cvtpk(p0[14], p0[15])}; \
              v4u w2 = {cvtpk(p1[0], p1[1]), cvtpk(p1[2], p1[3]), cvtpk(p1[4], p1[5]), cvtpk(p1[6], p1[7])}; \
              v4u w3 = {cvtpk(p1[8], p1[9]), cvtpk(p1[10], p1[11]), cvtpk(p1[12], p1[13]), cvtpk(p1[14], p1[15])}; \
              pk[0] = __builtin_bit_cast(bf16x8, w0); pk[1] = __builtin_bit_cast(bf16x8, w1); pk[2] = __builtin_bit_cast(bf16x8, w2); pk[3] = __builtin_bit_cast(bf16x8, w3); } }
#define ATT_POST() \
            if (need_) { if (hi == 0) wsf[r32] = fres_; \
                _Pragma("unroll") for (int r = 0; r < 16; ++r) { const float fr = wsf[crow(r, hi)]; \
                    _Pragma("unroll") for (int d = 0; d < 4; ++d) o[d][r] *= fr; } }
#define ATT_SB() __builtin_amdgcn_sched_barrier(0)
#define ATT_QK(p0, p1) do { p0 = __builtin_amdgcn_mfma_f32_32x32x16_bf16(kf[0], qr[0], negm, 0, 0, 0); p1 = __builtin_amdgcn_mfma_f32_32x32x16_bf16(kf[1], qr[0], negm, 0, 0, 0); \
        _Pragma("unroll") for (int d0 = 1; d0 < 4; ++d0) { p0 = __builtin_amdgcn_mfma_f32_32x32x16_bf16(kf[2 * d0], qr[d0], p0, 0, 0, 0); p1 = __builtin_amdgcn_mfma_f32_32x32x16_bf16(kf[2 * d0 + 1], qr[d0], p1, 0, 0, 0); } } while (0)
#define ATT_STEP(T_, SL_, SL1_, SL2_, G_DMA, ACT_, ACTN_) do { \
        if (ACTN_) ATT_KLOAD(SL1_); \
        if (G_DMA) ATT_DMA1((T_) + 2, SL2_, 0); \
        if (ACT_) { ATT_PV(0, va); ATT_VLOAD(va, SL_, 2); } \
        ATT_SB(); \
        if (G_DMA) ATT_DMA1((T_) + 2, SL2_, 1); \
        bool need_ = false; float fres_ = 1.0f; \
        if (ACTN_) { ATT_QK(ps0, ps1); ATT_SB(); if (G_DMA) ATT_DMA1((T_) + 2, SL2_, 2); ATT_PARTA(false, ps0, ps1) } \
        else if (G_DMA) ATT_DMA1((T_) + 2, SL2_, 2); \
        ATT_SB(); \
        if (G_DMA) ATT_DMA1((T_) + 2, SL2_, 3); \
        if (ACT_) { ATT_PV(1, vb); ATT_VLOAD(vb, SL_, 3); ATT_PV(2, va); ATT_PV(3, vb); } \
        if (ACTN_) { ATT_PARTB(ps0, ps1, pn) asm volatile("" :: "v"(pn[0]), "v"(pn[1]), "v"(pn[2]), "v"(pn[3]), "v"(lsum)); }        \
        _Pragma("unroll") for (int g_ = 0; g_ < 12; ++g_) { __builtin_amdgcn_sched_group_barrier(0x008, 1, 0); __builtin_amdgcn_sched_group_barrier(0x100, 1, 0); __builtin_amdgcn_sched_group_barrier(0x002, 7, 0); } \
        ATT_SB(); \
        if (ACTN_) { ATT_POST() _Pragma("unroll") for (int i_ = 0; i_ < 4; ++i_) pa[i_] = pn[i_]; \
            ATT_VLOAD(va, SL1_, 0); ATT_VLOAD(vb, SL1_, 1); } \
        ATT_SB(); \
    } while (0)
#define ATT_BARRIER() do { asm volatile("s_waitcnt vmcnt(0)" ::: "memory"); __builtin_amdgcn_s_barrier(); asm volatile("" ::: "memory"); } while (0)
    f32x16 ps0, ps1; bf16x8 pa[4], pn[4];
#pragma unroll
    for (int i = 0; i < 4; ++i) { pa[i] = (bf16x8){0, 0, 0, 0, 0, 0, 0, 0}; pn[i] = pa[i]; }
    bf16x8 va[4], vb[4];
    ATT_QK(ps0, ps1);
    ATT_VLOAD(va, 0, 0); ATT_VLOAD(vb, 0, 1);
    { bool need_ = false; float fres_ = 1.0f; ATT_PARTA(true, ps0, ps1) ATT_PARTB(ps0, ps1, pa) (void)need_; (void)fres_; }
    int t = 0;
    for (; t + 5 <= NT; t += 3) {
        ATT_BARRIER(); ATT_STEP(t, 0, 1, 2, true, true, true);
        ATT_BARRIER(); ATT_STEP(t + 1, 1, 2, 0, true, true, true);
        ATT_BARRIER(); ATT_STEP(t + 2, 2, 0, 1, true, true, true);
    }
    {
        int sl = 0, sl1 = 1, sl2 = 2;
        for (; t < NT; ++t) {
            if (t + 1 < NT) ATT_BARRIER();
            ATT_STEP(t, sl, sl1, sl2, (t + 2 < NT), (t < NTw), (t + 1 < NTw));
            const int s0 = sl; sl = sl1; sl1 = sl2; sl2 = s0;
        }
    }
#undef ATT_STEP
#undef ATT_PARTA
#undef ATT_PARTB
#undef ATT_POST
#undef ATT_BARRIER
#undef ATT_QK
#undef ATT_FAST
#undef ATT_SB
#undef ATT_KLOAD
#undef ATT_VLOAD
#undef ATT_PV
    int lane_e = lane; asm volatile("" : "+v"(lane_e)); const int r32e = lane_e & 31, hie = lane_e >> 5;
    const ConvJob cj0 = conv_job(a, wnext, lnext, it0), cj1 = conv_job(a, wnext, lnext, it1); f32x4 ct0[8], ct1[8];
    conv_load(cj0, lane_e, ct0); conv_load(cj1, lane_e, ct1);
    lsum = swapadd(lsum);
    if (hie == 0) wsf[r32e] = 1.0f / lsum;
#pragma unroll
    for (int r = 0; r < 16; ++r) { const float fr = wsf[crow(r, hie)];
#pragma unroll
        for (int d = 0; d < 4; ++d) o[d][r] *= fr; }
    LDS_WAIT(); __builtin_amdgcn_s_barrier(); asm volatile("" ::: "memory");
    LAS float* xch = (LAS float*)(lds + L_XCH) + rw * 4096 + lane_e;
    if (mp == 1) {
#pragma unroll
        for (int d = 0; d < 4; ++d)
#pragma unroll
            for (int r = 0; r < 16; ++r) xch[(d * 16 + r) * 64] = o[d][r];
    }
    LDS_WAIT(); __builtin_amdgcn_s_barrier(); asm volatile("" ::: "memory");
    if (mp == 0) {
        float ss[16];
#pragma unroll
        for (int r = 0; r < 16; ++r) ss[r] = 0.f;
#pragma unroll
        for (int d = 0; d < 4; ++d)
#pragma unroll
            for (int r = 0; r < 16; ++r) { const float y = o[d][r] - lam * xch[(d * 16 + r) * 64]; o[d][r] = y; ss[r] += y * y; }
#pragma unroll
        for (int r = 0; r < 16; ++r) {
            ss[r] = xadd<1>(ss[r]); ss[r] = xadd<2>(ss[r]); ss[r] = xadd<4>(ss[r]); ss[r] = xadd<8>(ss[r]); ss[r] = xadd<16>(ss[r]);
            ss[r] = post * __builtin_amdgcn_rsqf(ss[r] * (1.0f / 128.0f) + EPS);
        }
        LAS bf16* stg = (LAS bf16*)(lds + L_STG + rw * 8192);
#pragma unroll
        for (int d = 0; d < 4; ++d) { const float g = gn[32 * d + r32e];
#pragma unroll
            for (int r = 0; r < 16; ++r) stg[crow(r, hie) * 128 + 32 * d + r32e] = (bf16)f2bf(o[d][r] * ss[r] * g); }
        LDS_WAIT();
        bf16* orow = proj + (rowbase + q0 + 32 * rw) * PJ + C_AQ + h * 128;
#pragma unroll
        for (int i = 0; i < 8; ++i) { const int row = i * 4 + (lane_e >> 4), ch = lane_e & 15;
            const v4u v = *(const LAS v4u*)(stg + row * 128 + ch * 8); if (!dry) *(v4u*)(orow + (size_t)row * PJ + ch * 8) = v; }
    }
    conv_store(cj0, lane_e, ct0); conv_store(cj1, lane_e, ct1);
    LDS_WAIT(); __builtin_amdgcn_s_barrier(); asm volatile("" ::: "memory");
#undef ATT_DMA
#undef ATT_DMA1
}
}

__device__ __forceinline__ void phase_attn(const Args& a, const Frame& F, int l, bool dry, unsigned char* wnext) {
    unsigned char* ws = F.ws; bf16* proj = (bf16*)(ws + WS_BIG);
    const float lam = ((const float*)(ws + WS_LAM))[l];
    const float post = 1.0f - LAM_INIT[l];
    const float* gn = uni(a.da_norm) + l * 128;
    const int tid = opaque_tid(F.wave);
    for (int v = F.vcu; v < 256; v += F.G) {
        const int bh = v >> 4, s = v & 15;
#pragma unroll 1
        for (int i = 0; i < 4; ++i) {
            const int qb = (i == 0) ? 63 - s : (i == 1) ? 32 + s : (i == 2) ? 31 - s : s;
            const bool cv = (wnext != nullptr) && (v == F.vcu);
            const int gw = F.vcu * 8 + F.wave, NGW = F.G * 8;
            att::attn_unit(F.lds, proj, tid, F.wave, bh >> 2, bh & 3, qb, lam, post, gn, dry, a, wnext, l + 1, cv ? gw + (2 * i) * NGW : -1, cv ? gw + (2 * i + 1) * NGW : -1);
            if (cv && i == 3) {
                int lane = tid & 63; asm volatile("" : "+v"(lane));
                for (int it = gw + 8 * NGW; it < I_TOTAL - I_LA; it += NGW) conv_item(a, wnext, l + 1, it, lane);
                for (int r = gw; r < I_LA; r += NGW) conv_la_item(a, wnext, l + 1, r, lane);
                if (gw == 0) conv_lam(a, F.ws, l + 1, lane);
            }
        }
    }
}


constexpr int NPH = 12;
constexpr int N_PHASES = DEPTH * NPH + 1;
#ifndef REP_UP
#define REP_UP 1
#endif
#ifndef REP_DOWN
#define REP_DOWN 1
#endif
#ifndef REP_INPROJ
#define REP_INPROJ 1
#endif
#ifndef REP_R
#define REP_R 1
#endif
#ifndef REP_ATTN
#define REP_ATTN 1
#endif
#ifndef REP_G
#define REP_G 1
#endif
#ifndef REP_M
#define REP_M 1
#endif
#ifndef REP_R2
#define REP_R2 1
#endif
#ifndef REP_NORM
#define REP_NORM 1
#endif
#ifndef MK_PER_PHASE
#define MK_PER_PHASE 0
#endif

__global__ void __launch_bounds__(512, 2) mk_fwd(Args a) {
    extern __shared__ __attribute__((aligned(16))) unsigned char lds_raw[];
    Frame F;
    F.lds = (LAS unsigned char*)lds_raw; F.ws = uni(a.ws); F.wave = __builtin_amdgcn_readfirstlane((int)threadIdx.x >> 6);
    F.G = gridDim.x; { const int bx = blockIdx.x; F.vcu = (F.G % 8 == 0) ? (bx % 8) * (F.G / 8) + bx / 8 : bx; }
    volatile LAS unsigned* MISC = (volatile LAS unsigned*)(F.lds + MISC_OFF);
    if (threadIdx.x < 32) MISC[threadIdx.x] = 0u;
    __syncthreads();
    XcdBarrier bar; bar.bar = (unsigned*)(F.ws + WS_CTL); bar.x = 0; bar.st = nullptr;
    if (!MK_PER_PHASE) bar = xcd_barrier_post((unsigned*)(F.ws + WS_CTL), MISC + 8);
    const int lo = a.ph_lo, hi = a.ph_hi;
#define RUN(k) (lo <= (k) && (k) < hi)
#define SEAM(k) do { if (RUN(k) && RUN((k) + 1)) xcd_barrier(bar); } while (0)
    unsigned char* ws = F.ws; float* const outp = uni(a.out);
    bf16* XB = (bf16*)(ws + WS_HN); bf16* BIG = (bf16*)(ws + WS_BIG); bf16* MG = (bf16*)(ws + WS_ST); float* SSQ = (float*)(ws + WS_SSQ);
    const int cid = (int)blockIdx.x;

    if (RUN(0)) phase_rope(F);
    for (int l = 0; l < DEPTH; ++l) {
        const int pb = l * NPH;
        unsigned char* const wb1 = (unsigned char*)((unsigned long long)outp - WS_W);
        unsigned char* const wcur = (l & 1) ? wb1 : ws; unsigned char* const wnxt = (l + 1 < DEPTH) ? ((l & 1) ? ws : wb1) : nullptr;
        if (RUN(pb)) {
            for (int rep = 0; rep < REP_NORM; ++rep) {
            if (l == 0) phase_conv(a, F, 0, ws);
            if (l == 0) phase_prep(F, uni(a.x), XB, SSQ);
            }
        }
        if (l == 0) SEAM(pb);
        for (int hf = 0; hf < 2; ++hf) {
            const int p0 = pb + (hf ? 10 : 1);
            const float* ssq_in = SSQ + (size_t)(hf ? 2 : 0) * M * 16;
            float* ssq_out = SSQ + (size_t)(hf ? 0 : 1) * M * 16;
            if (RUN(p0)) {
                pg8::Gemm g{(const char*)XB, (const char*)(wcur + (hf ? W_13B : W_13A)), DMODEL, DMODEL, DMODEL, 0, 0};
                pg8::Order<(2 * DFFP) / 256, 1> S; S.init(F.G, cid, F.wave);
                pg8::EpiSwiGLU E{BIG, ssq_in};
                for (int rep = 0; rep < REP_UP; ++rep)
                pg8::gemm_phase<pg8::EpiSwiGLU, true>(F.lds, g, S, E);
            }
            SEAM(p0);
            if (RUN(p0 + 1)) {
                pg8::Gemm g{(const char*)BIG, (const char*)(wcur + (hf ? W_2B : W_2A)), DFFP, DFFP, DFFP, 0, 0};
                pg8::Order<(DMODEL) / 256, 1> S; S.init(F.G, cid, F.wave);
                for (int rep = 0; rep < REP_DOWN; ++rep) {
                pg8::EpiResid E{XB, 0.5f, 2.0f, rep < REP_DOWN - 1, ssq_out};
                pg8::gemm_phase<pg8::EpiResid, true>(F.lds, g, S, E); }
            }
            SEAM(p0 + 1);
            if (hf == 0) {
                const float* ssq_mix = ssq_out;
                if (RUN(pb + 3)) {
                    pg8::Gemm g{(const char*)XB, (const char*)(wcur + W_IN), DMODEL, DMODEL, DMODEL, 0, 0};
                    pg8::Order<(PJ) / 256, 1> S; S.init(F.G, cid, F.wave);
                    pg8::EpiInProj E{BIG, (const float*)(ws + WS_ROPE), uni(a.gla_ab) + l * 256, ssq_mix};
                    for (int rep = 0; rep < REP_INPROJ; ++rep)
                    pg8::gemm_phase<pg8::EpiInProj, true>(F.lds, g, S, E);
                }
                SEAM(pb + 3);
                if (RUN(pb + 4)) for (int rep = 0; rep < REP_R; ++rep) phase_r1_mfma(a, F);
                SEAM(pb + 4);
                if (RUN(pb + 6)) {
                    for (int rep = 0; rep < REP_R; ++rep) phase_r3_mfma(a, F, l, rep < REP_R - 1);
                    for (int rep = 0; rep < REP_ATTN; ++rep) phase_attn(a, F, l, rep < REP_ATTN - 1, rep == REP_ATTN - 1 ? wnxt : nullptr);
                }
                SEAM(pb + 6);
                if (RUN(pb + 7)) {
                    pg8::Gemm g{(const char*)XB, (const char*)(wcur + W_G), DMODEL, DMODEL, DMODEL, 0, 0};
                    pg8::Order<(3 * DMODEL) / 256, 1> S; S.init(F.G, cid, F.wave);
                    pg8::EpiGates E{BIG, ssq_mix};
                    for (int rep = 0; rep < REP_G; ++rep)
                    pg8::gemm_phase<pg8::EpiGates, true>(F.lds, g, S, E);
                }
                SEAM(pb + 7);
                if (RUN(pb + 8)) {
                    pg8::Gemm g{(const char*)BIG, (const char*)(wcur + W_B), PJ, 512, 512, 512 * 2, (size_t)DMODEL * 512 * 2};
                    pg8::Order<(DMODEL) / 256, 3> S; S.init(F.G, cid, F.wave);
                    pg8::EpiMerge E{BIG, MG};
                    for (int rep = 0; rep < REP_M; ++rep)
                    pg8::gemm_phase<pg8::EpiMerge, true>(F.lds, g, S, E);
                }
                SEAM(pb + 8);
                if (RUN(pb + 9)) {
                    pg8::Gemm g{(const char*)MG, (const char*)(wcur + W_O), DMODEL, DMODEL, DMODEL, 0, 0};
                    pg8::Order<(DMODEL) / 256, 1> S; S.init(F.G, cid, F.wave);
                    pg8::EpiResid E{XB, 1.0f, 1.0f, false, SSQ + (size_t)2 * M * 16};
                    pg8::gemm_phase<pg8::EpiResid, true>(F.lds, g, S, E);
                }
                SEAM(pb + 9);
            }
        }
    }
    if (RUN(DEPTH * NPH)) phase_final_norm(F, XB, outp, uni(a.final_norm), SSQ);
#undef RUN
#undef SEAM
}

extern "C" void kernel_launch(void* const* d_in, const int* in_sizes, int n_in, void* d_out, int out_size, void* d_ws, size_t ws_size, hipStream_t stream) {
    static int grid = 0;
    if (grid == 0) {
        if (n_in != 22 || in_sizes[0] != M * DMODEL || out_size != M * DMODEL || ws_size < WS_END) { fprintf(stderr, "kernel_launch: unexpected shapes (n_in %d, ws %zu)\n", n_in, ws_size); grid = -1; return; }
        int dev = 0, cus = 0, per_cu = 0;
        if (hipGetDevice(&dev) != hipSuccess || hipDeviceGetAttribute(&cus, hipDeviceAttributeMultiprocessorCount, dev) != hipSuccess) { grid = -1; return; }
        if (hipFuncSetAttribute((const void*)mk_fwd, hipFuncAttributeMaxDynamicSharedMemorySize, LDS_BYTES) != hipSuccess) { fprintf(stderr, "kernel_launch: hipFuncSetAttribute failed\n"); grid = -1; return; }
        if (hipOccupancyMaxActiveBlocksPerMultiprocessor(&per_cu, (const void*)mk_fwd, 512, LDS_BYTES) != hipSuccess || per_cu < 1) fprintf(stderr, "kernel_launch: occupancy query says %d\n", per_cu);
        (void)hipGetLastError();
        grid = cus;
    }
    if (grid < 0) return;
    if (hipMemsetAsync((char*)d_ws + WS_CTL, 0, CTL_ZERO_BYTES, stream) != hipSuccess) return;
    Args a{};
    a.x = (const float*)d_in[0]; a.ffn1_norm = (const float*)d_in[1]; a.ffn1_w1 = (const float*)d_in[2]; a.ffn1_w3 = (const float*)d_in[3]; a.ffn1_w2 = (const float*)d_in[4];
    a.mix_norm = (const float*)d_in[5]; a.w_in = (const float*)d_in[6]; a.lam_qk = (const float*)d_in[7]; a.da_norm = (const float*)d_in[8]; a.ret_norm = (const float*)d_in[9];
    a.gla_a2 = (const float*)d_in[10]; a.gla_ab = (const float*)d_in[11]; a.gla_norm = (const float*)d_in[12]; a.wb_a = (const float*)d_in[13]; a.wb_b = (const float*)d_in[14];
    a.wb_c = (const float*)d_in[15]; a.w_out = (const float*)d_in[16]; a.ffn2_norm = (const float*)d_in[17]; a.ffn2_w1 = (const float*)d_in[18]; a.ffn2_w3 = (const float*)d_in[19];
    a.ffn2_w2 = (const float*)d_in[20]; a.final_norm = (const float*)d_in[21];
    a.out = (float*)d_out; a.ws = (unsigned char*)d_ws;
#if MK_PER_PHASE
    for (int p = 0; p < N_PHASES; ++p) { a.ph_lo = p; a.ph_hi = p + 1; hipLaunchKernelGGL(mk_fwd, dim3(grid), dim3(512), LDS_BYTES, stream, a); }
#else
    a.ph_lo = 0; a.ph_hi = N_PHASES;
    hipLaunchKernelGGL(mk_fwd, dim3(grid), dim3(512), LDS_BYTES, stream, a);
#endif
}
```

```cpp
#include <hip/hip_runtime.h>
#include <cstdio>
#include <cstdint>

#define GAS __attribute__((address_space(1)))
#define LAS __attribute__((address_space(3)))
typedef unsigned short bf16;
typedef unsigned v4u __attribute__((ext_vector_type(4)));
typedef unsigned v2u __attribute__((ext_vector_type(2)));
typedef float f32x4 __attribute__((ext_vector_type(4)));
typedef float f32x2 __attribute__((ext_vector_type(2)));
typedef short bf16x8 __attribute__((ext_vector_type(8)));

constexpr int BATCH = 4, SEQ = 8192, DMODEL = 1024, DEPTH = 4, M = BATCH * SEQ;
constexpr int NH = 4;
constexpr int DFF = 2752, DFFP = 2816;
constexpr int INC = 7696;
constexpr int PJ = 4864;
constexpr int C_AQ = 0, C_RG = 512, C_CG = 1024, C_AK = 1536, C_AV = 2048, C_RQ = 2560, C_RK = 2816, C_RV = 3072, C_CQ = 3584, C_CK = 3840, C_CV = 4096, C_LA = 4608;
constexpr int C_GATE = 1536;
constexpr int O_AQ = 0, O_AK = 512, O_AV = 1024, O_RQ = 1536, O_RK = 1792, O_RV = 2048, O_RG = 2560, O_CQ = 3072, O_CK = 3328, O_CV = 3584, O_CG = 4096, O_CA = 4608, O_GATE = 4624;
constexpr float EPS = 1e-6f;
constexpr float C2 = 0.125f * 1.4426950408889634f;

constexpr size_t MiB = 1u << 20;
constexpr size_t WS_CTL = 0, CTL_ZERO_BYTES = 64 * 1024;
constexpr size_t WS_LAM = 256 * 1024;
constexpr size_t WS_DEC = 1 * MiB;
constexpr size_t WS_ROPE = 2 * MiB;
constexpr size_t WS_SSQ = 4 * MiB;
constexpr size_t WS_W = 10 * MiB;
constexpr size_t W_13A = WS_W, W_2A = W_13A + 11 * MiB, W_13B = W_2A + 11 * MiB / 2, W_2B = W_13B + 11 * MiB, W_IN = W_2B + 11 * MiB / 2,
                 W_G = W_IN + 19 * MiB / 2, W_B = W_G + 6 * MiB, W_O = W_B + 3 * MiB, W_END = W_O + 2 * MiB;
constexpr size_t WS_HN = 64 * MiB;
constexpr size_t WS_ST = 128 * MiB;
constexpr size_t WS_BIG = 192 * MiB;
constexpr size_t WS_TOT = 496 * MiB;
constexpr size_t WS_DR = 500 * MiB;
constexpr size_t WS_END = 501 * MiB;
static_assert(W_END <= WS_HN, "weight region");

constexpr int RING_BYTES = 131072;
constexpr int MISC_OFF = RING_BYTES + 320;
constexpr int LDS_BYTES = 147456;

__device__ __forceinline__ float bf2f(unsigned h) { return __uint_as_float(h << 16); }
__device__ __forceinline__ float bflo(unsigned w) { return __uint_as_float(w << 16); }
__device__ __forceinline__ float bfhi(unsigned w) { return __uint_as_float(w & 0xffff0000u); }
__device__ __forceinline__ unsigned f2bf(float f) { unsigned u = __float_as_uint(f); return (u + 0x7fffu + ((u >> 16) & 1u)) >> 16; }
__device__ __forceinline__ unsigned pk2(float lo, float hi) { typedef float f2_ __attribute__((ext_vector_type(2))); typedef __bf16 b2_ __attribute__((ext_vector_type(2))); f2_ v = {lo, hi}; b2_ b = __builtin_convertvector(v, b2_); return __builtin_bit_cast(unsigned, b); }
template <int K> __device__ __forceinline__ float xadd(float v) {
    if constexpr (K == 32) { auto rr = __builtin_amdgcn_permlane32_swap(__float_as_uint(v), __float_as_uint(v), false, false); return __uint_as_float(rr[0]) + __uint_as_float(rr[1]); }
    else return v + __int_as_float(__builtin_amdgcn_ds_swizzle(__float_as_int(v), (K << 10) | 0x1f));
}
__device__ __forceinline__ float wave_sum(float v) { v = xadd<1>(v); v = xadd<2>(v); v = xadd<4>(v); v = xadd<8>(v); v = xadd<16>(v); v = xadd<32>(v); return v; }
__device__ __forceinline__ float fast_exp2(float x) { return __builtin_amdgcn_exp2f(x); }
__device__ __forceinline__ float sigmoidf_(float x) { return __builtin_amdgcn_rcpf(1.0f + fast_exp2(-1.4426950408889634f * x)); }
__device__ __forceinline__ float siluf_(float x) { return x * sigmoidf_(x); }
template <class T> __device__ __forceinline__ T* uni(T* p) {
    const unsigned long long v = (unsigned long long)p;
    const unsigned lo = __builtin_amdgcn_readfirstlane((unsigned)v), hi = __builtin_amdgcn_readfirstlane((unsigned)(v >> 32));
    return (T*)(GAS T*)(((unsigned long long)hi << 32) | lo);
}
__device__ __forceinline__ int opaque_tid(int wave) { int z = 0; asm volatile("" : "+v"(z)); const int lane = __builtin_amdgcn_mbcnt_hi(-1, __builtin_amdgcn_mbcnt_lo(-1, z)); return wave * 64 + lane; }
__device__ __forceinline__ unsigned cvtpk2(float lo, float hi) { typedef float f2 __attribute__((ext_vector_type(2))); typedef __bf16 b2 __attribute__((ext_vector_type(2))); f2 v = {lo, hi}; b2 b = __builtin_convertvector(v, b2); return __builtin_bit_cast(unsigned, b); }
__device__ __forceinline__ void glds16(const void* gsrc, unsigned lds_dst) { unsigned keep;
    asm volatile("s_mov_b32 %0, m0\n\ts_mov_b32 m0, %2\n\ts_nop 0\n\tglobal_load_lds_dwordx4 %1, off\n\ts_mov_b32 m0, %0" : "=&s"(keep) : "v"(gsrc), "s"(lds_dst) : "memory"); }
template <int IMM> __device__ __forceinline__ void glds16s(const void* sbase, unsigned voff, unsigned lds_dst) { unsigned keep;
    asm volatile("s_mov_b32 %0, m0\n\ts_mov_b32 m0, %3\n\ts_nop 0\n\tglobal_load_lds_dwordx4 %1, %2 offset:%c4\n\ts_mov_b32 m0, %0" : "=&s"(keep) : "v"(voff), "s"(sbase), "s"(lds_dst), "i"(IMM) : "memory"); }
#define LDS_WAIT() asm volatile("s_waitcnt lgkmcnt(0)" ::: "memory")
#define VM_WAIT() asm volatile("s_waitcnt vmcnt(0)" ::: "memory")

namespace pg8 {
constexpr int BM = 256, BK = 64, HALF = 128, HTB = HALF * BK * 2, NXCD = 8, WGM = 8;
__host__ __device__ __forceinline__ int lds_byte(int r, int c) { const int x = (-(r >> 2)) & 3; return (r >> 3) * 1024 + (c >> 5) * 512 + (r & 7) * 64 + (((((c >> 3) & 3) ^ x)) << 4) + (c & 7) * 2; }
__host__ __device__ __forceinline__ void stage_rc(int b, int& R, int& C) { const int blk = b / 1024, i = (b % 1024) / 16; R = blk * 8 + ((i & 31) >> 2); const int x = (-(R >> 2)) & 3; C = ((i >> 5) * 4 + ((i & 3) ^ x)) * 8 + (b % 16) / 2; }
__host__ __device__ __forceinline__ int perm32(int rho) { const int n = rho >> 4, i = rho & 15; return 8 * (i >> 2) + 4 * n + (i & 3); }

struct Unit { int pm, pn, z; };
struct Gemm { const char* A; const char* B; int lda, ldb, K; size_t zA, zB; };
__device__ __forceinline__ const char* a_base(const Gemm& g, const Unit& u) { return g.A + (size_t)u.pm * 256 * g.lda * 2 + (size_t)u.z * g.zA; }
__device__ __forceinline__ const char* b_base(const Gemm& g, const Unit& u) { return g.B + (size_t)u.pn * 256 * g.ldb * 2 + (size_t)u.z * g.zB; }

template <int NN, int NZ> struct Order {
    static constexpr int nM = M / BM, nN = NN, nwg = nM * nN, nz = NZ;
    int G, c, wave;
    __device__ void init(int G_, int c_, int wave_) { G = G_; c = c_; wave = wave_; }
    __device__ bool next(int i, Unit& u) const {
        const int t = i / NZ; u.z = i - t * NZ;
        const int L = t * G + c; if (L >= nwg) return false;
        static_assert(nwg % NXCD == 0 && nM % WGM == 0, "tile counts");
        int wgid = L; { constexpr int q = nwg / NXCD; const int xcd = wgid % NXCD, off = wgid / NXCD; wgid = xcd * q + off; }
        constexpr int nig = WGM * nN; const int gid = wgid / nig, fm = gid * WGM, w = wgid - gid * nig;
        u.pm = fm + (w % WGM); u.pn = w / WGM; return true;
    }
};

template <class Epi, bool ALIGN_EPI, class Sched>
__device__ __forceinline__ void gemm_phase(LAS unsigned char* lds, const Gemm g, const Sched& S, const Epi& E) {
    const int tid = opaque_tid(S.wave), wid = S.wave, lane = tid & 63, wr = wid >> 2, wc = wid & 3, fr = lane & 15, fq = lane >> 4;
    const int nt = g.K / BK;
    unsigned voffA[2], voffB[2];
#pragma unroll
    for (int i = 0; i < 2; ++i) { int R, C; stage_rc(tid * 16 + i * 8192, R, C); const int Rb = Epi::PERM ? ((R & ~31) + perm32(R & 31)) : R;
        voffA[i] = (unsigned)(R * g.lda + C) * 2u; voffB[i] = (unsigned)(Rb * g.ldb + C) * 2u; }
    const size_t kstep = (size_t)(BK * 2);
    const size_t hstepA = (size_t)HALF * g.lda * 2, hstepB = (size_t)HALF * g.ldb * 2;
    const unsigned ldsw = (unsigned)wid * 1024u; const unsigned ldsb = (unsigned)(size_t)lds;
    const int aoff = lds_byte(wr * 64 + fr, fq * 8), boff = lds_byte(wc * 32 + fr, fq * 8);
#define PG8_SA(b, h) (((b) * 2 + (h)) * HTB)
#define PG8_SB(b, h) ((4 + (b) * 2 + (h)) * HTB)
#define PG8_STAGE(bufoff, gbase, voff) do { _Pragma("unroll") for (int _i = 0; _i < 2; ++_i) \
        glds16s<0>(uni((const char*)(gbase)), (voff)[_i], (unsigned)__builtin_amdgcn_readfirstlane((int)(ldsb + (bufoff) + ldsw + _i * 8192))); } while (0)
#define PG8_LDA(dst, b, h) do { _Pragma("unroll") for (int m = 0; m < 4; ++m) _Pragma("unroll") for (int k = 0; k < 2; ++k) dst[m][k] = *(const LAS bf16x8*)(lds + PG8_SA(b, h) + aoff + m * 2048 + k * 512); } while (0)
#define PG8_LDB(dst, b, h) do { _Pragma("unroll") for (int n = 0; n < 2; ++n) _Pragma("unroll") for (int k = 0; k < 2; ++k) dst[n][k] = *(const LAS bf16x8*)(lds + PG8_SB(b, h) + boff + n * 2048 + k * 512); } while (0)
#define PG8_MMA(ai, bj, At, Bt) do { __builtin_amdgcn_s_setprio(1); _Pragma("unroll") for (int m = 0; m < 4; ++m) _Pragma("unroll") for (int n = 0; n < 2; ++n) _Pragma("unroll") for (int k = 0; k < 2; ++k) \
        acc[ai][bj][m][n] = __builtin_amdgcn_mfma_f32_16x16x32_bf16(Bt[n][k], At[m][k], acc[ai][bj][m][n], 0, 0, 0); __builtin_amdgcn_s_setprio(0); } while (0)
#define PG8_WAIT_V(n) asm volatile("s_waitcnt vmcnt(" #n ")" ::: "memory")
#define PG8_WAIT_VN(n) asm volatile("s_waitcnt vmcnt(%0)" :: "n"(n) : "memory")
#define PG8_WAIT_L(n) asm volatile("s_waitcnt lgkmcnt(" #n ")" ::: "memory")
#define PG8_BAR __builtin_amdgcn_s_barrier()
#define PG8_SCHED __builtin_amdgcn_sched_barrier(0)
    Unit cur, nxt; int ui = 0;
    if (!S.next(0, cur)) return;
    f32x4 acc[2][2][4][2];
    if constexpr (Epi::CINIT) E.cinit(acc, cur, wr, wc, fr, fq);
    else {
#pragma unroll
    for (int a = 0; a < 2; ++a)
#pragma unroll
        for (int b = 0; b < 2; ++b)
#pragma unroll
            for (int m = 0; m < 4; ++m)
#pragma unroll
                for (int n = 0; n < 2; ++n) acc[a][b][m][n] = (f32x4){0.f, 0.f, 0.f, 0.f};
    }
    bf16x8 At[4][2], B0[2][2], B1[2][2];
    LAS float* rsl = (LAS float*)(lds + 132096) + (wid * 16 + fr) * 8;
    int cpm = -1;
    const char* cA = a_base(g, cur); const char* cB = b_base(g, cur);
    PG8_STAGE(PG8_SB(0, 0), cB, voffB); PG8_STAGE(PG8_SB(0, 1), cB + hstepB, voffB); PG8_STAGE(PG8_SA(0, 0), cA, voffA); PG8_STAGE(PG8_SA(0, 1), cA + hstepA, voffA);
    if (wr == 1) PG8_BAR;
    PG8_WAIT_V(2); PG8_BAR;
    PG8_STAGE(PG8_SB(1, 0), cB + kstep, voffB); PG8_STAGE(PG8_SA(1, 0), cA + kstep, voffA); PG8_STAGE(PG8_SB(1, 1), cB + hstepB + kstep, voffB);
    if constexpr (Epi::NST > 0) PG8_STAGE(PG8_SA(1, 1), cA + kstep + hstepA, voffA);
    PG8_WAIT_V(0); PG8_BAR;
    for (;;) {
        const bool has_next = S.next(ui + 1, nxt);
        const char* nA = has_next ? a_base(g, nxt) : cA; const char* nB = has_next ? b_base(g, nxt) : cB;
#define PG8_ITER(t, W123, S1) do { \
            const bool last = ((t) == nt - 2); \
            const char* a1 = cA + (size_t)((t) + 1) * kstep; \
            const char* a2 = last ? nA : cA + (size_t)((t) + 2) * kstep; const char* b2 = last ? nB : cB + (size_t)((t) + 2) * kstep; \
            const char* a3 = a2 + kstep; const char* b3 = b2 + kstep; \
            PG8_LDB(B0, 0, 0); PG8_LDB(B1, 0, 1); PG8_SCHED; PG8_LDA(At, 0, 0); if (S1) PG8_STAGE(PG8_SA(1, 1), a1 + hstepA, voffA); \
            PG8_WAIT_VN(W123); PG8_WAIT_L(0); PG8_BAR; PG8_MMA(0, 0, At, B0); PG8_MMA(0, 1, At, B1); PG8_BAR; PG8_SCHED; \
            PG8_LDA(At, 0, 1); PG8_STAGE(PG8_SB(0, 0), b2, voffB); PG8_STAGE(PG8_SB(0, 1), b2 + hstepB, voffB); PG8_STAGE(PG8_SA(0, 0), a2, voffA); \
            PG8_WAIT_VN(W123); PG8_WAIT_L(0); PG8_BAR; PG8_MMA(1, 0, At, B0); PG8_MMA(1, 1, At, B1); PG8_BAR; PG8_SCHED; \
            PG8_LDB(B0, 1, 0); PG8_LDB(B1, 1, 1); PG8_SCHED; PG8_LDA(At, 1, 0); PG8_STAGE(PG8_SA(0, 1), a2 + hstepA, voffA); \
            PG8_WAIT_VN(W123); PG8_WAIT_L(0); PG8_BAR; PG8_MMA(0, 0, At, B0); PG8_MMA(0, 1, At, B1); PG8_BAR; PG8_SCHED; \
            PG8_LDA(At, 1, 1); PG8_STAGE(PG8_SB(1, 0), b3, voffB); PG8_STAGE(PG8_SB(1, 1), b3 + hstepB, voffB); PG8_STAGE(PG8_SA(1, 0), a3, voffA); \
            PG8_WAIT_V(8); PG8_WAIT_L(0); PG8_BAR; PG8_MMA(1, 0, At, B0); PG8_MMA(1, 1, At, B1); PG8_BAR; PG8_SCHED; \
        } while (0)
        if constexpr (Epi::NST > 0) { PG8_ITER(0, 8 + Epi::NST, false); for (int t = 2; t < nt; t += 2) PG8_ITER(t, 8, true); PG8_STAGE(PG8_SA(1, 1), nA + kstep + hstepA, voffA); }
        else { for (int t = 0; t < nt; t += 2) PG8_ITER(t, 8, true); }
#undef PG8_ITER
        if constexpr (ALIGN_EPI) { if (wr == 0) PG8_BAR; }
        if constexpr (Epi::RSTD) {
            if (cur.pm != cpm) { cpm = cur.pm; E.rs_fill(cur, wr, fr, fq, rsl); }
            float rs[2][4]; { const f32x4 a0 = *(const LAS f32x4*)rsl, a1 = *(const LAS f32x4*)(rsl + 4); rs[0][0] = a0[0]; rs[0][1] = a0[1]; rs[0][2] = a0[2]; rs[0][3] = a0[3]; rs[1][0] = a1[0]; rs[1][1] = a1[1]; rs[1][2] = a1[2]; rs[1][3] = a1[3]; }
            E(acc, cur, wr, wc, fr, fq, rs);
        } else { const int te_ = opaque_tid(S.wave), fre_ = te_ & 15, fqe_ = (te_ >> 4) & 3; float rs[2][4]; E(acc, cur, wr, wc, fre_, fqe_, rs); }
        if (!has_next) break;
        if constexpr (Epi::CINIT) { const int te_ = opaque_tid(S.wave), fre_ = te_ & 15, fqe_ = (te_ >> 4) & 3; E.cinit(acc, nxt, wr, wc, fre_, fqe_); }
        else {
#pragma unroll
        for (int a = 0; a < 2; ++a)
#pragma unroll
            for (int b = 0; b < 2; ++b)
#pragma unroll
                for (int m = 0; m < 4; ++m)
#pragma unroll
                    for (int n = 0; n < 2; ++n) acc[a][b][m][n] = (f32x4){0.f, 0.f, 0.f, 0.f};
        }
        cur = nxt; cA = nA; cB = nB; ++ui;
        if constexpr (ALIGN_EPI) { if (wr == 1) PG8_BAR; }
    }
    PG8_WAIT_V(0);
    if constexpr (!ALIGN_EPI) { if (wr == 0) PG8_BAR; }
    PG8_BAR;
#undef PG8_SA
#undef PG8_SB
#undef PG8_STAGE
#undef PG8_LDA
#undef PG8_LDB
#undef PG8_MMA
#undef PG8_WAIT_V
#undef PG8_WAIT_VN
#undef PG8_WAIT_L
#undef PG8_BAR
#undef PG8_SCHED
}

typedef f32x4 Acc[2][2][4][2];
__device__ __forceinline__ float row_rstd(const float* part, int row, int fq) {
    const f32x4 p = *(const f32x4*)(part + (size_t)row * 16 + 4 * fq);
    float s = (p[0] + p[1]) + (p[2] + p[3]);
    s = xadd<16>(s); s = xadd<32>(s);
    return __builtin_amdgcn_rsqf(s * (1.0f / DMODEL) + EPS);
}
__device__ __forceinline__ v4u pack8(const f32x4 a, const f32x4 b) { v4u w; w.x = pk2(a[0], a[1]); w.y = pk2(a[2], a[3]); w.z = pk2(b[0], b[1]); w.w = pk2(b[2], b[3]); return w; }

__device__ __forceinline__ void rstd_fill(const float* part, int row0, int fq, LAS float* rsl) {
#pragma unroll
    for (int i = 0; i < 8; i += 2) {
        const float r0 = row_rstd(part, row0 + (i >> 2) * HALF + (i & 3) * 16, fq), r1 = row_rstd(part, row0 + ((i + 1) >> 2) * HALF + ((i + 1) & 3) * 16, fq);
        if (fq == 0) { rsl[i] = r0; rsl[i + 1] = r1; }
        asm volatile("" ::: "memory");
    }
    asm volatile("s_waitcnt lgkmcnt(0)" ::: "memory");
}
__device__ __forceinline__ void rows_rstd(const float* part, int row0, int fq, float (&rs)[2][4]) {
#pragma unroll
    for (int ai = 0; ai < 2; ++ai)
#pragma unroll
        for (int m = 0; m < 4; ++m) rs[ai][m] = row_rstd(part, row0 + ai * HALF + m * 16, fq);
}
struct EpiSwiGLU {
    static constexpr bool PERM = true; static constexpr bool CINIT = false; static constexpr int NST = 8;
    bf16* H; const float* ssq;
    static constexpr bool RSTD = true;
    __device__ __forceinline__ void rs_fill(const Unit& u, int wr, int fr, int fq, LAS float* rsl) const { rstd_fill(ssq, u.pm * BM + wr * 64 + fr, fq, rsl); }
    __device__ __forceinline__ void operator()(const Acc& acc, const Unit& u, int wr, int wc, int fr, int fq, const float (&rsv)[2][4]) const {
        const int row0 = u.pm * BM + wr * 64 + fr, col0 = u.pn * 128 + wc * 32 + 8 * fq;
#pragma unroll
        for (int ai = 0; ai < 2; ++ai)
#pragma unroll
            for (int m = 0; m < 4; ++m) {
                const float rs = rsv[ai][m];
                f32x4 v0, v1;
#pragma unroll
                for (int j = 0; j < 4; ++j) { v0[j] = siluf_(acc[ai][0][m][0][j] * rs) * (acc[ai][1][m][0][j] * rs); v1[j] = siluf_(acc[ai][0][m][1][j] * rs) * (acc[ai][1][m][1][j] * rs); }
                *(v4u*)(H + (size_t)(row0 + ai * HALF + m * 16) * DFFP + col0) = pack8(v0, v1);
            }
    }
};
struct EpiResid {
    static constexpr bool PERM = true, RSTD = false, CINIT = true; static constexpr int NST = 0;
    bf16* xb; float scale, iscale; bool dry; float* ssq;
    __device__ __forceinline__ void cinit(Acc& acc, const Unit& u, int wr, int wc, int fr, int fq) const {
        const int row0 = u.pm * BM + wr * 64 + fr, col0 = u.pn * BM + wc * 32 + 8 * fq;
#pragma unroll
        for (int ai = 0; ai < 2; ++ai)
#pragma unroll
            for (int m = 0; m < 4; ++m) { const size_t off = (size_t)(row0 + ai * HALF + m * 16) * DMODEL + col0;
#pragma unroll
                for (int bj = 0; bj < 2; ++bj) { const v4u w = *(const v4u*)(xb + off + bj * HALF);
                    acc[ai][bj][m][0] = (f32x4){bflo(w.x), bfhi(w.x), bflo(w.y), bfhi(w.y)} * iscale; acc[ai][bj][m][1] = (f32x4){bflo(w.z), bfhi(w.z), bflo(w.w), bfhi(w.w)} * iscale; } }
    }
    __device__ __forceinline__ void operator()(const Acc& acc, const Unit& u, int wr, int wc, int fr, int fq, const float (&)[2][4]) const {
        const int row0 = u.pm * BM + wr * 64 + fr, col0 = u.pn * BM + wc * 32 + 8 * fq;
#pragma unroll
        for (int ai = 0; ai < 2; ++ai)
#pragma unroll
            for (int m = 0; m < 4; ++m) { const int row = row0 + ai * HALF + m * 16; const size_t off = (size_t)row * DMODEL + col0; float ss = 0.f;
#pragma unroll
                for (int bj = 0; bj < 2; ++bj) {
                    const f32x4 v0 = acc[ai][bj][m][0] * scale, v1 = acc[ai][bj][m][1] * scale;
                    ss += (v0[0] * v0[0] + v0[1] * v0[1]) + (v0[2] * v0[2] + v0[3] * v0[3]) + (v1[0] * v1[0] + v1[1] * v1[1]) + (v1[2] * v1[2] + v1[3] * v1[3]);
                    if (!dry) *(v4u*)(xb + off + bj * HALF) = pack8(v0, v1); }
                ss = xadd<16>(ss); ss = xadd<32>(ss);
                if (fq == 0 && !dry) ssq[(size_t)row * 16 + u.pn * 4 + wc] = ss; }
    }
};
struct EpiInProj {
    static constexpr bool PERM = true; static constexpr bool CINIT = false; static constexpr int NST = 16;
    bf16* P; const float* rope; const float* la_bias; const float* ssq;
    static constexpr bool RSTD = true;
    __device__ __forceinline__ void rs_fill(const Unit& u, int wr, int fr, int fq, LAS float* rsl) const { rstd_fill(ssq, u.pm * BM + wr * 64 + fr, fq, rsl); }
    __device__ __forceinline__ void operator()(const Acc& acc, const Unit& u, int wr, int wc, int fr, int fq, const float (&rsv)[2][4]) const {
        const int row0 = u.pm * BM + wr * 64 + fr; const int pn = u.pn;
        if (pn == 10 || pn == 11) {
            const float sc = (pn == 11) ? 0.125f : 1.0f;
#pragma unroll
            for (int ai = 0; ai < 2; ++ai)
#pragma unroll
                for (int m = 0; m < 4; ++m) { const int row = row0 + ai * HALF + m * 16; const int pos = row & (SEQ - 1); const float rs = rsv[ai][m] * sc;
                    const f32x4* cs = (const f32x4*)(rope + ((size_t)pos * 32 + 8 * fq) * 2);
                    f32x4 o1[2], o2[2];
#pragma unroll
                    for (int n = 0; n < 2; ++n) { const f32x4 c01 = cs[2 * n], c23 = cs[2 * n + 1];
                        const float co[4] = {c01[0], c01[2], c23[0], c23[2]}, si[4] = {c01[1], c01[3], c23[1], c23[3]};
#pragma unroll
                        for (int j = 0; j < 4; ++j) { const float t1 = acc[ai][0][m][n][j], t2 = acc[ai][1][m][n][j]; o1[n][j] = (t1 * co[j] - t2 * si[j]) * rs; o2[n][j] = (t1 * si[j] + t2 * co[j]) * rs; } }
                    bf16* rowp = P + (size_t)row * PJ + pn * BM + wc * 64 + 8 * fq;
                    *(v4u*)(rowp) = pack8(o1[0], o1[1]); *(v4u*)(rowp + 32) = pack8(o2[0], o2[1]); }
            return;
        }
        const int col0 = pn * BM + wc * 32 + 8 * fq;
        if (pn == 18) {
            f32x4 bv[2][2];
            int bo = wc * 32 + 8 * fq; asm volatile("" : "+v"(bo));
#pragma unroll
            for (int bj = 0; bj < 2; ++bj)
#pragma unroll
                for (int n = 0; n < 2; ++n) bv[bj][n] = *(const f32x4*)(la_bias + bo + bj * HALF + 4 * n);
#pragma unroll
            for (int ai = 0; ai < 2; ++ai)
#pragma unroll
                for (int m = 0; m < 4; ++m) { bf16* rowp = P + (size_t)(row0 + ai * HALF + m * 16) * PJ + col0; const float rs = rsv[ai][m];
#pragma unroll
                    for (int bj = 0; bj < 2; ++bj) { f32x4 v[2];
#pragma unroll
                        for (int n = 0; n < 2; ++n)
#pragma unroll
                            for (int j = 0; j < 4; ++j) { const float x = acc[ai][bj][m][n][j] * rs + bv[bj][n][j]; v[n][j] = (fminf(x, 0.f) - 0.6931471805599453f * __builtin_amdgcn_logf(1.0f + fast_exp2(-1.4426950408889634f * fabsf(x)))) * (1.0f / 16.0f); }
                        *(v4u*)(rowp + bj * HALF) = pack8(v[0], v[1]); } }
            return;
        }
        const bool silu = (pn >= 2 && pn <= 5);
        const float sc = (pn <= 1) ? C2 : (pn == 14 ? 0.125f : 1.0f);
#pragma unroll
        for (int ai = 0; ai < 2; ++ai)
#pragma unroll
            for (int m = 0; m < 4; ++m) { bf16* rowp = P + (size_t)(row0 + ai * HALF + m * 16) * PJ + col0; const float rs = rsv[ai][m] * sc;
#pragma unroll
                for (int bj = 0; bj < 2; ++bj) { f32x4 v0 = acc[ai][bj][m][0] * rs, v1 = acc[ai][bj][m][1] * rs;
                    if (silu) {
#pragma unroll
                        for (int j = 0; j < 4; ++j) { v0[j] = siluf_(v0[j]); v1[j] = siluf_(v1[j]); } }
                    *(v4u*)(rowp + bj * HALF) = pack8(v0, v1); } }
    }
};
struct EpiGates {
    static constexpr bool PERM = true; static constexpr bool CINIT = false; static constexpr int NST = 16;
    bf16* P; const float* ssq;
    static constexpr bool RSTD = true;
    __device__ __forceinline__ void rs_fill(const Unit& u, int wr, int fr, int fq, LAS float* rsl) const { rstd_fill(ssq, u.pm * BM + wr * 64 + fr, fq, rsl); }
    __device__ __forceinline__ void operator()(const Acc& acc, const Unit& u, int wr, int wc, int fr, int fq, const float (&rsv)[2][4]) const {
        const int row0 = u.pm * BM + wr * 64 + fr, col0 = C_GATE + u.pn * BM + wc * 32 + 8 * fq;
#pragma unroll
        for (int ai = 0; ai < 2; ++ai)
#pragma unroll
            for (int m = 0; m < 4; ++m) { bf16* rowp = P + (size_t)(row0 + ai * HALF + m * 16) * PJ + col0; const float rs = rsv[ai][m];
#pragma unroll
                for (int bj = 0; bj < 2; ++bj) { f32x4 v0, v1;
#pragma unroll
                    for (int j = 0; j < 4; ++j) { v0[j] = sigmoidf_(acc[ai][bj][m][0][j] * rs); v1[j] = sigmoidf_(acc[ai][bj][m][1][j] * rs); }
                    *(v4u*)(rowp + bj * HALF) = pack8(v0, v1); } }
    }
};
struct EpiMerge {
    static constexpr bool PERM = true; static constexpr bool CINIT = true; static constexpr int NST = 0;
    const bf16* P; bf16* O;
    static constexpr bool RSTD = false;
    template <bool INV> __device__ __forceinline__ void scale(Acc& acc, const Unit& u, int wr, int wc, int fr, int fq) const {
        const int row0 = u.pm * BM + wr * 64 + fr, gcol0 = C_GATE + u.z * DMODEL + u.pn * BM + wc * 32 + 8 * fq;
#pragma unroll
        for (int ai = 0; ai < 2; ++ai) {
            v4u gw[4][2];
#pragma unroll
            for (int m = 0; m < 4; ++m)
#pragma unroll
                for (int bj = 0; bj < 2; ++bj) gw[m][bj] = *(const v4u*)(P + (size_t)(row0 + ai * HALF + m * 16) * PJ + gcol0 + bj * HALF);
#pragma unroll
            for (int m = 0; m < 4; ++m)
#pragma unroll
                for (int bj = 0; bj < 2; ++bj) { const v4u g = gw[m][bj];
                    float gf[8] = {bflo(g.x), bfhi(g.x), bflo(g.y), bfhi(g.y), bflo(g.z), bfhi(g.z), bflo(g.w), bfhi(g.w)};
                    if constexpr (INV) {
#pragma unroll
                        for (int j = 0; j < 8; ++j) gf[j] = __builtin_amdgcn_rcpf(fmaxf(gf[j], 1e-30f)); }
#pragma unroll
                    for (int j = 0; j < 4; ++j) { acc[ai][bj][m][0][j] *= gf[j]; acc[ai][bj][m][1][j] *= gf[4 + j]; } }
            __builtin_amdgcn_sched_barrier(0);
        }
    }
    __device__ __forceinline__ void cinit(Acc& acc, const Unit& u, int wr, int wc, int fr, int fq) const {
        if (u.z == 0) {
#pragma unroll
            for (int a = 0; a < 2; ++a)
#pragma unroll
                for (int b = 0; b < 2; ++b)
#pragma unroll
                    for (int m = 0; m < 4; ++m)
#pragma unroll
                        for (int n = 0; n < 2; ++n) acc[a][b][m][n] = (f32x4){0.f, 0.f, 0.f, 0.f};
        } else {
            const int row0 = u.pm * BM + wr * 64 + fr, gcol1 = C_GATE + u.z * DMODEL + u.pn * BM + wc * 32 + 8 * fq, gcol0 = gcol1 - DMODEL;
#pragma unroll
            for (int ai = 0; ai < 2; ++ai) {
                v4u gp[4][2], gc[4][2];
#pragma unroll
                for (int m = 0; m < 4; ++m)
#pragma unroll
                    for (int bj = 0; bj < 2; ++bj) { const size_t ro = (size_t)(row0 + ai * HALF + m * 16) * PJ + bj * HALF; gp[m][bj] = *(const v4u*)(P + ro + gcol0); gc[m][bj] = *(const v4u*)(P + ro + gcol1); }
#pragma unroll
                for (int m = 0; m < 4; ++m)
#pragma unroll
                    for (int bj = 0; bj < 2; ++bj) { const v4u p = gp[m][bj], c = gc[m][bj];
                        const float pf[8] = {bflo(p.x), bfhi(p.x), bflo(p.y), bfhi(p.y), bflo(p.z), bfhi(p.z), bflo(p.w), bfhi(p.w)};
                        const float cf[8] = {bflo(c.x), bfhi(c.x), bflo(c.y), bfhi(c.y), bflo(c.z), bfhi(c.z), bflo(c.w), bfhi(c.w)};
#pragma unroll
                        for (int j = 0; j < 4; ++j) { acc[ai][bj][m][0][j] *= pf[j] * __builtin_amdgcn_rcpf(fmaxf(cf[j], 1e-30f)); acc[ai][bj][m][1][j] *= pf[4 + j] * __builtin_amdgcn_rcpf(fmaxf(cf[4 + j], 1e-30f)); } }
                __builtin_amdgcn_sched_barrier(0);
            }
        }
    }
    __device__ __forceinline__ void operator()(Acc& acc, const Unit& u, int wr, int wc, int fr, int fq, const float (&)[2][4]) const {
        if (u.z < 2) return;
        scale<false>(acc, u, wr, wc, fr, fq);
        const int row0 = u.pm * BM + wr * 64 + fr, col0 = u.pn * BM + wc * 32 + 8 * fq;
#pragma unroll
        for (int ai = 0; ai < 2; ++ai)
#pragma unroll
            for (int m = 0; m < 4; ++m)
#pragma unroll
                for (int bj = 0; bj < 2; ++bj) *(v4u*)(O + (size_t)(row0 + ai * HALF + m * 16) * DMODEL + col0 + bj * HALF) = pack8(acc[ai][bj][m][0], acc[ai][bj][m][1]);
    }
};
}

#define XB_TMO      128
#define XB_XCNT(j)  (256  + 64 * (j))
#define XB_XSUB(j)  (1280 + 64 * (j))
#define XB_XGEN(j)  (2304 + 64 * (j))
#define XB_TOP      3328
#define XB_TOPGEN   3392
#define XCD_BAR_WORDS 3456
#define XB_SPIN_CAP (1u << 23)
__device__ __forceinline__ unsigned xb_ld(unsigned* p)              { return __hip_atomic_load(p, __ATOMIC_RELAXED, __HIP_MEMORY_SCOPE_AGENT); }
__device__ __forceinline__ unsigned xb_add(unsigned* p, unsigned v) { return __hip_atomic_fetch_add(p, v, __ATOMIC_RELAXED, __HIP_MEMORY_SCOPE_AGENT); }
__device__ __forceinline__ unsigned xb_xcc_id() { return (unsigned)__builtin_amdgcn_s_getreg((3 << 11) | 20) & 0xFu; }
#define XB_SPIN(cond, bar) do { unsigned _sp = 0; while (cond) { __builtin_amdgcn_s_sleep(1); \
    if ((++_sp & 255u) == 0u) { if (xb_ld(&(bar)[XB_TMO])) break; if (_sp > XB_SPIN_CAP) { atomicAdd(&(bar)[XB_TMO], 1u); break; } } } } while (0)
struct XcdBarrier { unsigned* bar; unsigned x; volatile LAS unsigned* st; };
__device__ __forceinline__ XcdBarrier xcd_barrier_post(unsigned* bar, volatile LAS unsigned* st) {
    XcdBarrier b; b.bar = bar; b.x = xb_xcc_id(); b.st = st;
    if (threadIdx.x == 0) (void)xb_add(&bar[XB_XCNT(b.x)], 1u);
    return b;
}
__device__ __forceinline__ void xcd_barrier_complete(unsigned* bar, unsigned x, unsigned& nloc, unsigned& nx) {
    const unsigned G = gridDim.x * gridDim.y * gridDim.z;
    unsigned sum, cnt, mine, sp = 0u;
    for (;;) {
        sum = 0u; cnt = 0u; mine = 0u;
#pragma unroll
        for (unsigned j = 0; j < 16; ++j) { const unsigned c = xb_ld(&bar[XB_XCNT(j)]); sum += c; cnt += (c > 0u) ? 1u : 0u; mine = (j == x) ? c : mine; }
        if (sum == G) break;
        __builtin_amdgcn_s_sleep(1);
        if ((++sp & 255u) == 0u) { if (xb_ld(&bar[XB_TMO])) break; if (sp > XB_SPIN_CAP) { atomicAdd(&bar[XB_TMO], 1u); break; } }
    }
    nloc = mine > 0u ? mine : 1u; nx = cnt > 0u ? cnt : 1u;
}
__device__ __forceinline__ void xcd_barrier(const XcdBarrier& b) {
    asm volatile("s_waitcnt vmcnt(0)" ::: "memory");
    __syncthreads();
    if (threadIdx.x == 0) {
        unsigned* bar = b.bar;
        __builtin_amdgcn_s_waitcnt(0);
        unsigned nloc = b.st[0], nx = b.st[1];
        if (nloc == 0u) { xcd_barrier_complete(bar, b.x, nloc, nx); b.st[0] = nloc; b.st[1] = nx; }
        const unsigned old = xb_add(&bar[XB_XSUB(b.x)], 1u);
        const unsigned gen = old / nloc;
        if (old + 1u == (gen + 1u) * nloc) {
            __builtin_amdgcn_fence(__ATOMIC_RELEASE, "agent");
            asm volatile("s_waitcnt vmcnt(0)" ::: "memory");
            const unsigned og = xb_add(&bar[XB_TOP], 1u);
            const unsigned tg = og / nx;
            if (og + 1u == (tg + 1u) * nx) xb_add(&bar[XB_TOPGEN], 1u);
            else XB_SPIN(xb_ld(&bar[XB_TOPGEN]) == tg, bar);
            __builtin_amdgcn_fence(__ATOMIC_ACQUIRE, "agent");
            xb_add(&bar[XB_XGEN(b.x)], 1u);
            asm volatile("s_waitcnt vmcnt(0)" ::: "memory");
        } else {
            XB_SPIN(xb_ld(&bar[XB_XGEN(b.x)]) == gen, bar);
            __builtin_amdgcn_fence(__ATOMIC_ACQUIRE, "agent");
            asm volatile("s_waitcnt vmcnt(0)" ::: "memory");
        }
    }
    __syncthreads();
}

struct Args {
    const float* x; const float* ffn1_norm; const float* ffn1_w1; const float* ffn1_w3; const float* ffn1_w2; const float* mix_norm; const float* w_in; const float* lam_qk;
    const float* da_norm; const float* ret_norm; const float* gla_a2; const float* gla_ab; const float* gla_norm; const float* wb_a; const float* wb_b; const float* wb_c; const float* w_out;
    const float* ffn2_norm; const float* ffn2_w1; const float* ffn2_w3; const float* ffn2_w2; const float* final_norm;
    float* out; unsigned char* ws; int ph_lo, ph_hi;
};
struct Frame { LAS unsigned char* lds; unsigned char* ws; int vcu, G, wave; };

__device__ __constant__ float LAM_INIT[4] = {0.2f, 0.35550906759f, 0.47071301834f, 0.55605820416f};

__device__ __forceinline__ void conv_tr(const float* src, int ldsrc, bf16* dst, int lddst, LAS float* scr, int lane, bool zero, const float* gain = nullptr) {
    if (zero) {
        const int c = lane & 7;
#pragma unroll
        for (int j = 0; j < 4; ++j) { const int n = (lane >> 3) + 8 * j; *(v4u*)(dst + (size_t)n * lddst + 8 * c) = (v4u){0u, 0u, 0u, 0u}; }
        return;
    }
    const int n4 = lane & 7, kg = lane >> 3;
    f32x4 tv[8];
#pragma unroll
    for (int j = 0; j < 8; ++j) tv[j] = *(const f32x4*)(src + (size_t)(8 * kg + j) * ldsrc + 4 * n4);
    if (gain) { const f32x4 g0 = *(const f32x4*)(gain + 8 * kg), g1 = *(const f32x4*)(gain + 8 * kg + 4);
#pragma unroll
        for (int j = 0; j < 4; ++j) { tv[j] = tv[j] * g0[j]; tv[4 + j] = tv[4 + j] * g1[j]; } }
#pragma unroll
    for (int i = 0; i < 4; ++i) { v4u o; o.x = pk2(tv[0][i], tv[1][i]); o.y = pk2(tv[2][i], tv[3][i]); o.z = pk2(tv[4][i], tv[5][i]); o.w = pk2(tv[6][i], tv[7][i]);
        *(v4u*)(dst + (size_t)(4 * n4 + i) * lddst + 8 * kg) = o; }
    (void)scr;
}
__device__ __forceinline__ int inproj_src_col(int g) {
    const int c = 32 * g;
    if (c < 512) return O_AQ + c;
    if (c < 1024) return O_RG + (c - 512);
    if (c < 1536) return O_CG + (c - 1024);
    if (c < 2048) return O_AK + (c - 1536);
    if (c < 2560) return O_AV + (c - 2048);
    if (c < 3072) { const int base = (c < 2816) ? O_RQ : O_RK; const int cc = (c < 2816) ? c - 2560 : c - 2816; const int half = cc >> 7, head = (cc & 127) >> 5; return base + head * 64 + 32 * half; }
    if (c < 3584) return O_RV + (c - 3072);
    if (c < 3840) return O_CQ + (c - 3584);
    if (c < 4096) return O_CK + (c - 3840);
    return O_CV + (c - 4096);
}
constexpr int I_W13 = 16 * 176, I_W2 = 44 * 32, I_WIN = 16 * 144, I_WG = 16 * 96, I_WB = 8 * 32, I_WO = 16 * 32, I_LA = 16 * 8;
constexpr int I_TOTAL = 2 * (I_W13 + I_W2) + I_WIN + I_WG + 3 * I_WB + I_WO + I_LA;

__device__ __forceinline__ void conv_w13(const float* w1, const float* w3, bf16* dst, int r, LAS float* scr, int lane, const float* gain) {
    const int kb = r / 176, g = r % 176, pn = g >> 3, half = (g >> 2) & 1, jj = g & 3, hc0 = pn * 128 + jj * 32;
    const float* src = (half ? w3 : w1) + (size_t)(64 * kb) * DFF + hc0;
    conv_tr(src, DFF, dst + (size_t)(32 * g) * DMODEL + 64 * kb, DMODEL, scr, lane, hc0 >= DFF, gain + 64 * kb);
}
__device__ __forceinline__ void conv_w2(const float* w2, bf16* dst, int r, LAS float* scr, int lane) {
    const int kb = r / 32, nb = r % 32;
    conv_tr(w2 + (size_t)(64 * kb) * DMODEL + 32 * nb, DMODEL, dst + (size_t)(32 * nb) * DFFP + 64 * kb, DFFP, scr, lane, kb >= 43);
}

struct ConvJob { const float* src; const float* gain; bf16* dst; int ldsrc, lddst, kind; };
__device__ __forceinline__ ConvJob conv_job(const Args& a, unsigned char* wd, int l, int it) {
    ConvJob j; j.src = nullptr; j.gain = nullptr; j.dst = nullptr; j.ldsrc = 0; j.lddst = 0; j.kind = 0;
    if (it < 0 || it >= I_TOTAL - I_LA) return j;
    const float* win = uni(a.w_in) + (size_t)l * DMODEL * INC;
    const float* gm = uni(a.mix_norm) + l * DMODEL;
    int r = it;
    if (r < I_W13 || (r >= I_W13 + I_W2 && r < 2 * I_W13 + I_W2)) { const bool second = r >= I_W13; if (second) r -= I_W13 + I_W2;
        const int kb = r / 176, g = r % 176, pn = g >> 3, half = (g >> 2) & 1, jj = g & 3, hc0 = pn * 128 + jj * 32;
        const float* w1 = uni(second ? a.ffn2_w1 : a.ffn1_w1) + (size_t)l * DMODEL * DFF; const float* w3 = uni(second ? a.ffn2_w3 : a.ffn1_w3) + (size_t)l * DMODEL * DFF;
        j.src = (half ? w3 : w1) + (size_t)(64 * kb) * DFF + hc0; j.ldsrc = DFF; j.dst = (bf16*)(wd + (second ? W_13B : W_13A)) + (size_t)(32 * g) * DMODEL + 64 * kb; j.lddst = DMODEL;
        j.gain = uni(second ? a.ffn2_norm : a.ffn1_norm) + l * DMODEL + 64 * kb; j.kind = (hc0 >= DFF) ? 2 : 1; return j; }
    r -= I_W13;
    if (r < I_W2 || (r >= I_W2 + I_W13 && r < 2 * I_W2 + I_W13)) { const bool second = r >= I_W2; if (second) r -= I_W2 + I_W13;
        const int kb = r / 32, nb = r % 32; const float* w2 = uni(second ? a.ffn2_w2 : a.ffn1_w2) + (size_t)l * DFF * DMODEL;
        j.src = w2 + (size_t)(64 * kb) * DMODEL + 32 * nb; j.ldsrc = DMODEL; j.dst = (bf16*)(wd + (second ? W_2B : W_2A)) + (size_t)(32 * nb) * DFFP + 64 * kb; j.lddst = DFFP; j.kind = (kb >= 43) ? 2 : 1; return j; }
    r -= I_W2 + I_W13 + I_W2;
    if (r < I_WIN) { const int kb = r / 144, g = r % 144;
        j.src = win + (size_t)(64 * kb) * INC + inproj_src_col(g); j.ldsrc = INC; j.dst = (bf16*)(wd + W_IN) + (size_t)(32 * g) * DMODEL + 64 * kb; j.lddst = DMODEL; j.gain = gm + 64 * kb; j.kind = 1; return j; }
    r -= I_WIN;
    if (r < I_WG) { const int kb = r / 96, g = r % 96;
        j.src = win + (size_t)(64 * kb) * INC + O_GATE + 32 * g; j.ldsrc = INC; j.dst = (bf16*)(wd + W_G) + (size_t)(32 * g) * DMODEL + 64 * kb; j.lddst = DMODEL; j.gain = gm + 64 * kb; j.kind = 1; return j; }
    r -= I_WG;
    if (r < 3 * I_WB) { const int z = r / I_WB, rr = r % I_WB, kb = rr / 32, nb = rr % 32;
        const float* wb = uni(z == 0 ? a.wb_a : (z == 1 ? a.wb_b : a.wb_c)) + (size_t)l * 512 * DMODEL;
        j.src = wb + (size_t)(64 * kb) * DMODEL + 32 * nb; j.ldsrc = DMODEL; j.dst = (bf16*)(wd + W_B) + (size_t)z * DMODEL * 512 + (size_t)(32 * nb) * 512 + 64 * kb; j.lddst = 512; j.kind = 1; return j; }
    r -= 3 * I_WB;
    { const int kb = r / 32, nb = r % 32;
      j.src = uni(a.w_out) + (size_t)l * DMODEL * DMODEL + (size_t)(64 * kb) * DMODEL + 32 * nb; j.ldsrc = DMODEL; j.dst = (bf16*)(wd + W_O) + (size_t)(32 * nb) * DMODEL + 64 * kb; j.lddst = DMODEL; j.kind = 1; }
    return j;
}
__device__ __forceinline__ void conv_load(const ConvJob& j, int lane, f32x4 (&tv)[8]) {
    if (j.kind == 1) { const int n4 = lane & 7, kg = lane >> 3;
#pragma unroll
        for (int q = 0; q < 8; ++q) tv[q] = *(const f32x4*)(j.src + (size_t)(8 * kg + q) * j.ldsrc + 4 * n4); }
}
__device__ __forceinline__ void conv_store(const ConvJob& j, int lane, f32x4 (&tv)[8]) {
    if (j.kind == 0) return;
    const int n4 = lane & 7, kg = lane >> 3;
    if (j.kind == 2) {
#pragma unroll
        for (int i = 0; i < 4; ++i) *(v4u*)(j.dst + (size_t)(4 * n4 + i) * j.lddst + 8 * kg) = (v4u){0u, 0u, 0u, 0u};
        return; }
    if (j.gain) { const f32x4 g0 = *(const f32x4*)(j.gain + 8 * kg), g1 = *(const f32x4*)(j.gain + 8 * kg + 4);
#pragma unroll
        for (int q = 0; q < 4; ++q) { tv[q] = tv[q] * g0[q]; tv[4 + q] = tv[4 + q] * g1[q]; } }
#pragma unroll
    for (int i = 0; i < 4; ++i) { v4u o; o.x = pk2(tv[0][i], tv[1][i]); o.y = pk2(tv[2][i], tv[3][i]); o.z = pk2(tv[4][i], tv[5][i]); o.w = pk2(tv[6][i], tv[7][i]);
        *(v4u*)(j.dst + (size_t)(4 * n4 + i) * j.lddst + 8 * kg) = o; }
}
__device__ __forceinline__ void conv_item(const Args& a, unsigned char* wd, int l, int it, int lane) {
    const ConvJob j = conv_job(a, wd, l, it); f32x4 tv[8]; conv_load(j, lane, tv); conv_store(j, lane, tv);
}
__device__ __forceinline__ void conv_la_item(const Args& a, unsigned char* wd, int l, int r, int lane) {
    const float* win = uni(a.w_in) + (size_t)l * DMODEL * INC;
    const float* gm = uni(a.mix_norm) + l * DMODEL;
    const int kb = r / 8, cb = r % 8, c8 = lane & 7; const float* a2 = uni(a.gla_a2) + (size_t)l * 16 * 256;
    const float* wrow = win + (size_t)(64 * kb + 8 * c8) * INC + O_CA;
#pragma unroll 1
    for (int j = 0; j < 4; ++j) { const int c = 32 * cb + (lane >> 3) + 8 * j;
        float av[16];
#pragma unroll
        for (int t = 0; t < 16; ++t) av[t] = a2[t * 256 + c];
        float o[8];
#pragma unroll
        for (int q = 0; q < 8; ++q) {
            float acc = 0.f;
#pragma unroll
            for (int t4 = 0; t4 < 4; ++t4) { const f32x4 w4 = *(const f32x4*)(wrow + (size_t)q * INC + 4 * t4);
                acc += (w4[0] * av[4 * t4] + w4[1] * av[4 * t4 + 1]) + (w4[2] * av[4 * t4 + 2] + w4[3] * av[4 * t4 + 3]); }
            o[q] = acc * gm[64 * kb + 8 * c8 + q]; }
        v4u w; w.x = pk2(o[0], o[1]); w.y = pk2(o[2], o[3]); w.z = pk2(o[4], o[5]); w.w = pk2(o[6], o[7]);
        *(v4u*)((bf16*)(wd + W_IN) + (size_t)(C_LA + c) * DMODEL + 64 * kb + 8 * c8) = w; }
}
__device__ __forceinline__ void conv_lam(const Args& a, unsigned char* ws, int l, int lane) {
    const float* lq = uni(a.lam_qk) + (size_t)l * 256;
    const float s1 = wave_sum(lq[lane] * lq[64 + lane]), s2 = wave_sum(lq[128 + lane] * lq[192 + lane]);
    if (lane == 0) ((float*)(ws + WS_LAM))[l] = __expf(s1) - __expf(s2) + LAM_INIT[l];
}
__device__ __forceinline__ void phase_conv(const Args& a, const Frame& F, int l, unsigned char* wd) {
    const int tid = opaque_tid(F.wave), lane = tid & 63, wave = F.wave;
    const int gw = F.vcu * 8 + wave, NGW = F.G * 8;
    for (int it = gw; it < I_TOTAL - I_LA; it += NGW) conv_item(a, wd, l, it, lane);
    for (int r = gw; r < I_LA; r += NGW) conv_la_item(a, wd, l, r, lane);
    if (gw == 0) conv_lam(a, F.ws, l, lane);
}

__device__ __forceinline__ void phase_rope(const Frame& F) {
    const int tid = opaque_tid(F.wave);
    float* rt = (float*)(F.ws + WS_ROPE);
    for (int idx = F.vcu * 512 + tid; idx < SEQ * 32; idx += F.G * 512) {
        const int pos = idx >> 5, i = idx & 31;
        const float inv = exp2f(-(float)i * (13.287712379549449f / 32.0f));
        const float ang = (float)pos * inv;
        double rev = (double)ang * 0.15915494309189535; rev -= floor(rev);
        const float rf = (float)rev;
        rt[2 * idx] = __builtin_amdgcn_cosf(rf); rt[2 * idx + 1] = __builtin_amdgcn_sinf(rf);
    }
}
__device__ __forceinline__ void phase_prep(const Frame& F, const float* x, bf16* xb, float* ssq) {
    const int tid = opaque_tid(F.wave), lane = tid & 63, wave = F.wave;
    const int gw = F.vcu * 8 + wave, NGW = F.G * 8;
    for (int m = gw; m < M; m += NGW) {
        const f32x4* xr = (const f32x4*)(x + (size_t)m * DMODEL) + lane;
        f32x4 v[4]; float s = 0.f;
#pragma unroll
        for (int j = 0; j < 4; ++j) { v[j] = xr[64 * j]; s += (v[j][0] * v[j][0] + v[j][1] * v[j][1]) + (v[j][2] * v[j][2] + v[j][3] * v[j][3]); }
        s = wave_sum(s);
        v2u* o8 = (v2u*)(xb + (size_t)m * DMODEL) + lane;
#pragma unroll
        for (int j = 0; j < 4; ++j) { v2u w; w.x = pk2(v[j][0], v[j][1]); w.y = pk2(v[j][2], v[j][3]); o8[64 * j] = w; }
        if (lane < 16) ssq[(size_t)m * 16 + lane] = (lane == 0) ? s : 0.f;
    }
}
__device__ __forceinline__ void phase_final_norm(const Frame& F, const bf16* xb, float* out, const float* gain, const float* ssq) {
    const int tid = opaque_tid(F.wave), lane = tid & 63, wave = F.wave;
    const int gw = F.vcu * 8 + wave, NGW = F.G * 8;
    f32x4 g[4];
#pragma unroll
    for (int j = 0; j < 4; ++j) g[j] = *((const f32x4*)gain + lane + 64 * j);
    for (int m = gw; m < M; m += NGW) {
        const v2u* xr = (const v2u*)(xb + (size_t)m * DMODEL) + lane; f32x4* orow = (f32x4*)(out + (size_t)m * DMODEL) + lane;
        float sq = ssq[(size_t)m * 16 + (lane & 15)];
        sq = xadd<1>(sq); sq = xadd<2>(sq); sq = xadd<4>(sq); sq = xadd<8>(sq);
        const float rstd = __builtin_amdgcn_rsqf(sq * (1.0f / DMODEL) + EPS);
#pragma unroll
        for (int j = 0; j < 4; ++j) { const v2u w = xr[64 * j]; orow[64 * j] = (f32x4){bflo(w.x), bfhi(w.x), bflo(w.y), bfhi(w.y)} * rstd * g[j]; }
    }
}

__device__ __forceinline__ float ret_logg(int h) { return h == 0 ? -0.031748698314580301f : (h == 1 ? -0.015748356968139168f : (h == 2 ? -0.0078431774610258928f : -0.0039138993211363287f)); }

__device__ __forceinline__ void chunk_cum(LAS float* cum, LAS float* tot, const bf16* prow, int mix, int h, int tid) {
    const int d = tid & 63, seg = tid >> 6;
    if (mix == 0) {
        const float lg = ret_logg(h);
#pragma unroll
        for (int x = 0; x < 8; ++x) { const int t = seg * 8 + x; cum[t * 64 + d] = (float)(t + 1) * lg; }
        __syncthreads(); __syncthreads();
        return;
    }
    float run = 0.f;
#pragma unroll
    for (int x = 0; x < 8; ++x) { const int t = seg * 8 + x; run += bf2f(prow[(size_t)t * PJ + C_LA + h * 64 + d]); cum[t * 64 + d] = run; }
    tot[seg * 64 + d] = run;
    __syncthreads();
    float off = 0.f;
    for (int s = 0; s < seg; ++s) off += tot[s * 64 + d];
#pragma unroll
    for (int x = 0; x < 8; ++x) { const int t = seg * 8 + x; cum[t * 64 + d] += off; }
    __syncthreads();
}

__device__ __forceinline__ void phase_r2(const Args& a, const Frame& F) {
    unsigned char* ws = F.ws; unsigned* ST = (unsigned*)(ws + WS_ST); const float* DEC = (const float*)(ws + WS_DEC);
    const int tid = opaque_tid(F.wave);
    for (int gt = F.vcu * 512 + tid; gt < 32 * 4096; gt += F.G * 512) {
        const int w = gt & 4095, seq = gt >> 12, mix = seq >> 4, bh = seq & 15, h = bh & 3, d0 = (2 * w) & 63;
        unsigned* p = ST + (size_t)seq * 128 * 4096 + w;
        const float* dp = DEC + (size_t)bh * 128 * 64 + d0;
        float s0 = 0.f, s1 = 0.f;
        const float cret = __expf(64.0f * ret_logg(h));
        unsigned ua[8], ub[8]; f32x2 da[8], db[8];
#define R2_LOAD(uu, dd, n0_) do { _Pragma("unroll") for (int i = 0; i < 8; ++i) { uu[i] = p[(size_t)((n0_) + i) * 4096]; dd[i] = mix ? *(const f32x2*)(dp + (size_t)((n0_) + i) * 64) : (f32x2){cret, cret}; } } while (0)
#define R2_SCAN(uu, dd, n0_) do { _Pragma("unroll") for (int i = 0; i < 8; ++i) { p[(size_t)((n0_) + i) * 4096] = pk2(s0, s1); s0 = s0 * dd[i][0] + bflo(uu[i]); s1 = s1 * dd[i][1] + bfhi(uu[i]); } } while (0)
        R2_LOAD(ua, da, 0);
        for (int n0 = 0; n0 < 128; n0 += 16) {
            R2_LOAD(ub, db, n0 + 8);
            R2_SCAN(ua, da, n0);
            if (n0 + 16 < 128) R2_LOAD(ua, da, n0 + 16);
            R2_SCAN(ub, db, n0 + 8);
        }
#undef R2_LOAD
#undef R2_SCAN
    }
}

namespace lin {
typedef float f32x16 __attribute__((ext_vector_type(16)));
typedef short v4i16_t __attribute__((ext_vector_type(4)));
constexpr int L_V = 0, L_S = 16384, L_QE = 32768, L_KE = 40960, L_KD = 40960, L_CUM = 49152, L_TOT = 65536, L_OB = 67584, OB_LD = 132, L_SIN = 101376, L_QE2 = 117760;
__device__ __forceinline__ int crow(int r, int hi) { return (r & 3) + 8 * (r >> 2) + 4 * hi; }
__device__ __forceinline__ bf16x8 trfrag(const LAS unsigned char* p) {
    const v4i16_t lo = __builtin_amdgcn_ds_read_tr16_b64_v4i16((LAS v4i16_t*)(p)), hh = __builtin_amdgcn_ds_read_tr16_b64_v4i16((LAS v4i16_t*)(p + 512));
    return (bf16x8){lo[0], lo[1], lo[2], lo[3], hh[0], hh[1], hh[2], hh[3]};
}
__device__ __forceinline__ void unpack8(const v4u w, float (&f)[8]) { f[0] = bflo(w.x); f[1] = bfhi(w.x); f[2] = bflo(w.y); f[3] = bfhi(w.y); f[4] = bflo(w.z); f[5] = bfhi(w.z); f[6] = bflo(w.w); f[7] = bfhi(w.w); }
__device__ __forceinline__ v4u pack8f(const float (&f)[8]) { v4u w; w.x = pk2(f[0], f[1]); w.y = pk2(f[2], f[3]); w.z = pk2(f[4], f[5]); w.w = pk2(f[6], f[7]); return w; }
__device__ __forceinline__ void dma_v(LAS unsigned char* lds, const bf16* vbase, int wid, int lane) {
    const bf16* vsrc = vbase + (size_t)(16 * (wid & 3) + (lane >> 2)) * PJ + (wid >> 2) * 32 + (lane & 3) * 8;
    __builtin_amdgcn_global_load_lds((const unsigned*)(vsrc), (LAS unsigned*)(lds + L_V + wid * 1024), 16, 0, 0);
    __builtin_amdgcn_global_load_lds((const unsigned*)(vsrc + 64), (LAS unsigned*)(lds + L_V + wid * 1024 + 8192), 16, 0, 0);
}
}

struct RFetch { v4u qw, kw, g0, g1; f32x4 pn0, pn1; unsigned short la[8]; };
__device__ __forceinline__ void chunk_cum_regs(LAS float* cum, LAS float* tot, const unsigned short (&la)[8], int mix, int h, int tid) {
    const int d = tid & 63, seg = tid >> 6;
    if (mix == 0) {
        const float lg = ret_logg(h);
#pragma unroll
        for (int x = 0; x < 8; ++x) { const int t = seg * 8 + x; cum[t * 64 + d] = (float)(t + 1) * lg; }
        __syncthreads(); __syncthreads();
        return;
    }
    float run = 0.f;
#pragma unroll
    for (int x = 0; x < 8; ++x) { const int t = seg * 8 + x; run += bf2f(la[x]); cum[t * 64 + d] = run; }
    tot[seg * 64 + d] = run;
    __syncthreads();
    float off = 0.f;
    for (int s = 0; s < seg; ++s) off += tot[s * 64 + d];
#pragma unroll
    for (int x = 0; x < 8; ++x) { const int t = seg * 8 + x; cum[t * 64 + d] += off; }
    __syncthreads();
}

__device__ __forceinline__ void phase_r1_mfma(const Args& a, const Frame& F) {
    using namespace lin;
    unsigned char* ws = F.ws; const bf16* proj = (const bf16*)(ws + WS_BIG); bf16* ST = (bf16*)(ws + WS_ST); float* DEC = (float*)(ws + WS_DEC);
    bf16* TOT = (bf16*)(ws + WS_TOT); float* DR = (float*)(ws + WS_DR);
    const int tid = opaque_tid(F.wave), lane = tid & 63, wid = F.wave, r32 = lane & 31, hi = lane >> 5;
    LAS unsigned char* lds = F.lds; LAS float* cum = (LAS float*)(lds + L_CUM); LAS float* tot = (LAS float*)(lds + L_TOT);
    const int t = tid >> 3, c = tid & 7;
    const int eb = wid >> 1, db = wid & 1, dcol = 32 * db + r32;
#define R1_FETCH(u_, f_) do { const int mix_ = (u_) >> 11, bh_ = ((u_) >> 7) & 15, n_ = (u_) & 127, h_ = bh_ & 3; \
        const bf16* prow_ = proj + (size_t)((bh_ >> 2) * SEQ + n_ * 64) * PJ; \
        f_.kw = *(const v4u*)(prow_ + (size_t)t * PJ + (mix_ ? C_CK : C_RK) + h_ * 64 + 8 * c); \
        if (mix_) { _Pragma("unroll") for (int x = 0; x < 8; ++x) f_.la[x] = prow_[(size_t)((tid >> 6) * 8 + x) * PJ + C_LA + h_ * 64 + (tid & 63)]; } \
        dma_v(lds, prow_ + (mix_ ? C_CV : C_RV) + h_ * 128, wid, lane); } while (0)
    RFetch cur; cur.qw = cur.g0 = cur.g1 = (v4u){0u, 0u, 0u, 0u};
    int v = F.vcu;
    if (v < 256) R1_FETCH(v * 16, cur);
    for (; v < 256; v += F.G) {
        const int sq = v >> 3, run = v & 7, mix = sq >> 4, bh = sq & 15, h = bh & 3;
        const float cret = __expf(64.0f * ret_logg(h));
        f32x16 state; float pst = 1.0f;
#pragma unroll
        for (int r = 0; r < 16; ++r) state[r] = 0.f;
#pragma unroll 1
        for (int i = 0; i < 16; ++i) {
            const int u = v * 16 + i, n = run * 16 + i;
            chunk_cum_regs(cum, tot, cur.la, mix, h, tid);
            float kf[8]; unpack8(cur.kw, kf);
            { const f32x4 c0 = *(const LAS f32x4*)(cum + t * 64 + 8 * c), c1 = *(const LAS f32x4*)(cum + t * 64 + 8 * c + 4);
              const f32x4 l0 = *(const LAS f32x4*)(cum + 63 * 64 + 8 * c), l1 = *(const LAS f32x4*)(cum + 63 * 64 + 8 * c + 4);
#pragma unroll
              for (int j = 0; j < 4; ++j) { kf[j] *= __expf(l0[j] - c0[j]); kf[4 + j] *= __expf(l1[j] - c1[j]); } }
            *(LAS v4u*)(lds + L_KD + (c >> 2) * 4096 + t * 64 + (c & 3) * 16) = pack8f(kf);
            asm volatile("s_waitcnt vmcnt(0) lgkmcnt(0)" ::: "memory"); __builtin_amdgcn_s_barrier(); asm volatile("" ::: "memory");
            const LAS unsigned char* tp = lds + ((lane >> 4) & 1) * 32 + (lane & 3) * 8 + (4 * hi + ((lane & 15) >> 2)) * 64;
            f32x16 acc;
#pragma unroll
            for (int r = 0; r < 16; ++r) acc[r] = 0.f;
#pragma unroll
            for (int ks = 0; ks < 4; ++ks) acc = __builtin_amdgcn_mfma_f32_32x32x16_bf16(trfrag(tp + L_V + eb * 4096 + ks * 1024), trfrag(tp + L_KD + db * 4096 + ks * 1024), acc, 0, 0, 0);
            const float decv = mix ? __expf(cum[63 * 64 + dcol]) : cret;
            LDS_WAIT(); __builtin_amdgcn_s_barrier(); asm volatile("" ::: "memory");
            { const int un = (i < 15) ? u + 1 : (v + F.G) * 16; if (i < 15 || v + F.G < 256) R1_FETCH(un, cur); }
            {
                LAS unsigned char* sg = lds + L_OB + wid * 2048;
#pragma unroll
                for (int r = 0; r < 16; ++r) *(LAS unsigned short*)(sg + crow(r, hi) * 64 + r32 * 2) = (unsigned short)f2bf(state[r]);
                LDS_WAIT();
                bf16* st = ST + ((size_t)(sq * 128 + n)) * 8192 + (size_t)(32 * eb) * 64 + 32 * db;
#pragma unroll
                for (int j = 0; j < 2; ++j) { const int p = lane + 64 * j, row = p >> 2, c16 = p & 3;
                    *(v4u*)(st + row * 64 + 8 * c16) = *(const LAS v4u*)(sg + row * 64 + c16 * 16); }
            }
            if (mix == 1 && eb == 0 && hi == 0) DEC[(size_t)(bh * 128 + n) * 64 + dcol] = pst;
#pragma unroll
            for (int r = 0; r < 16; ++r) state[r] = state[r] * decv + acc[r];
            pst *= decv;
        }
        bf16* tt = TOT + ((size_t)(sq * 8 + run)) * 8192 + dcol;
#pragma unroll
        for (int r = 0; r < 16; ++r) tt[(32 * eb + crow(r, hi)) * 64] = (bf16)f2bf(state[r]);
        if (eb == 0 && hi == 0) DR[(size_t)(sq * 8 + run) * 64 + dcol] = pst;
    }
#undef R1_FETCH
}

__device__ __forceinline__ void phase_r3_mfma(const Args& a, const Frame& F, int l, bool dry) {
    using namespace lin;
    unsigned char* ws = F.ws; bf16* proj = (bf16*)(ws + WS_BIG); const bf16* ST = (const bf16*)(ws + WS_ST); const float* DEC = (const float*)(ws + WS_DEC);
    const bf16* TOT = (const bf16*)(ws + WS_TOT); const float* DR = (const float*)(ws + WS_DR);
    const int tid = opaque_tid(F.wave), lane = tid & 63, wid = F.wave, r32 = lane & 31, hi = lane >> 5;
    LAS unsigned char* lds = F.lds; LAS float* cum = (LAS float*)(lds + L_CUM); LAS float* tot = (LAS float*)(lds + L_TOT); LAS float* ob = (LAS float*)(lds + L_OB);
    const int t = tid >> 3, c = tid & 7;
#define R3_FETCH(u_, f_) do { const int mix_ = (u_) >> 11, bh_ = ((u_) >> 7) & 15, n_ = (u_) & 127, h_ = bh_ & 3; \
        const bf16* prow_ = proj + (size_t)((bh_ >> 2) * SEQ + n_ * 64) * PJ; \
        f_.qw = *(const v4u*)(prow_ + (size_t)t * PJ + (mix_ ? C_CQ : C_RQ) + h_ * 64 + 8 * c); f_.kw = *(const v4u*)(prow_ + (size_t)t * PJ + (mix_ ? C_CK : C_RK) + h_ * 64 + 8 * c); \
        if (mix_) { _Pragma("unroll") for (int x = 0; x < 8; ++x) f_.la[x] = prow_[(size_t)((tid >> 6) * 8 + x) * PJ + C_LA + h_ * 64 + (tid & 63)]; \
                    const f32x4* pp_ = (const f32x4*)(DEC + (size_t)(bh_ * 128 + n_) * 64 + 8 * c); f_.pn0 = pp_[0]; f_.pn1 = pp_[1]; } \
        { const v4u* gp_ = (const v4u*)(prow_ + (size_t)t * PJ + (mix_ ? C_CG : C_RG) + h_ * 128 + 16 * c); f_.g0 = gp_[0]; f_.g1 = gp_[1]; } \
        dma_v(lds, prow_ + (mix_ ? C_CV : C_RV) + h_ * 128, wid, lane); \
        { const bf16* st_ = ST + ((size_t)((mix_ * 16 + bh_) * 128 + n_)) * 8192; \
          _Pragma("unroll") for (int i_ = 0; i_ < 2; ++i_) { const int p = wid + 8 * i_, cc = p >> 1, e0 = 64 * (p & 1); \
            __builtin_amdgcn_global_load_lds((const unsigned*)(st_ + (size_t)(e0 + lane) * 64 + cc * 8), (LAS unsigned*)(lds + L_S + cc * 2048 + e0 * 16), 16, 0, 0); } } } while (0)
    RFetch cur;
    int v = F.vcu;
    for (; v < 256; v += F.G) {
        const int sq = v >> 3, run = v & 7, mix = sq >> 4, bh = sq & 15, b = bh >> 2, h = bh & 3;
        const float lg64 = 64.0f * ret_logg(h);
        {
            const int e = tid >> 2, d0 = (tid & 3) * 16; float sv[16];
#pragma unroll
            for (int k = 0; k < 16; ++k) sv[k] = 0.f;
#pragma unroll 1
            for (int q = 0; q < run; ++q) {
                const v4u* tp_ = (const v4u*)(TOT + ((size_t)(sq * 8 + q)) * 8192 + e * 64 + d0); const f32x4* dp_ = (const f32x4*)(DR + (size_t)(sq * 8 + q) * 64 + d0);
                float tv[16]; { float t0[8], t1[8]; unpack8(tp_[0], t0); unpack8(tp_[1], t1);
#pragma unroll
                  for (int k = 0; k < 8; ++k) { tv[k] = t0[k]; tv[8 + k] = t1[k]; } }
#pragma unroll
                for (int k4 = 0; k4 < 4; ++k4) { const f32x4 d4 = dp_[k4];
#pragma unroll
                    for (int k = 0; k < 4; ++k) sv[4 * k4 + k] = sv[4 * k4 + k] * d4[k] + tv[4 * k4 + k]; }
            }
            float s0[8], s1[8];
#pragma unroll
            for (int k = 0; k < 8; ++k) { s0[k] = sv[k]; s1[k] = sv[8 + k]; }
            *(LAS v4u*)(lds + L_SIN + ((tid & 3) * 2) * 2048 + e * 16) = pack8f(s0); *(LAS v4u*)(lds + L_SIN + ((tid & 3) * 2 + 1) * 2048 + e * 16) = pack8f(s1);
        }
        R3_FETCH(v * 16, cur);
#pragma unroll 1
        for (int i = 0; i < 16; ++i) {
            const int u = v * 16 + i, n = run * 16 + i;
            bf16* prow = proj + (size_t)(b * SEQ + n * 64) * PJ;
            const int cg = (mix ? C_CG : C_RG) + h * 128;
            const float* gn = uni(mix ? a.gla_norm : a.ret_norm) + l * 128;
            chunk_cum_regs(cum, tot, cur.la, mix, h, tid);
            { float qf[8], kf[8], q2[8]; unpack8(cur.qw, qf); unpack8(cur.kw, kf);
              const f32x4 c0 = *(const LAS f32x4*)(cum + t * 64 + 8 * c), c1 = *(const LAS f32x4*)(cum + t * 64 + 8 * c + 4);
              const float pret = __expf(lg64 * (float)i);
#pragma unroll
              for (int j = 0; j < 4; ++j) { const float e0 = __expf(c0[j]), e1 = __expf(c1[j]); qf[j] *= e0; qf[4 + j] *= e1; kf[j] *= __builtin_amdgcn_rcpf(e0); kf[4 + j] *= __builtin_amdgcn_rcpf(e1);
                  q2[j] = qf[j] * (mix ? cur.pn0[j] : pret); q2[4 + j] = qf[4 + j] * (mix ? cur.pn1[j] : pret); }
              *(LAS v4u*)(lds + L_QE + c * 1024 + t * 16) = pack8f(qf); *(LAS v4u*)(lds + L_KE + c * 1024 + t * 16) = pack8f(kf); *(LAS v4u*)(lds + L_QE2 + c * 1024 + t * 16) = pack8f(q2); }
            const v4u gw0 = cur.g0, gw1 = cur.g1;
            asm volatile("s_waitcnt vmcnt(0) lgkmcnt(0)" ::: "memory"); __builtin_amdgcn_s_barrier(); asm volatile("" ::: "memory");
            {
                const int ib = wid & 1, eb = wid >> 1;
                bf16x8 qe[4];
#pragma unroll
                for (int d0 = 0; d0 < 4; ++d0) qe[d0] = *(const LAS bf16x8*)(lds + L_QE + (2 * d0 + hi) * 1024 + (32 * ib + r32) * 16);
                f32x16 p0, p1;
#pragma unroll
                for (int r = 0; r < 16; ++r) { p0[r] = 0.f; p1[r] = 0.f; }
                const LAS unsigned char* kb = lds + L_KE + hi * 1024 + r32 * 16;
#pragma unroll
                for (int d0 = 0; d0 < 4; ++d0) p0 = __builtin_amdgcn_mfma_f32_32x32x16_bf16(*(const LAS bf16x8*)(kb + d0 * 2048), qe[d0], p0, 0, 0, 0);
                if (ib == 1) {
#pragma unroll
                    for (int d0 = 0; d0 < 4; ++d0) p1 = __builtin_amdgcn_mfma_f32_32x32x16_bf16(*(const LAS bf16x8*)(kb + d0 * 2048 + 512), qe[d0], p1, 0, 0, 0);
#pragma unroll
                    for (int r = 0; r < 16; ++r) if (crow(r, hi) > r32) p1[r] = 0.f;
                } else {
#pragma unroll
                    for (int r = 0; r < 16; ++r) if (crow(r, hi) > r32) p0[r] = 0.f;
                }
                bf16x8 pa[4];
                { v4u w0 = {cvtpk2(p0[0], p0[1]), cvtpk2(p0[2], p0[3]), cvtpk2(p0[4], p0[5]), cvtpk2(p0[6], p0[7])};
                  v4u w1 = {cvtpk2(p0[8], p0[9]), cvtpk2(p0[10], p0[11]), cvtpk2(p0[12], p0[13]), cvtpk2(p0[14], p0[15])};
                  v4u w2 = {cvtpk2(p1[0], p1[1]), cvtpk2(p1[2], p1[3]), cvtpk2(p1[4], p1[5]), cvtpk2(p1[6], p1[7])};
                  v4u w3 = {cvtpk2(p1[8], p1[9]), cvtpk2(p1[10], p1[11]), cvtpk2(p1[12], p1[13]), cvtpk2(p1[14], p1[15])};
                  pa[0] = __builtin_bit_cast(bf16x8, w0); pa[1] = __builtin_bit_cast(bf16x8, w1); pa[2] = __builtin_bit_cast(bf16x8, w2); pa[3] = __builtin_bit_cast(bf16x8, w3); }
                f32x16 o;
#pragma unroll
                for (int r = 0; r < 16; ++r) o[r] = 0.f;
                const LAS unsigned char* vp = lds + L_V + eb * 4096 + ((lane >> 4) & 1) * 32 + (lane & 3) * 8 + (4 * hi + ((lane & 15) >> 2)) * 64;
#pragma unroll
                for (int ks = 0; ks < 4; ++ks) o = __builtin_amdgcn_mfma_f32_32x32x16_bf16(pa[ks], trfrag(vp + ks * 1024), o, 0, 0, 0);
#pragma unroll
                for (int d0 = 0; d0 < 4; ++d0) o = __builtin_amdgcn_mfma_f32_32x32x16_bf16(qe[d0], *(const LAS bf16x8*)(lds + L_S + (2 * d0 + hi) * 2048 + (32 * eb + r32) * 16), o, 0, 0, 0);
#pragma unroll
                for (int d0 = 0; d0 < 4; ++d0) o = __builtin_amdgcn_mfma_f32_32x32x16_bf16(*(const LAS bf16x8*)(lds + L_QE2 + (2 * d0 + hi) * 1024 + (32 * ib + r32) * 16),
                                                                                         *(const LAS bf16x8*)(lds + L_SIN + (2 * d0 + hi) * 2048 + (32 * eb + r32) * 16), o, 0, 0, 0);
#pragma unroll
                for (int r = 0; r < 16; ++r) ob[(32 * ib + crow(r, hi)) * OB_LD + 32 * eb + r32] = o[r];
            }
            LDS_WAIT(); __builtin_amdgcn_s_barrier(); asm volatile("" ::: "memory");
            if (i < 15) R3_FETCH(u + 1, cur);
            {
                const int ii = tid >> 3, sg = tid & 7;
                f32x4 vv[4]; float ss = 0.f;
#pragma unroll
                for (int k = 0; k < 4; ++k) { vv[k] = *(const LAS f32x4*)(ob + ii * OB_LD + 16 * sg + 4 * k); ss += (vv[k][0] * vv[k][0] + vv[k][1] * vv[k][1]) + (vv[k][2] * vv[k][2] + vv[k][3] * vv[k][3]); }
                ss = xadd<1>(ss); ss = xadd<2>(ss); ss = xadd<4>(ss);
                const float rstd = __builtin_amdgcn_rsqf(ss * (1.0f / 128.0f) + EPS);
                v4u* gp = (v4u*)(prow + (size_t)ii * PJ + cg + 16 * sg);
#pragma unroll
                for (int k2 = 0; k2 < 2; ++k2) { const v4u gw = k2 ? gw1 : gw0; float gf[8]; unpack8(gw, gf);
                    const f32x4 g0 = *(const f32x4*)(gn + 16 * sg + 8 * k2), g1 = *(const f32x4*)(gn + 16 * sg + 8 * k2 + 4);
                    float y[8];
#pragma unroll
                    for (int j = 0; j < 4; ++j) { y[j] = vv[2 * k2][j] * rstd * g0[j] * gf[j]; y[4 + j] = vv[2 * k2 + 1][j] * rstd * g1[j] * gf[4 + j]; }
                    if (!dry) gp[k2] = pack8f(y); }
            }
        }
        LDS_WAIT(); __builtin_amdgcn_s_barrier(); asm volatile("" ::: "memory");
    }
#undef R3_FETCH
}

namespace att {
typedef float f32x16 __attribute__((ext_vector_type(16)));
typedef short v4i16_t __attribute__((ext_vector_type(4)));
constexpr int SLOT = 16384, L_K = 0, L_V = 3 * SLOT, L_WS = 6 * SLOT, L_XCH = 0, L_STG = 65536;
constexpr float THR = 8.0f;
__device__ __forceinline__ int crow(int r, int hi) { return (r & 3) + 8 * (r >> 2) + 4 * hi; }
__device__ __forceinline__ float swapmax(float m) { auto rr = __builtin_amdgcn_permlane32_swap(__float_as_uint(m), __float_as_uint(m), false, false); return fmaxf(__uint_as_float(rr[0]), __uint_as_float(rr[1])); }
__device__ __forceinline__ float max3f(float a, float b, float c) { return __builtin_fmaxf(__builtin_fmaxf(a, b), c); }
__device__ __forceinline__ float swapadd(float m) { auto rr = __builtin_amdgcn_permlane32_swap(__float_as_uint(m), __float_as_uint(m), false, false); return __uint_as_float(rr[0]) + __uint_as_float(rr[1]); }
__device__ __forceinline__ unsigned cvtpk(float lo, float hi) { typedef float f2 __attribute__((ext_vector_type(2))); typedef __bf16 b2 __attribute__((ext_vector_type(2))); f2 v = {lo, hi}; b2 b = __builtin_convertvector(v, b2); return __builtin_bit_cast(unsigned, b); }

__device__ __forceinline__ void attn_unit(LAS unsigned char* lds, bf16* proj, int tid, int wid, int b, int h, int qb, float lam, float post, const float* gn, bool dry,
                                          const Args& a, unsigned char* wnext, int lnext, int it0, int it1) {
    const int lane = tid & 63, r32 = lane & 31, hi = lane >> 5, mp = wid & 1, rw = wid >> 1;
    const size_t rowbase = (size_t)b * SEQ; const int q0 = qb * 128;
    const int NT = 2 * qb + 2, NTw = 2 * qb + 1 + (rw >> 1);
    const bf16* Kh = proj + rowbase * PJ + C_AK + h * 128; const bf16* Vh = proj + rowbase * PJ + C_AV + h * 128;
    const unsigned kvoff = (unsigned)(lane * PJ + wid * 8) * 2u;
    const unsigned vvoff = (unsigned)((16 * (wid & 3) + (lane >> 2)) * PJ + (wid >> 2) * 32 + (lane & 3) * 8) * 2u;
    const unsigned kdst = L_K + wid * 1024, vdst = L_V + wid * 1024;
    const unsigned ldsb = (unsigned)(size_t)lds;
#define ATT_DMA(t, slot) do { const char* kt_ = (const char*)uni(Kh + (size_t)(t) * 64 * PJ); const char* vt_ = (const char*)uni(Vh + (size_t)(t) * 64 * PJ); \
        const unsigned kd_ = (unsigned)__builtin_amdgcn_readfirstlane((int)(ldsb + kdst + (slot) * SLOT)), vd_ = (unsigned)__builtin_amdgcn_readfirstlane((int)(ldsb + vdst + (slot) * SLOT)); \
        glds16s<0>(kt_, kvoff, kd_); glds16s<0>(kt_ + 128, kvoff, kd_ + 8192); glds16s<0>(vt_, vvoff, vd_); glds16s<0>(vt_ + 128, vvoff, vd_ + 8192); } while (0)
#define ATT_DMA1(t, slot, P_) do { const char* bt_ = (const char*)uni(((P_) < 2 ? Kh : Vh) + (size_t)(t) * 64 * PJ) + ((P_) & 1) * 128; \
        const unsigned dd_ = (unsigned)__builtin_amdgcn_readfirstlane((int)(ldsb + ((P_) < 2 ? kdst : vdst) + (slot) * SLOT + ((P_) & 1) * 8192)); \
        glds16s<0>(bt_, (P_) < 2 ? kvoff : vvoff, dd_); } while (0)
    bf16x8 qr[4];
    { const bf16* qp = proj + (rowbase + q0 + 32 * rw + r32) * PJ + C_AQ + h * 128 + mp * 64 + hi * 8;
#pragma unroll
      for (int d0 = 0; d0 < 4; ++d0) qr[d0] = *(const bf16x8*)(qp + d0 * 16); }
    ATT_DMA(0, 0); ATT_DMA(1, 1);
    f32x16 o[4];
#pragma unroll
    for (int d = 0; d < 4; ++d)
#pragma unroll
        for (int r = 0; r < 16; ++r) o[d][r] = 0.f;
    float mref = 0.f, lsum = 0.f;
    float one_ = 1.0f; asm volatile("" : "+v"(one_));
    f32x16 negm;
#pragma unroll
    for (int r = 0; r < 16; ++r) negm[r] = 0.f;
    volatile LAS float* wsf = (volatile LAS float*)(lds + L_WS) + wid * 64;
    const LAS unsigned char* kb0 = lds + L_K + mp * 8192 + hi * 1024 + r32 * 16;
    const LAS unsigned char* vp0 = lds + L_V + ((lane >> 4) & 1) * 32 + (lane & 3) * 8 + (4 * hi + ((lane & 15) >> 2)) * 64;
#define ATT_KLOAD(slot) do { _Pragma("unroll") for (int d0 = 0; d0 < 4; ++d0) { kf[2 * d0] = *(const LAS bf16x8*)(kb0 + (slot) * SLOT + d0 * 2048); kf[2 * d0 + 1] = *(const LAS bf16x8*)(kb0 + (slot) * SLOT + d0 * 2048 + 512); } } while (0)
#define ATT_VLOAD(dst, slot, d0_) do { _Pragma("unroll") for (int ks_ = 0; ks_ < 4; ++ks_) { \
        const v4i16_t lo_ = __builtin_amdgcn_ds_read_tr16_b64_v4i16((LAS v4i16_t*)(vp0 + (slot) * SLOT + (d0_) * 4096 + ks_ * 1024)); \
        const v4i16_t hh_ = __builtin_amdgcn_ds_read_tr16_b64_v4i16((LAS v4i16_t*)(vp0 + (slot) * SLOT + (d0_) * 4096 + ks_ * 1024 + 512)); \
        dst[ks_] = (bf16x8){lo_[0], lo_[1], lo_[2], lo_[3], hh_[0], hh_[1], hh_[2], hh_[3]}; } } while (0)
#define ATT_PV(d0_, vf_) do { _Pragma("unroll") for (int ks_ = 0; ks_ < 4; ++ks_) o[d0_] = __builtin_amdgcn_mfma_f32_32x32x16_bf16(pa[ks_], vf_[ks_], o[d0_], 0, 0, 0); } while (0)
    asm volatile("s_waitcnt vmcnt(4)" ::: "memory"); LDS_WAIT(); __builtin_amdgcn_s_barrier(); asm volatile("" ::: "memory");
    bf16x8 kf[8];
    ATT_KLOAD(0);
#define ATT_PARTA(FIRST_, p0, p1) \
            float ra = max3f(p0[0], p0[1], p1[0]), rb = max3f(p0[2], p0[3], p1[1]); ra = max3f(ra, p1[2], p1[3]); \
            _Pragma("unroll") for (int r = 4; r < 16; r += 4) { ra = max3f(ra, p0[r], p0[r + 1]); rb = max3f(rb, p0[r + 2], p0[r + 3]); ra = max3f(ra, p1[r], p1[r + 1]); rb = max3f(rb, p1[r + 2], p1[r + 3]); } \
            float rm = swapmax(fmaxf(ra, rb)); \
            if ((FIRST_) || __any(rm > THR)) { \
                const float dl = (FIRST_) ? rm : fmaxf(rm, 0.f); \
                mref += dl; \
                _Pragma("unroll") for (int r = 0; r < 16; ++r) { p0[r] -= dl; p1[r] -= dl; negm[r] = -mref; } \
                fres_ = fast_exp2(-dl); lsum *= fres_; need_ = !(FIRST_); }
#define ATT_PARTB(p0, p1, pk) \
            { float sacc = 0.f, sbcc = 0.f; \
            _Pragma("unroll") for (int r = 0; r < 16; ++r) { p0[r] = fast_exp2(p0[r]); p1[r] = fast_exp2(p1[r]); sacc += p0[r]; sbcc = __builtin_fmaf(p1[r], one_, sbcc); } \
            lsum += sacc + sbcc; \
            { v4u w0 = {cvtpk(p0[0], p0[1]), cvtpk(p0[2], p0[3]), cvtpk(p0[4], p0[5]), cvtpk(p0[6], p0[7])}; \
              v4u w1 = {cvtpk(p0[8], p0[9]), cvtpk(p0[10], p0[11]), cvtpk(p0[12], p0[13]), cvtpk(p0[14], p0[15])}; \
              v4u w2 = {cvtpk(p1[0], p1[1]), cvtpk(p1[2], p1[3]), cvtpk(p1[4], p1[5]), cvtpk(p1[6], p1[7])}; \
              v4u w3 = {cvtpk(p1[8], p1[9]), cvtpk(p1[10], p1[11]), cvtpk(p1[12], p1[13]), cvtpk(p1[14], p1[15])}; \
              pk[0] = __builtin_bit_cast(bf16x8, w0); pk[1] = __builtin_bit_cast(bf16x8, w1); pk[2] = __builtin_bit_cast(bf16x8, w2); pk[3] = __builtin_bit_cast(bf16x8, w3); } }
#define ATT_POST() \
            if (need_) { if (hi == 0) wsf[r32] = fres_; \
                _Pragma("unroll") for (int r = 0; r < 16; ++r) { const float fr = wsf[crow(r, hi)]; \
                    _Pragma("unroll") for (int d = 0; d < 4; ++d) o[d][r] *= fr; } }
#define ATT_SB() __builtin_amdgcn_sched_barrier(0)
#define ATT_QK(p0, p1) do { p0 = __builtin_amdgcn_mfma_f32_32x32x16_bf16(kf[0], qr[0], negm, 0, 0, 0); p1 = __builtin_amdgcn_mfma_f32_32x32x16_bf16(kf[1], qr[0], negm, 0, 0, 0); \
        _Pragma("unroll") for (int d0 = 1; d0 < 4; ++d0) { p0 = __builtin_amdgcn_mfma_f32_32x32x16_bf16(kf[2 * d0], qr[d0], p0, 0, 0, 0); p1 = __builtin_amdgcn_mfma_f32_32x32x16_bf16(kf[2 * d0 + 1], qr[d0], p1, 0, 0, 0); } } while (0)
#define ATT_STEP(T_, SL_, SL1_, SL2_, G_DMA, ACT_, ACTN_) do { \
        if (ACTN_) ATT_KLOAD(SL1_); \
        if (G_DMA) ATT_DMA1((T_) + 2, SL2_, 0); \
        if (ACT_) { ATT_PV(0, va); ATT_VLOAD(va, SL_, 2); } \
        ATT_SB(); \
        if (G_DMA) ATT_DMA1((T_) + 2, SL2_, 1); \
        bool need_ = false; float fres_ = 1.0f; \
        if (ACTN_) { ATT_QK(ps0, ps1); ATT_SB(); if (G_DMA) ATT_DMA1((T_) + 2, SL2_, 2); ATT_PARTA(false, ps0, ps1) } \
        else if (G_DMA) ATT_DMA1((T_) + 2, SL2_, 2); \
        ATT_SB(); \
        if (G_DMA) ATT_DMA1((T_) + 2, SL2_, 3); \
        if (ACT_) { ATT_PV(1, vb); ATT_VLOAD(vb, SL_, 3); ATT_PV(2, va); ATT_PV(3, vb); } \
        if (ACTN_) { ATT_PARTB(ps0, ps1, pn) asm volatile("" :: "v"(pn[0]), "v"(pn[1]), "v"(pn[2]), "v"(pn[3]), "v"(lsum)); }        \
        _Pragma("unroll") for (int g_ = 0; g_ < 12; ++g_) { __builtin_amdgcn_sched_group_barrier(0x008, 1, 0); __builtin_amdgcn_sched_group_barrier(0x100, 1, 0); __builtin_amdgcn_sched_group_barrier(0x002, 7, 0); } \
        ATT_SB(); \
        if (ACTN_) { ATT_POST() _Pragma("unroll") for (int i_ = 0; i_ < 4; ++i_) pa[i_] = pn[i_]; \
            ATT_VLOAD(va, SL1_, 0); ATT_VLOAD(vb, SL1_, 1); } \
        ATT_SB(); \
    } while (0)
#define ATT_BARRIER() do { asm volatile("s_waitcnt vmcnt(0)" ::: "memory"); __builtin_amdgcn_s_barrier(); asm volatile("" ::: "memory"); } while (0)
    f32x16 ps0, ps1; bf16x8 pa[4], pn[4];
#pragma unroll
    for (int i = 0; i < 4; ++i) { pa[i] = (bf16x8){0, 0, 0, 0, 0, 0, 0, 0}; pn[i] = pa[i]; }
    bf16x8 va[4], vb[4];
    ATT_QK(ps0, ps1);
    ATT_VLOAD(va, 0, 0); ATT_VLOAD(vb, 0, 1);
    { bool need_ = false; float fres_ = 1.0f; ATT_PARTA(true, ps0, ps1) ATT_PARTB(ps0, ps1, pa) (void)need_; (void)fres_; }
    int t = 0;
    for (; t + 5 <= NT; t += 3) {
        ATT_BARRIER(); ATT_STEP(t, 0, 1, 2, true, true, true);
        ATT_BARRIER(); ATT_STEP(t + 1, 1, 2, 0, true, true, true);
        ATT_BARRIER(); ATT_STEP(t + 2, 2, 0, 1, true, true, true);
    }
    {
        int sl = 0, sl1 = 1, sl2 = 2;
        for (; t < NT; ++t) {
            if (t + 1 < NT) ATT_BARRIER();
            ATT_STEP(t, sl, sl1, sl2, (t + 2 < NT), (t < NTw), (t + 1 < NTw));
            const int s0 = sl; sl = sl1; sl1 = sl2; sl2 = s0;
        }
    }
#undef ATT_STEP
#undef ATT_PARTA
#undef ATT_PARTB
#undef ATT_POST
#undef ATT_BARRIER
#undef ATT_QK
#undef ATT_FAST
#undef ATT_SB
#undef ATT_KLOAD
#undef ATT_VLOAD
#undef ATT_PV
    int lane_e = lane; asm volatile("" : "+v"(lane_e)); const int r32e = lane_e & 31, hie = lane_e >> 5;
    const ConvJob cj0 = conv_job(a, wnext, lnext, it0), cj1 = conv_job(a, wnext, lnext, it1); f32x4 ct0[8], ct1[8];
    conv_load(cj0, lane_e, ct0); conv_load(cj1, lane_e, ct1);
    lsum = swapadd(lsum);
    if (hie == 0) wsf[r32e] = 1.0f / lsum;
#pragma unroll
    for (int r = 0; r < 16; ++r) { const float fr = wsf[crow(r, hie)];
#pragma unroll
        for (int d = 0; d < 4; ++d) o[d][r] *= fr; }
    LDS_WAIT(); __builtin_amdgcn_s_barrier(); asm volatile("" ::: "memory");
    LAS float* xch = (LAS float*)(lds + L_XCH) + rw * 4096 + lane_e;
    if (mp == 1) {
#pragma unroll
        for (int d = 0; d < 4; ++d)
#pragma unroll
            for (int r = 0; r < 16; ++r) xch[(d * 16 + r) * 64] = o[d][r];
    }
    LDS_WAIT(); __builtin_amdgcn_s_barrier(); asm volatile("" ::: "memory");
    if (mp == 0) {
        float ss[16];
#pragma unroll
        for (int r = 0; r < 16; ++r) ss[r] = 0.f;
#pragma unroll
        for (int d = 0; d < 4; ++d)
#pragma unroll
            for (int r = 0; r < 16; ++r) { const float y = o[d][r] - lam * xch[(d * 16 + r) * 64]; o[d][r] = y; ss[r] += y * y; }
#pragma unroll
        for (int r = 0; r < 16; ++r) {
            ss[r] = xadd<1>(ss[r]); ss[r] = xadd<2>(ss[r]); ss[r] = xadd<4>(ss[r]); ss[r] = xadd<8>(ss[r]); ss[r] = xadd<16>(ss[r]);
            ss[r] = post * __builtin_amdgcn_rsqf(ss[r] * (1.0f / 128.0f) + EPS);
        }
        LAS bf16* stg = (LAS bf16*)(lds + L_STG + rw * 8192);
#pragma unroll
        for (int d = 0; d < 4; ++d) { const float g = gn[32 * d + r32e];
#pragma unroll
            for (int r = 0; r < 16; ++r) stg[crow(r, hie) * 128 + 32 * d + r32e] = (bf16)f2bf(o[d][r] * ss[r] * g); }
        LDS_WAIT();
        bf16* orow = proj + (rowbase + q0 + 32 * rw) * PJ + C_AQ + h * 128;
#pragma unroll
        for (int i = 0; i < 8; ++i) { const int row = i * 4 + (lane_e >> 4), ch = lane_e & 15;
            const v4u v = *(const LAS v4u*)(stg + row * 128 + ch * 8); if (!dry) *(v4u*)(orow + (size_t)row * PJ + ch * 8) = v; }
    }
    conv_store(cj0, lane_e, ct0); conv_store(cj1, lane_e, ct1);
    LDS_WAIT(); __builtin_amdgcn_s_barrier(); asm volatile("" ::: "memory");
#undef ATT_DMA
#undef ATT_DMA1
}
}

__device__ __forceinline__ void phase_attn(const Args& a, const Frame& F, int l, bool dry, unsigned char* wnext) {
    unsigned char* ws = F.ws; bf16* proj = (bf16*)(ws + WS_BIG);
    const float lam = ((const float*)(ws + WS_LAM))[l];
    const float post = 1.0f - LAM_INIT[l];
    const float* gn = uni(a.da_norm) + l * 128;
    const int tid = opaque_tid(F.wave);
    for (int v = F.vcu; v < 256; v += F.G) {
        const int bh = v >> 4, s = v & 15;
#pragma unroll 1
        for (int i = 0; i < 4; ++i) {
            const int qb = (i == 0) ? 63 - s : (i == 1) ? 32 + s : (i == 2) ? 31 - s : s;
            const bool cv = (wnext != nullptr) && (v == F.vcu);
            const int gw = F.vcu * 8 + F.wave, NGW = F.G * 8;
            att::attn_unit(F.lds, proj, tid, F.wave, bh >> 2, bh & 3, qb, lam, post, gn, dry, a, wnext, l + 1, cv ? gw + (2 * i) * NGW : -1, cv ? gw + (2 * i + 1) * NGW : -1);
            if (cv && i == 3) {
                int lane = tid & 63; asm volatile("" : "+v"(lane));
                for (int it = gw + 8 * NGW; it < I_TOTAL - I_LA; it += NGW) conv_item(a, wnext, l + 1, it, lane);
                for (int r = gw; r < I_LA; r += NGW) conv_la_item(a, wnext, l + 1, r, lane);
                if (gw == 0) conv_lam(a, F.ws, l + 1, lane);
            }
        }
    }
}


constexpr int NPH = 12;
constexpr int N_PHASES = DEPTH * NPH + 1;
#ifndef REP_UP
#define REP_UP 1
#endif
#ifndef REP_DOWN
#define REP_DOWN 1
#endif
#ifndef REP_INPROJ
#define REP_INPROJ 1
#endif
#ifndef REP_R
#define REP_R 1
#endif
#ifndef REP_ATTN
#define REP_ATTN 1
#endif
#ifndef REP_G
#define REP_G 1
#endif
#ifndef REP_M
#define REP_M 1
#endif
#ifndef REP_R2
#define REP_R2 1
#endif
#ifndef REP_NORM
#define REP_NORM 1
#endif
#ifndef MK_PER_PHASE
#define MK_PER_PHASE 0
#endif

__global__ void __launch_bounds__(512, 2) mk_fwd(Args a) {
    extern __shared__ __attribute__((aligned(16))) unsigned char lds_raw[];
    Frame F;
    F.lds = (LAS unsigned char*)lds_raw; F.ws = uni(a.ws); F.wave = __builtin_amdgcn_readfirstlane((int)threadIdx.x >> 6);
    F.G = gridDim.x; { const int bx = blockIdx.x; F.vcu = (F.G % 8 == 0) ? (bx % 8) * (F.G / 8) + bx / 8 : bx; }
    volatile LAS unsigned* MISC = (volatile LAS unsigned*)(F.lds + MISC_OFF);
    if (threadIdx.x < 32) MISC[threadIdx.x] = 0u;
    __syncthreads();
    XcdBarrier bar; bar.bar = (unsigned*)(F.ws + WS_CTL); bar.x = 0; bar.st = nullptr;
    if (!MK_PER_PHASE) bar = xcd_barrier_post((unsigned*)(F.ws + WS_CTL), MISC + 8);
    const int lo = a.ph_lo, hi = a.ph_hi;
#define RUN(k) (lo <= (k) && (k) < hi)
#define SEAM(k) do { if (RUN(k) && RUN((k) + 1)) xcd_barrier(bar); } while (0)
    unsigned char* ws = F.ws; float* const outp = uni(a.out);
    bf16* XB = (bf16*)(ws + WS_HN); bf16* BIG = (bf16*)(ws + WS_BIG); bf16* MG = (bf16*)(ws + WS_ST); float* SSQ = (float*)(ws + WS_SSQ);
    const int cid = (int)blockIdx.x;

    if (RUN(0)) phase_rope(F);
    for (int l = 0; l < DEPTH; ++l) {
        const int pb = l * NPH;
        unsigned char* const wb1 = (unsigned char*)((unsigned long long)outp - WS_W);
        unsigned char* const wcur = (l & 1) ? wb1 : ws; unsigned char* const wnxt = (l + 1 < DEPTH) ? ((l & 1) ? ws : wb1) : nullptr;
        if (RUN(pb)) {
            for (int rep = 0; rep < REP_NORM; ++rep) {
            if (l == 0) phase_conv(a, F, 0, ws);
            if (l == 0) phase_prep(F, uni(a.x), XB, SSQ);
            }
        }
        if (l == 0) SEAM(pb);
        for (int hf = 0; hf < 2; ++hf) {
            const int p0 = pb + (hf ? 10 : 1);
            const float* ssq_in = SSQ + (size_t)(hf ? 2 : 0) * M * 16;
            float* ssq_out = SSQ + (size_t)(hf ? 0 : 1) * M * 16;
            if (RUN(p0)) {
                pg8::Gemm g{(const char*)XB, (const char*)(wcur + (hf ? W_13B : W_13A)), DMODEL, DMODEL, DMODEL, 0, 0};
                pg8::Order<(2 * DFFP) / 256, 1> S; S.init(F.G, cid, F.wave);
                pg8::EpiSwiGLU E{BIG, ssq_in};
                for (int rep = 0; rep < REP_UP; ++rep)
                pg8::gemm_phase<pg8::EpiSwiGLU, true>(F.lds, g, S, E);
            }
            SEAM(p0);
            if (RUN(p0 + 1)) {
                pg8::Gemm g{(const char*)BIG, (const char*)(wcur + (hf ? W_2B : W_2A)), DFFP, DFFP, DFFP, 0, 0};
                pg8::Order<(DMODEL) / 256, 1> S; S.init(F.G, cid, F.wave);
                for (int rep = 0; rep < REP_DOWN; ++rep) {
                pg8::EpiResid E{XB, 0.5f, 2.0f, rep < REP_DOWN - 1, ssq_out};
                pg8::gemm_phase<pg8::EpiResid, true>(F.lds, g, S, E); }
            }
            SEAM(p0 + 1);
            if (hf == 0) {
                const float* ssq_mix = ssq_out;
                if (RUN(pb + 3)) {
                    pg8::Gemm g{(const char*)XB, (const char*)(wcur + W_IN), DMODEL, DMODEL, DMODEL, 0, 0};
                    pg8::Order<(PJ) / 256, 1> S; S.init(F.G, cid, F.wave);
                    pg8::EpiInProj E{BIG, (const float*)(ws + WS_ROPE), uni(a.gla_ab) + l * 256, ssq_mix};
                    for (int rep = 0; rep < REP_INPROJ; ++rep)
                    pg8::gemm_phase<pg8::EpiInProj, true>(F.lds, g, S, E);
                }
                SEAM(pb + 3);
                if (RUN(pb + 4)) for (int rep = 0; rep < REP_R; ++rep) phase_r1_mfma(a, F);
                SEAM(pb + 4);
                if (RUN(pb + 6)) {
                    for (int rep = 0; rep < REP_R; ++rep) phase_r3_mfma(a, F, l, rep < REP_R - 1);
                    for (int rep = 0; rep < REP_ATTN; ++rep) phase_attn(a, F, l, rep < REP_ATTN - 1, rep == REP_ATTN - 1 ? wnxt : nullptr);
                }
                SEAM(pb + 6);
                if (RUN(pb + 7)) {
                    pg8::Gemm g{(const char*)XB, (const char*)(wcur + W_G), DMODEL, DMODEL, DMODEL, 0, 0};
                    pg8::Order<(3 * DMODEL) / 256, 1> S; S.init(F.G, cid, F.wave);
                    pg8::EpiGates E{BIG, ssq_mix};
                    for (int rep = 0; rep < REP_G; ++rep)
                    pg8::gemm_phase<pg8::EpiGates, true>(F.lds, g, S, E);
                }
                SEAM(pb + 7);
                if (RUN(pb + 8)) {
                    pg8::Gemm g{(const char*)BIG, (const char*)(wcur + W_B), PJ, 512, 512, 512 * 2, (size_t)DMODEL * 512 * 2};
                    pg8::Order<(DMODEL) / 256, 3> S; S.init(F.G, cid, F.wave);
                    pg8::EpiMerge E{BIG, MG};
                    for (int rep = 0; rep < REP_M; ++rep)
                    pg8::gemm_phase<pg8::EpiMerge, true>(F.lds, g, S, E);
                }
                SEAM(pb + 8);
                if (RUN(pb + 9)) {
                    pg8::Gemm g{(const char*)MG, (const char*)(wcur + W_O), DMODEL, DMODEL, DMODEL, 0, 0};
                    pg8::Order<(DMODEL) / 256, 1> S; S.init(F.G, cid, F.wave);
                    pg8::EpiResid E{XB, 1.0f, 1.0f, false, SSQ + (size_t)2 * M * 16};
                    pg8::gemm_phase<pg8::EpiResid, true>(F.lds, g, S, E);
                }
                SEAM(pb + 9);
            }
        }
    }
    if (RUN(DEPTH * NPH)) phase_final_norm(F, XB, outp, uni(a.final_norm), SSQ);
#undef RUN
#undef SEAM
}

extern "C" void kernel_launch(void* const* d_in, const int* in_sizes, int n_in, void* d_out, int out_size, void* d_ws, size_t ws_size, hipStream_t stream) {
    static int grid = 0;
    if (grid == 0) {
        if (n_in != 22 || in_sizes[0] != M * DMODEL || out_size != M * DMODEL || ws_size < WS_END) { fprintf(stderr, "kernel_launch: unexpected shapes (n_in %d, ws %zu)\n", n_in, ws_size); grid = -1; return; }
        int dev = 0, cus = 0, per_cu = 0;
        if (hipGetDevice(&dev) != hipSuccess || hipDeviceGetAttribute(&cus, hipDeviceAttributeMultiprocessorCount, dev) != hipSuccess) { grid = -1; return; }
        if (hipFuncSetAttribute((const void*)mk_fwd, hipFuncAttributeMaxDynamicSharedMemorySize, LDS_BYTES) != hipSuccess) { fprintf(stderr, "kernel_launch: hipFuncSetAttribute failed\n"); grid = -1; return; }
        if (hipOccupancyMaxActiveBlocksPerMultiprocessor(&per_cu, (const void*)mk_fwd, 512, LDS_BYTES) != hipSuccess || per_cu < 1) fprintf(stderr, "kernel_launch: occupancy query says %d\n", per_cu);
        (void)hipGetLastError();
        grid = cus;
    }
    if (grid < 0) return;
    if (hipMemsetAsync((char*)d_ws + WS_CTL, 0, CTL_ZERO_BYTES, stream) != hipSuccess) return;
    Args a{};
    a.x = (const float*)d_in[0]; a.ffn1_norm = (const float*)d_in[1]; a.ffn1_w1 = (const float*)d_in[2]; a.ffn1_w3 = (const float*)d_in[3]; a.ffn1_w2 = (const float*)d_in[4];
    a.mix_norm = (const float*)d_in[5]; a.w_in = (const float*)d_in[6]; a.lam_qk = (const float*)d_in[7]; a.da_norm = (const float*)d_in[8]; a.ret_norm = (const float*)d_in[9];
    a.gla_a2 = (const float*)d_in[10]; a.gla_ab = (const float*)d_in[11]; a.gla_norm = (const float*)d_in[12]; a.wb_a = (const float*)d_in[13]; a.wb_b = (const float*)d_in[14];
    a.wb_c = (const float*)d_in[15]; a.w_out = (const float*)d_in[16]; a.ffn2_norm = (const float*)d_in[17]; a.ffn2_w1 = (const float*)d_in[18]; a.ffn2_w3 = (const float*)d_in[19];
    a.ffn2_w2 = (const float*)d_in[20]; a.final_norm = (const float*)d_in[21];
    a.out = (float*)d_out; a.ws = (unsigned char*)d_ws;
#if MK_PER_PHASE
    for (int p = 0; p < N_PHASES; ++p) { a.ph_lo = p; a.ph_hi = p + 1; hipLaunchKernelGGL(mk_fwd, dim3(grid), dim3(512), LDS_BYTES, stream, a); }
#else
    a.ph_lo = 0; a.ph_hi = N_PHASES;
    hipLaunchKernelGGL(mk_fwd, dim3(grid), dim3(512), LDS_BYTES, stream, a);
#endif
}
```
